# Optimizing an MI355X kernel written in HIP

```python
import math
import jax, jax.numpy as jnp
from jax import lax
import numpy as np

D_MODEL = 1024
BATCH = 8
SEQ = 2048
DEPTH = 2

HEAD_DIM = 64
A_HEADS = D_MODEL // 4 // HEAD_DIM
A_WIDTH = A_HEADS * HEAD_DIM
B_HEADS = D_MODEL // 2 // (2 * HEAD_DIM)
B_QK = B_HEADS * 2 * HEAD_DIM
B_V = B_HEADS * 2 * HEAD_DIM
C_WIDTH = D_MODEL // 4
MIX_WIDTH = A_WIDTH + B_V + C_WIDTH
IN_COLS = 3 * A_WIDTH + 2 * B_QK + B_V + 3 * C_WIDTH
SPLITS = (A_WIDTH, 2 * A_WIDTH, 3 * A_WIDTH,
          3 * A_WIDTH + B_QK, 3 * A_WIDTH + 2 * B_QK, 3 * A_WIDTH + 2 * B_QK + B_V,
          3 * A_WIDTH + 2 * B_QK + B_V + C_WIDTH, 3 * A_WIDTH + 2 * B_QK + B_V + 2 * C_WIDTH)
DILATED_PATTERNS = ((128, 1), (512, 4), (2048, 16))
Q_BLOCK = 128
CONV_WIDTH = 3
D_FF = ((8 * D_MODEL // 3 + 127) // 128) * 128
ROPE_THETA = 500000.0
ROPE_FRACTION = 4
NORM_EPS = 1e-6
SUBLN_EPS = 1e-5

kernel_name = "hybrid_dilated_diffattn_shortconv_block"


def rms_norm(x, g, eps=NORM_EPS):
    xf = x.astype(jnp.float32)
    y = xf * lax.rsqrt(jnp.mean(xf * xf, axis=-1, keepdims=True) + eps)
    return (y * g.astype(jnp.float32)).astype(x.dtype)


def partial_rope(x, pos):
    e = x.shape[-1]
    r = e // ROPE_FRACTION
    half = r // 2
    inv = ROPE_THETA ** (-(jnp.arange(half, dtype=jnp.float32) * 2.0 / r))
    ang = pos.astype(jnp.float32)[..., None] * inv
    cos = jnp.cos(ang)[:, :, None, :]
    sin = jnp.sin(ang)[:, :, None, :]
    xr = x[..., :r].astype(jnp.float32)
    x1, x2 = xr[..., :half], xr[..., half:]
    rot = jnp.concatenate([x1 * cos - x2 * sin, x1 * sin + x2 * cos], axis=-1).astype(x.dtype)
    return jnp.concatenate([rot, x[..., r:]], axis=-1)


def causal_dwconv(x, w):
    c = x.shape[-1]
    return lax.conv_general_dilated(
        x, w.astype(x.dtype)[:, None, :], window_strides=(1,),
        padding=[(CONV_WIDTH - 1, 0)], dimension_numbers=('NWC', 'WIO', 'NWC'),
        feature_group_count=c)


def dilated_window_branch(q, k, v, window, dilation):
    b, s, h, e = q.shape
    steps = window // dilation
    L = s // dilation
    nblk = -(-L // steps)
    Lp = nblk * steps

    def to_blocks(t):
        t = t.reshape(b, L, dilation, h, t.shape[-1]).transpose(0, 2, 3, 1, 4)
        t = jnp.pad(t, ((0, 0), (0, 0), (0, 0), (0, Lp - L), (0, 0)))
        return t.reshape(b, dilation, h, nblk, steps, t.shape[-1])

    def with_prev(t):
        prev = jnp.pad(t, ((0, 0), (0, 0), (0, 0), (1, 0), (0, 0), (0, 0)))[:, :, :, :-1]
        return jnp.concatenate([prev, t], axis=4)

    qb = to_blocks(q)
    kc = with_prev(to_blocks(k))
    vc = with_prev(to_blocks(v))
    sc = jnp.einsum('brhnqe,brhnke->brhnqk', qb, kc, preferred_element_type=jnp.float32)
    qi = jnp.arange(steps)[:, None]
    kj = jnp.arange(2 * steps)[None, :]
    dist = qi + steps - kj
    key_idx = jnp.arange(nblk)[:, None, None] * steps + kj - steps
    valid = (dist >= 0) & (dist <= steps) & (key_idx >= 0)
    sc = jnp.where(valid, sc, -jnp.inf)
    m = jnp.max(sc, axis=-1, keepdims=True)
    p = jnp.exp(sc - m)
    l = jnp.sum(p, axis=-1, keepdims=True)
    o = jnp.einsum('brhnqk,brhnke->brhnqe', p, vc) / l

    def from_blocks(t):
        f = t.shape[-1]
        t = t.reshape(b, dilation, h, Lp, f)[:, :, :, :L]
        return t.transpose(0, 3, 1, 2, 4).reshape(b, s, h, f)

    return from_blocks(o), from_blocks(m), from_blocks(l)


def dilated_mixture_attention(q, k, v):
    outs = [dilated_window_branch(q, k, v, w, d) for (w, d) in DILATED_PATTERNS]
    m_all = outs[0][1]
    for _, m_i, _ in outs[1:]:
        m_all = jnp.maximum(m_all, m_i)
    num = 0.0
    den = 0.0
    for o_i, m_i, l_i in outs:
        w_i = l_i * jnp.exp(m_i - m_all)
        num = num + w_i * o_i
        den = den + w_i
    return num / den


def differential_attention(q1, q2, k1, k2, v, lam):
    b, s, h, e = q1.shape
    nqb = s // Q_BLOCK
    kpos = jnp.arange(s)

    def blocks(t):
        return t.reshape(b, nqb, Q_BLOCK, h, t.shape[-1]).transpose(1, 0, 2, 3, 4)

    def one_block(args):
        q1b, q2b, i = args
        qpos = i * Q_BLOCK + jnp.arange(Q_BLOCK)
        causal = kpos[None, :] <= qpos[:, None]

        def attn(qb, kk):
            sc = jnp.einsum('bqhe,bkhe->bhqk', qb, kk, preferred_element_type=jnp.float32)
            return jax.nn.softmax(jnp.where(causal, sc, -jnp.inf), axis=-1)

        a = attn(q1b, k1) - lam * attn(q2b, k2)
        return jnp.einsum('bhqk,bkhe->bqhe', a, v)

    o = lax.map(one_block, (blocks(q1), blocks(q2), jnp.arange(nqb)))
    return o.transpose(1, 0, 2, 3, 4).reshape(b, s, h, v.shape[-1])


def hybrid_mixer(h, pos, w_in, lq1, lk1, lq2, lk2, subln_g, conv_w, w_out, layer_idx):
    b, s, _ = h.shape
    proj = h @ w_in
    aq, ak, av, bq, bk, bv, cb, cc, ch = jnp.split(proj, SPLITS, axis=-1)
    scale = HEAD_DIM ** -0.5

    aq = partial_rope(aq.reshape(b, s, A_HEADS, HEAD_DIM), pos) * scale
    ak = partial_rope(ak.reshape(b, s, A_HEADS, HEAD_DIM), pos)
    av = av.reshape(b, s, A_HEADS, HEAD_DIM)
    o_a = dilated_mixture_attention(aq, ak, av).astype(h.dtype).reshape(b, s, A_WIDTH)

    bq = bq.reshape(b, s, B_HEADS, 2, HEAD_DIM)
    bk = bk.reshape(b, s, B_HEADS, 2, HEAD_DIM)
    q1 = partial_rope(bq[:, :, :, 0], pos) * scale
    q2 = partial_rope(bq[:, :, :, 1], pos) * scale
    k1 = partial_rope(bk[:, :, :, 0], pos)
    k2 = partial_rope(bk[:, :, :, 1], pos)
    bv = bv.reshape(b, s, B_HEADS, 2 * HEAD_DIM)
    lam_init = 0.8 - 0.6 * math.exp(-0.3 * layer_idx)
    lam = (jnp.exp(jnp.sum(lq1.astype(jnp.float32) * lk1.astype(jnp.float32)))
           - jnp.exp(jnp.sum(lq2.astype(jnp.float32) * lk2.astype(jnp.float32))) + lam_init)
    o_b = differential_attention(q1, q2, k1, k2, bv, lam)
    o_b = rms_norm(o_b, subln_g, SUBLN_EPS) * (1.0 - lam_init)
    o_b = o_b.astype(h.dtype).reshape(b, s, B_V)

    o_c = cb * causal_dwconv(cc * ch, conv_w)

    return jnp.concatenate([o_a, o_b, o_c], axis=-1) @ w_out


def conv_glu_ffn(h, w_up, conv_w, w_down):
    gu = h @ w_up
    g, u = jnp.split(gu, 2, axis=-1)
    g = causal_dwconv(g, conv_w)
    return (jax.nn.silu(g) * u) @ w_down


def setup_inputs(seed: int = 0) -> dict:
    key = jax.random.key(seed)
    ks = jax.random.split(key, 16)

    def nrm(k, shape, scale):
        return jax.random.normal(k, shape, jnp.float32) * scale

    return {
        "x": nrm(ks[0], (BATCH, SEQ, D_MODEL), 1.0),
        "positions": jnp.tile(jnp.arange(SEQ, dtype=jnp.int32)[None, :], (BATCH, 1)),
        "norm_mix_g": 1.0 + nrm(ks[1], (DEPTH, D_MODEL), 0.05),
        "w_in": nrm(ks[2], (DEPTH, D_MODEL, IN_COLS), D_MODEL ** -0.5),
        "lambda_q1": nrm(ks[3], (DEPTH, HEAD_DIM), 0.1),
        "lambda_k1": nrm(ks[4], (DEPTH, HEAD_DIM), 0.1),
        "lambda_q2": nrm(ks[5], (DEPTH, HEAD_DIM), 0.1),
        "lambda_k2": nrm(ks[6], (DEPTH, HEAD_DIM), 0.1),
        "subln_g": 1.0 + nrm(ks[7], (DEPTH, 2 * HEAD_DIM), 0.05),
        "conv_mix_w": nrm(ks[8], (DEPTH, CONV_WIDTH, C_WIDTH), CONV_WIDTH ** -0.5),
        "w_out": nrm(ks[9], (DEPTH, MIX_WIDTH, D_MODEL), MIX_WIDTH ** -0.5),
        "norm_ffn_g": 1.0 + nrm(ks[10], (DEPTH, D_MODEL), 0.05),
        "w_up": nrm(ks[11], (DEPTH, D_MODEL, 2 * D_FF), D_MODEL ** -0.5),
        "conv_ffn_w": nrm(ks[12], (DEPTH, CONV_WIDTH, D_FF), CONV_WIDTH ** -0.5),
        "w_down": nrm(ks[13], (DEPTH, D_FF, D_MODEL), D_FF ** -0.5),
        "final_g": 1.0 + nrm(ks[14], (D_MODEL,), 0.05),
    }


def reference(x, positions, norm_mix_g, w_in, lambda_q1, lambda_k1, lambda_q2, lambda_k2,
              subln_g, conv_mix_w, w_out, norm_ffn_g, w_up, conv_ffn_w, w_down, final_g):
    h = x
    for layer in range(DEPTH):
        hn = rms_norm(h, norm_mix_g[layer])
        h = h + hybrid_mixer(hn, positions, w_in[layer], lambda_q1[layer], lambda_k1[layer],
                             lambda_q2[layer], lambda_k2[layer], subln_g[layer],
                             conv_mix_w[layer], w_out[layer], layer)
        hn = rms_norm(h, norm_ffn_g[layer])
        h = h + conv_glu_ffn(hn, w_up[layer], conv_ffn_w[layer], w_down[layer])
    return rms_norm(h, final_g)
```

```cpp
#include <hip/hip_runtime.h>
#include <hip/hip_cooperative_groups.h>
#include <hip/hip_bf16.h>
#include <cstdio>
#include <cstdint>
#include <cmath>
namespace pg8 {
#define PG8_LAS __attribute__((address_space(3)))
typedef unsigned short bf16_t;
typedef short bf16x8 __attribute__((ext_vector_type(8)));
typedef float f32x4 __attribute__((ext_vector_type(4)));
typedef unsigned u32x4 __attribute__((ext_vector_type(4)));
constexpr int BM = 256, BK = 64, HALF = 128, HTB = HALF * BK * 2  , STAGE_BYTES = 8 * HTB, NXCD = 8, WGM = 16;

__host__ __device__ __forceinline__ int lds_byte(int r, int c) { const int st = (r >> 4) * 2 + (c >> 5), rr = r & 15, cc = c & 31, ob = rr * 64 + cc * 2; return st * 1024 + (ob ^ (((ob >> 9) & 1) << 5)); }
__host__ __device__ __forceinline__ void stage_rc(int b, int& R, int& C) { const int st = b / 1024, sb = b % 1024, swz = sb ^ (((sb >> 9) & 1) << 5); R = (st >> 1) * 16 + swz / 64; C = (st & 1) * 32 + (swz % 64) / 2; }
__host__ __device__ __forceinline__ int perm32(int rho) { const int n = rho >> 4, i = rho & 15; return 8 * (i >> 2) + 4 * n + (i & 3); }

struct Unit { int pm, pn; };
struct Gemm { const bf16_t* A; const bf16_t* Bt; int K; int a_rows; };

struct StaticOrder {
    int nM, nN, nwg, G, c;
    __host__ __device__ void init(int nM_, int nN_, int G_, int c_) { nM = nM_; nN = nN_; nwg = nM * nN; G = G_; c = c_; }
    __host__ __device__ bool next(int i, Unit& u) const {
        const long L = (long)i * G + c; if (L >= nwg) return false;
        int wgid = (int)L; { const int q = nwg / NXCD, r = nwg % NXCD, xcd = wgid % NXCD, off = wgid / NXCD; wgid = (xcd < r ? xcd * (q + 1) : r * (q + 1) + (xcd - r) * q) + off; }
        const int nig = WGM * nN, gid = wgid / nig, fm = gid * WGM, gsz = (nM - fm) < WGM ? (nM - fm) : WGM;
        u.pm = fm + ((wgid % nig) % gsz); u.pn = (wgid % nig) / gsz; return true;
    }
    __device__ __forceinline__ void a_ready(const Unit&) const {}
    __device__ __forceinline__ void done(const Unit&) const {}
};


__device__ __forceinline__ unsigned cvt_pk_bf16(float lo, float hi) { unsigned r; asm volatile("v_cvt_pk_bf16_f32 %0, %1, %2" : "=v"(r) : "v"(lo), "v"(hi)); return r; }
constexpr int MROWS = 16384, DMODEL = 1024;
constexpr float QK_C2 = 0.125f * 1.4426950408889634f;

__device__ __forceinline__ f32x4 rstd_load(const float* SS, int row, int fq) { return *(const f32x4*)(SS + (size_t)row * 16 + 4 * fq); }
__device__ __forceinline__ float rstd_finish(f32x4 a) {
    float s = (a[0] + a[1]) + (a[2] + a[3]);
    s += __shfl_xor(s, 16); s += __shfl_xor(s, 32);
    return __builtin_amdgcn_rsqf(s * (1.0f / 1024.0f) + 1e-6f);
}

struct NoPrep { };
struct EpiInProj {
    static constexpr bool PERM = true, AFTER_DRAIN = false, HAS_INIT = false, HAS_PREP = true;
    bf16_t* O; const float* SS; const float* rope;
    PG8_LAS float* lrstd; PG8_LAS float* lrope;
    struct Prep { f32x4 s0, s1, r0, r1; };
    static __device__ __forceinline__ bool tile_rope(int pn) { return (pn <= 1) || (pn >= 3 && pn <= 6); }
    __device__ __forceinline__ void prep_load(Prep& P, const Unit& u, int tid) const {
        asm volatile("" : "+v"(tid));
        const int row = u.pm * BM + (tid >> 1), h = tid & 1;
        const f32x4* sp = (const f32x4*)(SS + (size_t)row * 16 + 8 * h); P.s0 = sp[0]; P.s1 = sp[1];
        const f32x4* rp = (const f32x4*)(rope + (size_t)row * 16 + 8 * h); P.r0 = rp[0]; P.r1 = rp[1];
    }
    __device__ __forceinline__ void prep_store(const Prep& P, const Unit& u, int tid) const {
        asm volatile("" : "+v"(tid));
        float s = ((P.s0[0] + P.s0[1]) + (P.s0[2] + P.s0[3])) + ((P.s1[0] + P.s1[1]) + (P.s1[2] + P.s1[3]));
        s += __shfl_xor(s, 1);
        if ((tid & 1) == 0) lrstd[tid >> 1] = __builtin_amdgcn_rsqf(s * (1.0f / 1024.0f) + 1e-6f);
        PG8_LAS f32x4* d = (PG8_LAS f32x4*)(lrope + (tid >> 1) * 16 + 8 * (tid & 1)); d[0] = P.r0; d[1] = P.r1;
    }
    __device__ __forceinline__ void operator()(f32x4 (&acc)[2][2][4][2], const Unit& u, const Unit& nxt, bool has_next, int wr, int wc, int fr, int fq, int tid) const {
        Prep P;
        asm volatile("" : "+v"(fr), "+v"(fq));
        const int pn = u.pn;
        const bool is_q = (pn == 0) || (pn == 3) || (pn == 4);
        const float qs = is_q ? QK_C2 : 1.0f;
        const bool lrot = tile_rope(pn) && ((wc & 1) == 0) && fq < 2;
        const float sgn = (fq == 0) ? -1.0f : 1.0f;
        const int rl0 = wr * 64 + fr, row0 = u.pm * BM + rl0, col0 = pn * BM + wc * 32 + 8 * fq;
#pragma unroll
        for (int ai = 0; ai < 2; ++ai) {
            if (ai == 1 && has_next) prep_load(P, nxt, tid);
#pragma unroll
            for (int m = 0; m < 4; ++m) {
                const int rl = rl0 + ai * HALF + m * 16;
                const float rs = lrstd[rl] * qs;
                const PG8_LAS f32x4* rp = (const PG8_LAS f32x4*)(lrope + rl * 16);
                const f32x4 one = {1.f, 1.f, 1.f, 1.f}, zero = {0.f, 0.f, 0.f, 0.f};
                const f32x4 cs0 = lrot ? rp[0] : one, cs1 = lrot ? rp[1] : one, sn0 = lrot ? rp[2] * sgn : zero, sn1 = lrot ? rp[3] * sgn : zero;
#pragma unroll
                for (int bj = 0; bj < 2; ++bj) {
                    f32x4 v0 = acc[ai][bj][m][0] * rs, v1 = acc[ai][bj][m][1] * rs, p0, p1;
#pragma unroll
                    for (int j = 0; j < 4; ++j) { p0[j] = __shfl_xor(v0[j], 16); p1[j] = __shfl_xor(v1[j], 16); }
                    v0 = v0 * cs0 + p0 * sn0; v1 = v1 * cs1 + p1 * sn1;
                    u32x4 w; w.x = cvt_pk_bf16(v0[0], v0[1]); w.y = cvt_pk_bf16(v0[2], v0[3]); w.z = cvt_pk_bf16(v1[0], v1[1]); w.w = cvt_pk_bf16(v1[2], v1[3]);
                    *(u32x4*)(O + (size_t)(row0 + ai * HALF + m * 16) * 3072 + col0 + bj * HALF) = w;
                }
                if (m & 1) asm volatile("" ::: "memory");
            }
        }
        asm volatile("s_waitcnt lgkmcnt(0)" ::: "memory"); __builtin_amdgcn_s_barrier(); asm volatile("" ::: "memory");
        if (has_next) prep_store(P, nxt, tid);
    }
};

__device__ __forceinline__ void resid_init_load(u32x4 (&raw)[16], const bf16_t* xin, const Unit& u, int wr, int wc, int fr, int fq) {
    const int row0 = u.pm * BM + wr * 64 + fr, col0 = u.pn * BM + wc * 32 + 8 * fq;
#pragma unroll
    for (int ai = 0; ai < 2; ++ai)
#pragma unroll
        for (int m = 0; m < 4; ++m)
#pragma unroll
            for (int bj = 0; bj < 2; ++bj) raw[(ai * 4 + m) * 2 + bj] = *(const u32x4*)(xin + (size_t)(row0 + ai * HALF + m * 16) * DMODEL + col0 + bj * HALF);
}
__device__ __forceinline__ void resid_init_acc(f32x4 (&acc)[2][2][4][2], const u32x4 (&raw)[16]) {
#pragma unroll
    for (int ai = 0; ai < 2; ++ai)
#pragma unroll
        for (int m = 0; m < 4; ++m)
#pragma unroll
            for (int bj = 0; bj < 2; ++bj) { const u32x4 x = raw[(ai * 4 + m) * 2 + bj];
                acc[ai][bj][m][0] = (f32x4){__builtin_bit_cast(float, x.x << 16), __builtin_bit_cast(float, x.x & 0xffff0000u), __builtin_bit_cast(float, x.y << 16), __builtin_bit_cast(float, x.y & 0xffff0000u)};
                acc[ai][bj][m][1] = (f32x4){__builtin_bit_cast(float, x.z << 16), __builtin_bit_cast(float, x.z & 0xffff0000u), __builtin_bit_cast(float, x.w << 16), __builtin_bit_cast(float, x.w & 0xffff0000u)}; }
}

struct EpiResid {
    static constexpr bool PERM = true, AFTER_DRAIN = false, HAS_INIT = true, HAS_PREP = false;
    typedef NoPrep Prep;
    const bf16_t* xin; bf16_t* xo; float* SS;
    __device__ __forceinline__ void init_load(u32x4 (&raw)[16], const Unit& u, int wr, int wc, int fr, int fq) const { resid_init_load(raw, xin, u, wr, wc, fr, fq); }
    __device__ __forceinline__ void init_acc(f32x4 (&acc)[2][2][4][2], const u32x4 (&raw)[16]) const { resid_init_acc(acc, raw); }
    __device__ __forceinline__ void operator()(f32x4 (&acc)[2][2][4][2], const Unit& u, const Unit& nxt, bool has_next, int wr, int wc, int fr, int fq, int tid) const {
        const int row0 = u.pm * BM + wr * 64 + fr, col0 = u.pn * BM + wc * 32 + 8 * fq;
#pragma unroll
        for (int ai = 0; ai < 2; ++ai)
#pragma unroll
            for (int m = 0; m < 4; ++m) {
                const int row = row0 + ai * HALF + m * 16; float ssq = 0.f;
#pragma unroll
                for (int bj = 0; bj < 2; ++bj) {
                    const size_t off = (size_t)row * DMODEL + col0 + bj * HALF;
                    const f32x4 h0 = acc[ai][bj][m][0], h1 = acc[ai][bj][m][1];
                    u32x4 w; w.x = cvt_pk_bf16(h0[0], h0[1]); w.y = cvt_pk_bf16(h0[2], h0[3]); w.z = cvt_pk_bf16(h1[0], h1[1]); w.w = cvt_pk_bf16(h1[2], h1[3]);
                    *(u32x4*)(xo + off) = w;
                    ssq += ((h0[0] * h0[0] + h0[1] * h0[1]) + (h0[2] * h0[2] + h0[3] * h0[3])) + ((h1[0] * h1[0] + h1[1] * h1[1]) + (h1[2] * h1[2] + h1[3] * h1[3]));
                }
                ssq += __shfl_xor(ssq, 16); ssq += __shfl_xor(ssq, 32);
                if (fq == 0) SS[(size_t)row * 16 + u.pn * 4 + wc] = ssq;
            }
    }
};

struct EpiResidFinal {
    static constexpr bool PERM = true, AFTER_DRAIN = false, HAS_INIT = true, HAS_PREP = false;
    typedef NoPrep Prep;
    const bf16_t* xin; float* out; float* SS; const float* g; unsigned* cnt; PG8_LAS unsigned* flag;
    __device__ __forceinline__ void init_load(u32x4 (&raw)[16], const Unit& u, int wr, int wc, int fr, int fq) const { resid_init_load(raw, xin, u, wr, wc, fr, fq); }
    __device__ __forceinline__ void init_acc(f32x4 (&acc)[2][2][4][2], const u32x4 (&raw)[16]) const { resid_init_acc(acc, raw); }
    __device__ __forceinline__ void operator()(f32x4 (&acc)[2][2][4][2], const Unit& u, const Unit& nxt, bool has_next, int wr, int wc, int fr, int fq, int tid) const {
        const int row0 = u.pm * BM + wr * 64 + fr, col0 = u.pn * BM + wc * 32 + 8 * fq;
#pragma unroll
        for (int ai = 0; ai < 2; ++ai) {
#pragma unroll
            for (int m = 0; m < 4; ++m) {
                const int row = row0 + ai * HALF + m * 16; float ssq = 0.f;
#pragma unroll
                for (int bj = 0; bj < 2; ++bj) {
                    const f32x4 h0 = acc[ai][bj][m][0], h1 = acc[ai][bj][m][1];
                    ssq += ((h0[0] * h0[0] + h0[1] * h0[1]) + (h0[2] * h0[2] + h0[3] * h0[3])) + ((h1[0] * h1[0] + h1[1] * h1[1]) + (h1[2] * h1[2] + h1[3] * h1[3]));
                }
                ssq += __shfl_xor(ssq, 16); ssq += __shfl_xor(ssq, 32);
                if (fq == 0) __hip_atomic_store(SS + (size_t)row * 16 + u.pn * 4 + wc, ssq, __ATOMIC_RELAXED, __HIP_MEMORY_SCOPE_AGENT);
            }
        }
        asm volatile("s_waitcnt vmcnt(0)" ::: "memory");
        __builtin_amdgcn_s_barrier(); asm volatile("" ::: "memory");
        if (wr == 0 && wc == 0 && fr == 0 && fq == 0) {
            __hip_atomic_fetch_add(cnt + 64 * u.pm, 1u, __ATOMIC_RELAXED, __HIP_MEMORY_SCOPE_AGENT);
            unsigned spins = 0;
            while (__hip_atomic_load(cnt + 64 * u.pm, __ATOMIC_RELAXED, __HIP_MEMORY_SCOPE_AGENT) < 4u) { __builtin_amdgcn_s_sleep(2); if (++spins > (1u << 22)) break; }
            __builtin_amdgcn_fence(__ATOMIC_ACQUIRE, "agent");
            asm volatile("s_waitcnt vmcnt(0)" ::: "memory");
            flag[0] = 1u;
        }
        asm volatile("s_waitcnt lgkmcnt(0)" ::: "memory"); __builtin_amdgcn_s_barrier(); asm volatile("" ::: "memory");
        f32x4 part[2][4];
#pragma unroll
        for (int ai = 0; ai < 2; ++ai)
#pragma unroll
            for (int m = 0; m < 4; ++m) { float* sp = SS + (size_t)(row0 + ai * HALF + m * 16) * 16 + 4 * fq;
#pragma unroll
                for (int j = 0; j < 4; ++j) part[ai][m][j] = __hip_atomic_load(sp + j, __ATOMIC_RELAXED, __HIP_MEMORY_SCOPE_AGENT); }
        f32x4 gv[2][2];
#pragma unroll
        for (int bj = 0; bj < 2; ++bj) { gv[bj][0] = *(const f32x4*)(g + col0 + bj * HALF); gv[bj][1] = *(const f32x4*)(g + col0 + bj * HALF + 4); }
#pragma unroll
        for (int ai = 0; ai < 2; ++ai)
#pragma unroll
            for (int m = 0; m < 4; ++m) {
                const float rs = rstd_finish(part[ai][m]);
                float* rowp = out + (size_t)(row0 + ai * HALF + m * 16) * DMODEL + col0;
#pragma unroll
                for (int bj = 0; bj < 2; ++bj) { *(f32x4*)(rowp + bj * HALF) = acc[ai][bj][m][0] * rs * gv[bj][0]; *(f32x4*)(rowp + bj * HALF + 4) = acc[ai][bj][m][1] * rs * gv[bj][1]; }
            }
    }
};

template <int N> __device__ __forceinline__ float dpp_ror(float v) { return __builtin_bit_cast(float, __builtin_amdgcn_update_dpp(0, __builtin_bit_cast(int, v), 0x120 + N, 0xf, 0xf, false)); }

struct EpiGlu {
    static constexpr bool PERM = true, AFTER_DRAIN = false, HAS_INIT = false, HAS_PREP = true;
    bf16_t* ACT; const float* SS; const float* cw;
    PG8_LAS float* halo;
    PG8_LAS float* lrstd;
    PG8_LAS float* lcw;
    struct Prep { f32x4 s0, s1, w; };
    __device__ __forceinline__ void prep_load(Prep& P, const Unit& u, int tid) const {
        asm volatile("" : "+v"(tid));
        int row = u.pm * 254 - 2 + (tid >> 1); row = row < 0 ? 0 : (row >= MROWS ? MROWS - 1 : row);
        const f32x4* sp = (const f32x4*)(SS + (size_t)row * 16 + 8 * (tid & 1)); P.s0 = sp[0]; P.s1 = sp[1];
        if (tid < 96) P.w = *(const f32x4*)(cw + (tid >> 5) * 2816 + u.pn * 128 + 4 * (tid & 31));
    }
    __device__ __forceinline__ void prep_store(const Prep& P, const Unit& u, int tid) const {
        asm volatile("" : "+v"(tid));
        float s = ((P.s0[0] + P.s0[1]) + (P.s0[2] + P.s0[3])) + ((P.s1[0] + P.s1[1]) + (P.s1[2] + P.s1[3]));
        s += __shfl_xor(s, 1);
        if ((tid & 1) == 0) lrstd[tid >> 1] = __builtin_amdgcn_rsqf(s * (1.0f / 1024.0f) + 1e-6f);
        if (tid < 96) *(PG8_LAS f32x4*)(lcw + 4 * tid) = P.w;
    }
    __device__ __forceinline__ void operator()(f32x4 (&acc)[2][2][4][2], const Unit& u, const Unit& nxt, bool has_next, int wr, int wc, int fr, int fq, int tid) const {
        const int lane = fr + 16 * fq;
        const int grow0 = u.pm * 254 - 2;
        const int cl = wc * 32 + 8 * fq;
        const int hcol = u.pn * 128 + cl;
#pragma unroll
        for (int ai = 0; ai < 2; ++ai)
#pragma unroll
            for (int m = 0; m < 4; ++m) {
                const float rs = lrstd[ai * HALF + wr * 64 + m * 16 + fr];
#pragma unroll
                for (int bj = 0; bj < 2; ++bj) { acc[ai][bj][m][0] = acc[ai][bj][m][0] * rs; acc[ai][bj][m][1] = acc[ai][bj][m][1] * rs; }
            }
        const f32x4 w0a = *(const PG8_LAS f32x4*)(lcw + cl), w0b = *(const PG8_LAS f32x4*)(lcw + cl + 4);
        const f32x4 w1a = *(const PG8_LAS f32x4*)(lcw + 128 + cl), w1b = *(const PG8_LAS f32x4*)(lcw + 128 + cl + 4);
        const f32x4 w2a = *(const PG8_LAS f32x4*)(lcw + 256 + cl), w2b = *(const PG8_LAS f32x4*)(lcw + 256 + cl + 4);
        if (fr >= 14) {
#pragma unroll
            for (int ai = 0; ai < 2; ++ai) { PG8_LAS float* hp = halo + ((2 * ai + wr) * 2 + (fr - 14)) * 128 + cl;
                *(PG8_LAS f32x4*)hp = acc[ai][0][3][0]; *(PG8_LAS f32x4*)(hp + 4) = acc[ai][0][3][1]; }
        }
        asm volatile("s_waitcnt lgkmcnt(0)" ::: "memory"); __builtin_amdgcn_s_barrier(); asm volatile("" ::: "memory");
        Prep P;
#pragma unroll
        for (int ai = 0; ai < 2; ++ai) {
            if (ai == 1 && has_next) prep_load(P, nxt, tid);
            const int q = 2 * ai + wr;
            f32x4 pv0 = {0.f, 0.f, 0.f, 0.f}, pv1 = pv0;
            if (fr >= 14 && q > 0) { const PG8_LAS float* hp = halo + ((q - 1) * 2 + (fr - 14)) * 128 + cl; pv0 = *(const PG8_LAS f32x4*)hp; pv1 = *(const PG8_LAS f32x4*)(hp + 4); }
#pragma unroll
            for (int m = 0; m < 4; ++m) {
                const int rl = ai * HALF + wr * 64 + m * 16 + fr, grow = grow0 + rl;
                const int tpos = grow & 2047;
                const f32x4 gp0 = (m == 0) ? pv0 : acc[ai][0][m - 1][0], gp1 = (m == 0) ? pv1 : acc[ai][0][m - 1][1];
                f32x4 r0, r1;
#pragma unroll
                for (int j = 0; j < 4; ++j) {
                    { const float cur = acc[ai][0][m][0][j];
                      float p1 = dpp_ror<1>((fr == 15) ? gp0[j] : cur), p2 = dpp_ror<2>((fr >= 14) ? gp0[j] : cur);
                      if (tpos < 1) p1 = 0.f; if (tpos < 2) p2 = 0.f;
                      const float cv = w0a[j] * p2 + w1a[j] * p1 + w2a[j] * cur;
                      r0[j] = cv * __builtin_amdgcn_rcpf(1.0f + __builtin_amdgcn_exp2f(-1.4426950408889634f * cv)) * acc[ai][1][m][0][j]; }
                    { const float cur = acc[ai][0][m][1][j];
                      float p1 = dpp_ror<1>((fr == 15) ? gp1[j] : cur), p2 = dpp_ror<2>((fr >= 14) ? gp1[j] : cur);
                      if (tpos < 1) p1 = 0.f; if (tpos < 2) p2 = 0.f;
                      const float cv = w0b[j] * p2 + w1b[j] * p1 + w2b[j] * cur;
                      r1[j] = cv * __builtin_amdgcn_rcpf(1.0f + __builtin_amdgcn_exp2f(-1.4426950408889634f * cv)) * acc[ai][1][m][1][j]; }
                }
                if (rl >= 2 && grow < MROWS) {
                    u32x4 w; w.x = cvt_pk_bf16(r0[0], r0[1]); w.y = cvt_pk_bf16(r0[2], r0[3]); w.z = cvt_pk_bf16(r1[0], r1[1]); w.w = cvt_pk_bf16(r1[2], r1[3]);
                    *(u32x4*)(ACT + (size_t)grow * 2816 + hcol) = w;
                }
            }
        }
        if (has_next) prep_store(P, nxt, tid);
    }
};
template <class Epi, class Sched, bool ALIGN_EPI = false, bool SP2 = false>
__device__ __forceinline__ void gemm_phase(PG8_LAS unsigned char* lds, const Gemm g, const Sched& S, const Epi& E) {
    int tid_ = threadIdx.x; asm volatile("" : "+v"(tid_));
    const int tid = tid_, wid = __builtin_amdgcn_readfirstlane(tid >> 6), lane = tid & 63, wr = wid >> 2, wc = wid & 3, fr = lane & 15, fq = lane >> 4;
    const int K = g.K, nt = K / BK;
    unsigned voffA[2], voffB[2];
#pragma unroll
    for (int i = 0; i < 2; ++i) { int R, C; stage_rc(tid * 16 + i * 8192, R, C); const int Rb = Epi::PERM ? ((R & ~31) + perm32(R & 31)) : R;
        voffA[i] = (unsigned)(R * K + C) * 2u; voffB[i] = (unsigned)(Rb * K + C) * 2u; }
    const size_t kstep = (size_t)(BK * 2);
    const size_t hstep = (size_t)HALF * K * 2;
    const size_t tstep = 2 * hstep;
    const size_t tstepA = (size_t)g.a_rows * K * 2;
    const unsigned ldsw = (unsigned)wid * 1024u;
    const int aoff = lds_byte(wr * 64 + fr, fq * 8), boff = lds_byte(wc * 32 + fr, fq * 8);
#define PG8_SA(b, h) (((b) * 2 + (h)) * HTB)
#define PG8_SB(b, h) ((4 + (b) * 2 + (h)) * HTB)
#define PG8_STAGE(bufoff, gbase, voff) do { _Pragma("unroll") for (int _i = 0; _i < 2; ++_i) \
        __builtin_amdgcn_global_load_lds((const unsigned*)((const char*)(gbase) + (voff)[_i]), (PG8_LAS unsigned*)(lds + (bufoff) + ldsw + _i * 8192), 16, 0, 0); } while (0)
#define PG8_LDA(dst, b, h) do { _Pragma("unroll") for (int m = 0; m < 4; ++m) _Pragma("unroll") for (int k = 0; k < 2; ++k) dst[m][k] = *(const PG8_LAS bf16x8*)(lds + PG8_SA(b, h) + aoff + m * 2048 + k * 1024); } while (0)
#define PG8_LDB(dst, b, h) do { _Pragma("unroll") for (int n = 0; n < 2; ++n) _Pragma("unroll") for (int k = 0; k < 2; ++k) dst[n][k] = *(const PG8_LAS bf16x8*)(lds + PG8_SB(b, h) + boff + n * 2048 + k * 1024); } while (0)
#define PG8_MMA(ai, bj, At, Bt) do { __builtin_amdgcn_s_setprio(1); _Pragma("unroll") for (int m = 0; m < 4; ++m) _Pragma("unroll") for (int n = 0; n < 2; ++n) _Pragma("unroll") for (int k = 0; k < 2; ++k) \
        acc[ai][bj][m][n] = __builtin_amdgcn_mfma_f32_16x16x32_bf16(Bt[n][k], At[m][k], acc[ai][bj][m][n], 0, 0, 0); __builtin_amdgcn_s_setprio(0); } while (0)
#define PG8_WAIT_V(n) asm volatile("s_waitcnt vmcnt(" #n ")" ::: "memory")
#define PG8_WAIT_L(n) asm volatile("s_waitcnt lgkmcnt(" #n ")" ::: "memory")
#define PG8_BAR __builtin_amdgcn_s_barrier()
#define PG8_SCHED __builtin_amdgcn_sched_barrier(0)
    Unit cur, nxt; int ui = 0;
    if (!S.next(0, cur)) return;
    f32x4 acc[2][2][4][2];
    u32x4 iraw[Epi::HAS_INIT ? 16 : 1];
    if constexpr (Epi::HAS_INIT) E.init_load(iraw, cur, wr, wc, fr, fq);
    typename Epi::Prep prep;
    if constexpr (Epi::HAS_PREP) E.prep_load(prep, cur, tid);
    bf16x8 At[4][2], B0[2][2], B1[2][2];
    const char* cA = (const char*)g.A + (size_t)cur.pm * tstepA; const char* cB = (const char*)g.Bt + (size_t)cur.pn * tstep;
    S.a_ready(cur);
    if constexpr (SP2) {
        PG8_STAGE(PG8_SB(0, 0), cB, voffB); PG8_STAGE(PG8_SB(0, 1), cB + hstep, voffB); PG8_STAGE(PG8_SA(0, 0), cA, voffA); PG8_STAGE(PG8_SA(0, 1), cA + hstep, voffA);
        if (wr == 1) PG8_BAR;
        PG8_WAIT_V(2); PG8_BAR;
        PG8_STAGE(PG8_SB(1, 0), cB + kstep, voffB); PG8_STAGE(PG8_SA(1, 0), cA + kstep, voffA); PG8_STAGE(PG8_SB(1, 1), cB + hstep + kstep, voffB);
        PG8_WAIT_V(6); PG8_BAR;
    } else {
        PG8_STAGE(PG8_SB(0, 0), cB, voffB); PG8_STAGE(PG8_SA(0, 0), cA, voffA); PG8_STAGE(PG8_SB(0, 1), cB + hstep, voffB); PG8_STAGE(PG8_SA(0, 1), cA + hstep, voffA);
        if (wr == 1) PG8_BAR;
        PG8_WAIT_V(4); PG8_BAR;
        PG8_STAGE(PG8_SB(1, 0), cB + kstep, voffB); PG8_STAGE(PG8_SA(1, 0), cA + kstep, voffA); PG8_STAGE(PG8_SB(1, 1), cB + hstep + kstep, voffB);
        PG8_WAIT_V(6); PG8_BAR;
    }
    if constexpr (Epi::HAS_PREP) E.prep_store(prep, cur, tid);
    if constexpr (Epi::HAS_INIT) { E.init_acc(acc, iraw); }
    else {
#pragma unroll
        for (int a = 0; a < 2; ++a)
#pragma unroll
            for (int b = 0; b < 2; ++b)
#pragma unroll
                for (int m = 0; m < 4; ++m)
#pragma unroll
                    for (int n = 0; n < 2; ++n) acc[a][b][m][n] = (f32x4){0.f, 0.f, 0.f, 0.f};
    }
    for (;;) {
        const bool has_next = S.next(ui + 1, nxt);
        const char* nA = has_next ? (const char*)g.A + (size_t)nxt.pm * tstepA : cA; const char* nB = has_next ? (const char*)g.Bt + (size_t)nxt.pn * tstep : cB;
        for (int t = 0; t < nt; t += 2) {
            const bool last = (t == nt - 2);
            const char* a1 = cA + (size_t)(t + 1) * kstep;
            const char* a2 = last ? nA : cA + (size_t)(t + 2) * kstep; const char* b2 = last ? nB : cB + (size_t)(t + 2) * kstep;
            const char* a3 = a2 + kstep; const char* b3 = b2 + kstep;
            if (last && has_next) S.a_ready(nxt);
            if constexpr (SP2) {
            PG8_LDB(B0, 0, 0); PG8_LDB(B1, 0, 1); PG8_SCHED; PG8_LDA(At, 0, 0); PG8_STAGE(PG8_SA(1, 1), a1 + hstep, voffA);
            PG8_WAIT_V(8); PG8_WAIT_L(0); PG8_BAR; PG8_MMA(0, 0, At, B0); PG8_MMA(0, 1, At, B1); PG8_BAR; PG8_SCHED;
            PG8_LDA(At, 0, 1); PG8_STAGE(PG8_SB(0, 0), b2, voffB); PG8_STAGE(PG8_SB(0, 1), b2 + hstep, voffB); PG8_STAGE(PG8_SA(0, 0), a2, voffA);
            PG8_WAIT_V(8); PG8_WAIT_L(0); PG8_BAR; PG8_MMA(1, 0, At, B0); PG8_MMA(1, 1, At, B1); PG8_BAR; PG8_SCHED;
            PG8_LDB(B0, 1, 0); PG8_LDB(B1, 1, 1); PG8_SCHED; PG8_LDA(At, 1, 0); PG8_STAGE(PG8_SA(0, 1), a2 + hstep, voffA);
            PG8_WAIT_V(8); PG8_WAIT_L(0); PG8_BAR; PG8_MMA(0, 0, At, B0); PG8_MMA(0, 1, At, B1); PG8_BAR; PG8_SCHED;
            PG8_LDA(At, 1, 1); PG8_STAGE(PG8_SB(1, 0), b3, voffB); PG8_STAGE(PG8_SB(1, 1), b3 + hstep, voffB); PG8_STAGE(PG8_SA(1, 0), a3, voffA);
            PG8_WAIT_V(8); PG8_WAIT_L(0); PG8_BAR; PG8_MMA(1, 0, At, B0); PG8_MMA(1, 1, At, B1); PG8_BAR; PG8_SCHED;
            } else {
            PG8_LDB(B0, 0, 0); PG8_SCHED; PG8_LDA(At, 0, 0); PG8_STAGE(PG8_SA(1, 1), a1 + hstep, voffA);
            PG8_WAIT_L(8); PG8_BAR; PG8_WAIT_L(0); PG8_MMA(0, 0, At, B0); PG8_BAR; PG8_SCHED;
            PG8_LDB(B1, 0, 1); PG8_STAGE(PG8_SB(0, 0), b2, voffB);
            PG8_BAR; PG8_WAIT_L(0); PG8_MMA(0, 1, At, B1); PG8_BAR;
            PG8_LDA(At, 0, 1); PG8_STAGE(PG8_SA(0, 0), a2, voffA);
            PG8_BAR; PG8_WAIT_L(0); PG8_MMA(1, 0, At, B0); PG8_BAR; PG8_SCHED;
            PG8_STAGE(PG8_SB(0, 1), b2 + hstep, voffB);
            PG8_WAIT_V(6); PG8_BAR; PG8_MMA(1, 1, At, B1); PG8_BAR;
            PG8_LDB(B0, 1, 0); PG8_SCHED; PG8_LDA(At, 1, 0); PG8_STAGE(PG8_SA(0, 1), a2 + hstep, voffA);
            PG8_WAIT_L(8); PG8_BAR; PG8_WAIT_L(0); PG8_MMA(0, 0, At, B0); PG8_BAR; PG8_SCHED;
            PG8_LDB(B1, 1, 1); PG8_STAGE(PG8_SB(1, 0), b3, voffB);
            PG8_BAR; PG8_WAIT_L(0); PG8_MMA(0, 1, At, B1); PG8_BAR;
            PG8_LDA(At, 1, 1); PG8_STAGE(PG8_SA(1, 0), a3, voffA);
            PG8_BAR; PG8_WAIT_L(0); PG8_MMA(1, 0, At, B0); PG8_BAR; PG8_SCHED;
            PG8_STAGE(PG8_SB(1, 1), b3 + hstep, voffB);
            PG8_WAIT_V(6); PG8_BAR; PG8_MMA(1, 1, At, B1); PG8_BAR;
            }
        }
        if constexpr (ALIGN_EPI) { if (wr == 0) PG8_BAR; }
        if constexpr (!Epi::AFTER_DRAIN) { E(acc, cur, nxt, has_next, wr, wc, fr, fq, tid); S.done(cur); }
        if (!has_next) break;
        if constexpr (Epi::HAS_INIT) { E.init_load(iraw, nxt, wr, wc, fr, fq); E.init_acc(acc, iraw); }
        else {
#pragma unroll
        for (int a = 0; a < 2; ++a)
#pragma unroll
            for (int b = 0; b < 2; ++b)
#pragma unroll
                for (int m = 0; m < 4; ++m)
#pragma unroll
                    for (int n = 0; n < 2; ++n) acc[a][b][m][n] = (f32x4){0.f, 0.f, 0.f, 0.f};
        }
        cur = nxt; cA = nA; cB = nB; ++ui;
        if constexpr (ALIGN_EPI) { if (wr == 1) PG8_BAR; }
    }
    PG8_WAIT_V(0);
    if constexpr (!ALIGN_EPI) { if (wr == 0) PG8_BAR; }
    PG8_BAR;
    if constexpr (Epi::AFTER_DRAIN) { E.fused(acc, cur, wr, wc, fr, fq, lds, wid, lane); S.done(cur); }
#undef PG8_SA
#undef PG8_SB
#undef PG8_STAGE
#undef PG8_LDA
#undef PG8_LDB
#undef PG8_MMA
#undef PG8_WAIT_V
#undef PG8_WAIT_L
#undef PG8_BAR
#undef PG8_SCHED
}
}
namespace attn_body {
using bf16=__hip_bfloat16;
using bf16x8=__attribute__((ext_vector_type(8)))short;
using s16x4=__attribute__((ext_vector_type(4)))short;
using f32x16=__attribute__((ext_vector_type(16)))float;
using u32x4=__attribute__((ext_vector_type(4)))unsigned;
constexpr int BATCH=8,SEQ=2048,D=64,DM=3072;
constexpr int NW=8,QBLK=32,QB=QBLK*NW,KVBLK=64,NQB=SEQ/QB;
constexpr int ATTN_UNIT_ROWS=QB;
__device__ __forceinline__ int crow(int r,int hi){return (r&3)+8*(r>>2)+4*hi;}
#define SBAR() __builtin_amdgcn_sched_barrier(0)
__device__ __forceinline__ void cmask(f32x16&p0,f32x16&p1,int jb,int qrel,int hi){
  const float NEG=-INFINITY; int kb=64*jb+4*hi;
  #pragma unroll
  for(int r=0;r<16;++r){int kv=kb+(r&3)+8*(r>>2); if(kv>qrel)p0[r]=NEG; if(kv+32>qrel)p1[r]=NEG;}
}

__device__ __forceinline__ float dwl(int d){
  const int w=(int)(d<=128)+(int)(((d&3)==0)&&(d<=512))+(int)((d&15)==0);
  const float a=(w==0)?-INFINITY:(w==1)?0.f:(w==2)?1.f:1.5849625007f;
  return d<0?-INFINITY:a;
}
typedef __attribute__((address_space(3))) const float* ldsf_cptr;
typedef float f32x2m __attribute__((ext_vector_type(2)));
constexpr int DMASK_TBL_N=2368;
#define DMASK_BATCH(o_) asm volatile("ds_read2_b32 %0, %8 offset0:" #o_ "+0 offset1:" #o_ "+1\n\tds_read2_b32 %1, %8 offset0:" #o_ "+2 offset1:" #o_ "+3\n\t" \
      "ds_read2_b32 %2, %8 offset0:" #o_ "+8 offset1:" #o_ "+9\n\tds_read2_b32 %3, %8 offset0:" #o_ "+10 offset1:" #o_ "+11\n\t" \
      "ds_read2_b32 %4, %8 offset0:" #o_ "+16 offset1:" #o_ "+17\n\tds_read2_b32 %5, %8 offset0:" #o_ "+18 offset1:" #o_ "+19\n\t" \
      "ds_read2_b32 %6, %8 offset0:" #o_ "+24 offset1:" #o_ "+25\n\tds_read2_b32 %7, %8 offset0:" #o_ "+26 offset1:" #o_ "+27\n\ts_waitcnt lgkmcnt(0)" \
      :"=&v"(t0),"=&v"(t1),"=&v"(t2),"=&v"(t3),"=&v"(t4),"=&v"(t5),"=&v"(t6),"=&v"(t7):"v"(a):"memory")
__device__ __forceinline__ void dmask(f32x16&p0,f32x16&p1,int base,unsigned tbl_addr){
  const unsigned a=tbl_addr+(unsigned)(2047-base)*4u;
  f32x2m t0,t1,t2,t3,t4,t5,t6,t7;
  DMASK_BATCH(0);
  p0[0]+=t0.x;p0[1]+=t0.y;p0[2]+=t1.x;p0[3]+=t1.y;p0[4]+=t2.x;p0[5]+=t2.y;p0[6]+=t3.x;p0[7]+=t3.y;
  p0[8]+=t4.x;p0[9]+=t4.y;p0[10]+=t5.x;p0[11]+=t5.y;p0[12]+=t6.x;p0[13]+=t6.y;p0[14]+=t7.x;p0[15]+=t7.y;
  DMASK_BATCH(32);
  p1[0]+=t0.x;p1[1]+=t0.y;p1[2]+=t1.x;p1[3]+=t1.y;p1[4]+=t2.x;p1[5]+=t2.y;p1[6]+=t3.x;p1[7]+=t3.y;
  p1[8]+=t4.x;p1[9]+=t4.y;p1[10]+=t5.x;p1[11]+=t5.y;p1[12]+=t6.x;p1[13]+=t6.y;p1[14]+=t7.x;p1[15]+=t7.y;
}

constexpr int NSLOT=3, SLOTB=8192;
constexpr int LDS_K=0, LDS_V=NSLOT*SLOTB, LDS_WS=2*NSLOT*SLOTB, LDS_OST=LDS_WS+NW*64*4, LDS_BYTES=LDS_OST+NW*4096;
constexpr float C2=0.125f*1.4426950408889634f;
__device__ __forceinline__ void glds16(const void*gsrc,unsigned lds_dst){unsigned keep;
  asm volatile("s_mov_b32 %0, m0\n\ts_mov_b32 m0, %2\n\ts_nop 0\n\tglobal_load_lds_dwordx4 %1, off\n\ts_mov_b32 m0, %0":"=&s"(keep):"v"(gsrc),"s"(lds_dst):"memory");}
__device__ __forceinline__ float max3f(float a,float b,float c){float r;asm("v_max3_f32 %0, %1, %2, %3":"=v"(r):"v"(a),"v"(b),"v"(c));return r;}
__device__ __forceinline__ float max2f(float a,float b){float r;asm("v_max_f32_e32 %0, %1, %2":"=v"(r):"v"(a),"v"(b));return r;}
__device__ __forceinline__ float fadd_s(float a,float b){float r;asm("v_add_f32_e32 %0, %1, %2":"=v"(r):"v"(a),"v"(b));return r;}
__device__ __forceinline__ float fsub_s(float a,float b){float r;asm("v_sub_f32_e32 %0, %1, %2":"=v"(r):"v"(a),"v"(b));return r;}
typedef float f32x2_t __attribute__((ext_vector_type(2))); typedef __bf16 bf16x2_t __attribute__((ext_vector_type(2)));
__device__ __forceinline__ unsigned cvtpk_s(float lo,float hi){f32x2_t v={lo,hi};bf16x2_t b=__builtin_convertvector(v,bf16x2_t);return __builtin_bit_cast(unsigned,b);}
#define WAIT_BAR(N) asm volatile("s_waitcnt vmcnt(" #N ") lgkmcnt(0)\n\ts_barrier":::"memory")

__device__ __forceinline__ void qkt(f32x16&p0,f32x16&p1,const char*Kslot,const bf16x8*qr,const f32x16&negm,int r32,int hi){
  const char*kb=Kslot+hi*1024+r32*16;
  #pragma unroll
  for(int d0=0;d0<4;++d0){
    const bf16x8 b0=*reinterpret_cast<const bf16x8*>(kb+d0*2048);
    const bf16x8 b1=*reinterpret_cast<const bf16x8*>(kb+d0*2048+512);
    if(d0==0){p0=__builtin_amdgcn_mfma_f32_32x32x16_bf16(b0,qr[0],negm,0,0,0);p1=__builtin_amdgcn_mfma_f32_32x32x16_bf16(b1,qr[0],negm,0,0,0);}
    else{p0=__builtin_amdgcn_mfma_f32_32x32x16_bf16(b0,qr[d0],p0,0,0,0);p1=__builtin_amdgcn_mfma_f32_32x32x16_bf16(b1,qr[d0],p1,0,0,0);}}
}
typedef __attribute__((address_space(3))) const char* lds_cptr;
typedef short v4i16_t __attribute__((ext_vector_type(4)));
__device__ __forceinline__ void kload8(bf16x8*kf,lds_cptr kp){
  kf[0]=*(const __attribute__((address_space(3))) bf16x8*)(kp);      kf[1]=*(const __attribute__((address_space(3))) bf16x8*)(kp+512);
  kf[2]=*(const __attribute__((address_space(3))) bf16x8*)(kp+2048); kf[3]=*(const __attribute__((address_space(3))) bf16x8*)(kp+2560);
  kf[4]=*(const __attribute__((address_space(3))) bf16x8*)(kp+4096); kf[5]=*(const __attribute__((address_space(3))) bf16x8*)(kp+4608);
  kf[6]=*(const __attribute__((address_space(3))) bf16x8*)(kp+6144); kf[7]=*(const __attribute__((address_space(3))) bf16x8*)(kp+6656);
}
__device__ __forceinline__ void kload2(bf16x8*kf,lds_cptr kp,int j){ kf[2*j]=*(const __attribute__((address_space(3))) bf16x8*)(kp+j*2048); kf[2*j+1]=*(const __attribute__((address_space(3))) bf16x8*)(kp+j*2048+512); }
__device__ __forceinline__ s16x4 vtr(lds_cptr p){ return __builtin_bit_cast(s16x4,__builtin_amdgcn_ds_read_tr16_b64_v4i16((__attribute__((address_space(3))) v4i16_t*)p)); }
__device__ __forceinline__ float rowmax(const f32x16&p0,const f32x16&p1){
  float a=max3f(p0[0],p0[1],p1[0]),b=max3f(p0[2],p0[3],p1[1]);a=max3f(a,p1[2],p1[3]);
  #pragma unroll
  for(int r=4;r<16;r+=4){a=max3f(a,p0[r],p0[r+1]);b=max3f(b,p0[r+2],p0[r+3]);a=max3f(a,p1[r],p1[r+1]);b=max3f(b,p1[r+2],p1[r+3]);}
  const float m=max2f(a,b);
  auto rr=__builtin_amdgcn_permlane32_swap(__float_as_uint(m),__float_as_uint(m),false,false);
  return max2f(__uint_as_float(rr[0]),__uint_as_float(rr[1]));
}
__device__ __forceinline__ void pv(f32x16*o,int vb,bf16x8 pa0,bf16x8 pa1,bf16x8 pa2,bf16x8 pa3){
  #pragma unroll
  for(int d0=0;d0<2;++d0){s16x4 lo[4],hi[4];
    #pragma unroll
    for(int ks=0;ks<4;++ks){
      asm volatile("ds_read_b64_tr_b16 %0,%1 offset:%c2":"=&v"(lo[ks]):"v"(vb),"i"(d0*4096+ks*1024):"memory");
      asm volatile("ds_read_b64_tr_b16 %0,%1 offset:%c2":"=&v"(hi[ks]):"v"(vb),"i"(d0*4096+ks*1024+512):"memory");}
    asm volatile("s_waitcnt lgkmcnt(0)":::"memory");SBAR();
    #define PK(k) (bf16x8){lo[k][0],lo[k][1],lo[k][2],lo[k][3],hi[k][0],hi[k][1],hi[k][2],hi[k][3]}
    o[d0]=__builtin_amdgcn_mfma_f32_32x32x16_bf16(pa0,PK(0),o[d0],0,0,0);
    o[d0]=__builtin_amdgcn_mfma_f32_32x32x16_bf16(pa1,PK(1),o[d0],0,0,0);
    o[d0]=__builtin_amdgcn_mfma_f32_32x32x16_bf16(pa2,PK(2),o[d0],0,0,0);
    o[d0]=__builtin_amdgcn_mfma_f32_32x32x16_bf16(pa3,PK(3),o[d0],0,0,0);
    #undef PK
  }
}

#ifndef ATTN_STORE16
#define ATTN_STORE16(p,v) (*(u32x4*)(p)=(v))
#endif
template<int THRL,int MODE> __device__ __forceinline__ void attn_unit(int b,int qb,const bf16*Q,const bf16*__restrict__ K,const bf16*__restrict__ V,bf16*O,int opitch,char*shm,unsigned tbl){
  int tid_=threadIdx.x; asm volatile("":"+v"(tid_));
  const int tid=tid_,lane=tid&63,r32=lane&31,hi=lane>>5; const int wid=__builtin_amdgcn_readfirstlane(tid>>6);
  const long rowbase=(long)b*SEQ; const int q0=qb*QB;
  const bf16*Qw=Q+(rowbase+q0+wid*QBLK)*DM;
  const bf16*Kh=K+rowbase*DM,*Vh=V+rowbase*DM;
  const unsigned lds0=(unsigned)(uintptr_t)shm;
  float*wsf=(float*)(shm+LDS_WS)+wid*64;
  const bf16*ksrc=Kh+(long)lane*DM+wid*8;
  const bf16*vsrc=Vh+(long)(16*(wid&3)+(lane>>2))*DM+(wid>>2)*32+(lane&3)*8;
  const unsigned kdst=lds0+LDS_K+wid*1024, vdst=lds0+LDS_V+wid*1024;
  #define DMA_K(t,slot) glds16(ksrc+(long)(t)*KVBLK*DM,(unsigned)__builtin_amdgcn_readfirstlane(kdst+(slot)))
  #define DMA_V(t,slot) glds16(vsrc+(long)(t)*KVBLK*DM,(unsigned)__builtin_amdgcn_readfirstlane(vdst+(slot)))
  const int vb0=(int)(lds0+LDS_V)+((lane>>4)&1)*32+(lane&3)*8+(4*hi+((lane&15)>>2))*64;
  const char*Kbase=shm+LDS_K; bf16x8 kf[8];
  const lds_cptr shm3=(lds_cptr)shm; const lds_cptr kp0=shm3+LDS_K+hi*1024+r32*16; const lds_cptr vp0=shm3+LDS_V+((lane>>4)&1)*32+(lane&3)*8+(4*hi+((lane&15)>>2))*64;
  const int NT=(q0+QB)/KVBLK;
  DMA_K(0,0);DMA_V(0,0);DMA_K(1,SLOTB);
  bf16x8 qr[4];
  #pragma unroll
  for(int d0=0;d0<4;++d0)qr[d0]=*reinterpret_cast<const bf16x8*>(&Qw[(long)r32*DM+d0*16+hi*8]);
  float mhat=0.f,l_reg=0.f;f32x16 o[2];o[0]=f32x16{};o[1]=f32x16{};f32x16 negm=f32x16{};asm volatile("":"+v"(negm));
  const int qrel=wid*QBLK+r32;
  #define CMASK(P0,P1,t) do{ if constexpr(MODE==0){int jb_=(t)-(NT-4); if(jb_>=0)cmask(P0,P1,jb_,qrel,hi);} else if constexpr(MODE==1) { dmask(P0,P1,q0+qrel-64*(t)-4*hi,tbl); } }while(0)
  bool resc=false;
  #define START(P0,P1) do{ const float rm=rowmax(P0,P1); resc=false; \
    { const float dl=rm; mhat=fadd_s(mhat,dl); \
      _Pragma("unroll") for(int r=0;r<16;++r){P0[r]=fsub_s(P0[r],dl);P1[r]=fsub_s(P1[r],dl);} \
      _Pragma("unroll") for(int r=0;r<16;++r)negm[r]=-mhat; asm volatile("":"+v"(negm)); } \
    _Pragma("unroll") for(int r=0;r<16;++r)P0[r]=__builtin_amdgcn_exp2f(P0[r]); }while(0)
  #define RESC() do{ if(resc){ asm volatile("s_waitcnt lgkmcnt(0)":::"memory"); \
      _Pragma("unroll") for(int d_=0;d_<2;++d_) _Pragma("unroll") for(int r=0;r<16;++r)o[d_][r]*=wsf[crow(r,hi)]; } }while(0)
  f32x16 pA0,pA1,pB0,pB1;
  int sl_prev=0,sl_cur=0,sl_next=SLOTB;
  #define ROT() do{sl_prev=sl_cur;sl_cur=sl_next;sl_next=(sl_next==(NSLOT-1)*SLOTB)?0:sl_next+SLOTB;}while(0)
  DMA_K(2,2*SLOTB);
  WAIT_BAR(3);
  qkt(pA0,pA1,Kbase,qr,negm,r32,hi);asm volatile("s_nop 15\n\ts_nop 7":"+v"(pA0),"+v"(pA1));CMASK(pA0,pA1,0);
  START(pA0,pA1);
  _Pragma("unroll") for(int r=0;r<16;++r)pA1[r]=__builtin_amdgcn_exp2f(pA1[r]);
  WAIT_BAR(0);
  DMA_K(3,0);DMA_V(1,SLOTB);
  ROT();
  kload8(kf,kp0+sl_cur);
  WAIT_BAR(2);
  s16x4 vlo[8],vhi[8]; u32x4 pw0,pw1,pw2,pw3;
  #define PKW(P,B) cvtpk_s(P[B],P[B+1])
  #define PAF(k) __builtin_bit_cast(bf16x8,pw##k)
  #define VFR(i) (bf16x8){vlo[i][0],vlo[i][1],vlo[i][2],vlo[i][3],vhi[i][0],vhi[i][1],vhi[i][2],vhi[i][3]}
  #define PIN(x) asm volatile("":"+v"(x))
  #define MX3(a,b,c) __builtin_fmaxf(__builtin_fmaxf((a),(b)),(c))
  #define GAPA(MF,A0,A1,A2,A3,W0,W1,PW) do{ MF; sacc+=A0; sacc+=A1; sacc+=A2; sacc+=A3; PIN(sacc); W0; W1; PIN(PW); SBAR(); }while(0)
  #define EX(v) __builtin_amdgcn_exp2f(v)
  #define GAPB(MF,X,B) do{ MF; X[B]=EX(X[B]); X[B+1]=EX(X[B+1]); X[B+2]=EX(X[B+2]); X[B+3]=EX(X[B+3]); PIN(X); SBAR(); }while(0)
  #define VRD(i) do{ vlo[i]=vtr(vp_+(((i)>>2)*4096+((i)&3)*1024)); vhi[i]=vtr(vp_+(((i)>>2)*4096+((i)&3)*1024+512)); }while(0)
  #define KRD(G,j) do{ if(G){ kload2(kf,kp0+sl_next,j); SBAR(); } }while(0)
  #define STEP(C0,C1,P0,P1,t,GK,GV,GL) do{ SBAR(); \
    const lds_cptr vp_=vp0+sl_prev; \
    VRD(0); SBAR(); float sacc=(P0[0]+P0[1]); \
    GAPA(C0=__builtin_amdgcn_mfma_f32_32x32x16_bf16(kf[0],qr[0],negm,0,0,0), P0[2],P0[3],P0[4],P0[5],     pw0[0]=PKW(P0,0), pw0[1]=PKW(P0,2), pw0); \
    VRD(4); SBAR(); GAPA(C1=__builtin_amdgcn_mfma_f32_32x32x16_bf16(kf[1],qr[0],negm,0,0,0), P0[6],P0[7],P0[8],P0[9],     pw0[2]=PKW(P0,4), pw0[3]=PKW(P0,6), pw0); \
    VRD(1); SBAR(); GAPA(C0=__builtin_amdgcn_mfma_f32_32x32x16_bf16(kf[2],qr[1],C0,0,0,0),   P0[10],P0[11],P0[12],P0[13], pw1[0]=PKW(P0,8), pw1[1]=PKW(P0,10), pw1); \
    VRD(5); SBAR(); GAPA(C1=__builtin_amdgcn_mfma_f32_32x32x16_bf16(kf[3],qr[1],C1,0,0,0),   P0[14],P0[15],P1[0],P1[1],   pw1[2]=PKW(P0,12),pw1[3]=PKW(P0,14), pw1); \
    VRD(2); SBAR(); GAPA(C0=__builtin_amdgcn_mfma_f32_32x32x16_bf16(kf[4],qr[2],C0,0,0,0),   P1[2],P1[3],P1[4],P1[5],     pw2[0]=PKW(P1,0), pw2[1]=PKW(P1,2), pw2); \
    VRD(6); SBAR(); GAPA(C1=__builtin_amdgcn_mfma_f32_32x32x16_bf16(kf[5],qr[2],C1,0,0,0),   P1[6],P1[7],P1[8],P1[9],     pw2[2]=PKW(P1,4), pw2[3]=PKW(P1,6), pw2); \
    VRD(3); SBAR(); GAPA(C0=__builtin_amdgcn_mfma_f32_32x32x16_bf16(kf[6],qr[3],C0,0,0,0),   P1[10],P1[11],P1[12],P1[13], pw3[0]=PKW(P1,8), pw3[1]=PKW(P1,10), pw3); \
    VRD(7); SBAR(); GAPA(C1=__builtin_amdgcn_mfma_f32_32x32x16_bf16(kf[7],qr[3],C1,0,0,0),   P1[14],P1[15],0.f,0.f,       pw3[2]=PKW(P1,12),pw3[3]=PKW(P1,14), pw3); \
    l_reg+=sacc; \
    if(GK){DMA_K((t)+3,sl_cur);} if(GV){DMA_V((t)+1,sl_next);} \
    CMASK(C0,C1,t); \
    { float a=MX3(C0[0],C0[1],C1[0]),b=MX3(C0[2],C0[3],C1[1]); a=MX3(a,C1[2],C1[3]); \
      _Pragma("unroll") for(int r=4;r<16;r+=4){a=MX3(a,C0[r],C0[r+1]);b=MX3(b,C0[r+2],C0[r+3]);a=MX3(a,C1[r],C1[r+1]);b=MX3(b,C1[r+2],C1[r+3]);} \
      float rm=__builtin_fmaxf(a,b); { auto rr=__builtin_amdgcn_permlane32_swap(__float_as_uint(rm),__float_as_uint(rm),false,false); rm=__builtin_fmaxf(__uint_as_float(rr[0]),__uint_as_float(rr[1])); } \
      resc=false; \
      if(__builtin_expect(__any(rm>(float)THRL),0)){ const float dl=__builtin_fmaxf(rm,0.f); mhat+=dl; \
        _Pragma("unroll") for(int r=0;r<16;++r){C0[r]-=dl;C1[r]-=dl;} \
        _Pragma("unroll") for(int r=0;r<16;++r)negm[r]=-mhat; asm volatile("":"+v"(negm)); \
        const float f=__builtin_amdgcn_exp2f(-dl); l_reg*=f; if(hi==0)wsf[r32]=f; resc=true; } } \
    SBAR(); \
    GAPB(o[0]=__builtin_amdgcn_mfma_f32_32x32x16_bf16(PAF(0),VFR(0),o[0],0,0,0), C0,0); \
    GAPB(o[1]=__builtin_amdgcn_mfma_f32_32x32x16_bf16(PAF(0),VFR(4),o[1],0,0,0), C0,4); \
    KRD(GL,0); GAPB(o[0]=__builtin_amdgcn_mfma_f32_32x32x16_bf16(PAF(1),VFR(1),o[0],0,0,0), C0,8); \
    KRD(GL,1); GAPB(o[1]=__builtin_amdgcn_mfma_f32_32x32x16_bf16(PAF(1),VFR(5),o[1],0,0,0), C0,12); \
    KRD(GL,2); GAPB(o[0]=__builtin_amdgcn_mfma_f32_32x32x16_bf16(PAF(2),VFR(2),o[0],0,0,0), C1,0); \
    KRD(GL,3); GAPB(o[1]=__builtin_amdgcn_mfma_f32_32x32x16_bf16(PAF(2),VFR(6),o[1],0,0,0), C1,4); \
    GAPB(o[0]=__builtin_amdgcn_mfma_f32_32x32x16_bf16(PAF(3),VFR(3),o[0],0,0,0), C1,8); \
    GAPB(o[1]=__builtin_amdgcn_mfma_f32_32x32x16_bf16(PAF(3),VFR(7),o[1],0,0,0), C1,12); \
    }while(0)
  int t=1;
  #undef CMASK
  #define CMASK(P0,P1,t) do{ if constexpr(MODE==1){ dmask(P0,P1,q0+qrel-64*(t)-4*hi,tbl); } }while(0)
  for(;t+5<NT;t+=2){
    STEP(pB0,pB1,pA0,pA1,t,true,true,true);     WAIT_BAR(2); RESC(); ROT();
    STEP(pA0,pA1,pB0,pB1,t+1,true,true,true);   WAIT_BAR(2); RESC(); ROT();
  }
  #undef CMASK
  #define CMASK(P0,P1,t) do{ if constexpr(MODE==0){int jb_=(t)-(NT-4); if(jb_>=0)cmask(P0,P1,jb_,qrel,hi);} else if constexpr(MODE==1) { dmask(P0,P1,q0+qrel-64*(t)-4*hi,tbl); } }while(0)
  #define ENDW(tt) do{ if((tt)+3<NT){WAIT_BAR(2);} else if((tt)+2<NT){WAIT_BAR(1);} else {WAIT_BAR(0);} }while(0)
  for(;t+1<NT;t+=2){
    STEP(pB0,pB1,pA0,pA1,t,(t+3<NT),(t+1<NT),(t+1<NT));       ENDW(t);   RESC(); ROT();
    STEP(pA0,pA1,pB0,pB1,t+1,(t+4<NT),(t+2<NT),(t+2<NT));     ENDW(t+1); RESC(); ROT();
  }
  STEP(pB0,pB1,pA0,pA1,NT-1,false,false,false); RESC();
  { float sacc=pB0[0]+pB0[1]; _Pragma("unroll") for(int r=2;r<16;++r)sacc+=pB0[r]; _Pragma("unroll") for(int r=0;r<16;++r)sacc+=pB1[r]; l_reg+=sacc;
    pw0=(u32x4){PKW(pB0,0),PKW(pB0,2),PKW(pB0,4),PKW(pB0,6)};pw1=(u32x4){PKW(pB0,8),PKW(pB0,10),PKW(pB0,12),PKW(pB0,14)};pw2=(u32x4){PKW(pB1,0),PKW(pB1,2),PKW(pB1,4),PKW(pB1,6)};pw3=(u32x4){PKW(pB1,8),PKW(pB1,10),PKW(pB1,12),PKW(pB1,14)};
    SBAR(); pv(o,vb0+sl_cur,PAF(0),PAF(1),PAF(2),PAF(3)); }
  #undef PKW
  #undef PAF
  #undef VFR
  #undef PIN
  #undef MX3
  #undef GAPA
  #undef GAPB
  #undef EX
  #undef VRD
  #undef KRD
  #undef STEP
  #undef ENDW
  {auto rr=__builtin_amdgcn_permlane32_swap(__float_as_uint(l_reg),__float_as_uint(l_reg),false,false);l_reg=__uint_as_float(rr[0])+__uint_as_float(rr[1]);}
  if(hi==0)wsf[32+r32]=l_reg;asm volatile("s_waitcnt lgkmcnt(0)":::"memory");
  float rli[16];
  #pragma unroll
  for(int r=0;r<16;++r)rli[r]=__builtin_amdgcn_rcpf(wsf[32+crow(r,hi)]);
  bf16*Ow=O+(rowbase+q0+wid*QBLK)*(long)opitch;
  { bf16*stg=(bf16*)(shm+LDS_OST)+wid*2048;
    #pragma unroll
    for(int r=0;r<16;++r){const int orow=crow(r,hi);
      #pragma unroll
      for(int d0=0;d0<2;++d0)stg[orow*64+d0*32+r32]=__float2bfloat16(o[d0][r]*rli[r]);}
    asm volatile("s_waitcnt lgkmcnt(0)":::"memory");
    #pragma unroll
    for(int i=0;i<4;++i){const int row=i*8+(lane>>3),ch=lane&7; const u32x4 v=*(const u32x4*)(stg+row*64+ch*8); ATTN_STORE16(Ow+(long)row*opitch+ch*8,v);} }
  asm volatile("s_waitcnt lgkmcnt(0)\n\ts_barrier":::"memory");
  #undef DMA_K
  #undef DMA_V
  #undef CMASK
  #undef START
  #undef RESC
  #undef ROT
}
constexpr int ATTN_LDS_BYTES=LDS_BYTES;
#undef SBAR
#undef WAIT_BAR
}

namespace attn_b {
using bf16 = __hip_bfloat16;
typedef short bf16x8 __attribute__((ext_vector_type(8)));
typedef short s16x4 __attribute__((ext_vector_type(4)));
typedef float f32x16 __attribute__((ext_vector_type(16)));
typedef float f32x4 __attribute__((ext_vector_type(4)));
typedef unsigned u32x4 __attribute__((ext_vector_type(4)));
constexpr int DQ = 64, DV = 128, PIN = 3072, POUT = 1024;
constexpr int NW = 8, QBLK = 32, KVBLK = 64, QB = NW * QBLK;
constexpr int SHM_V = KVBLK * DV * 2, SHM_K = KVBLK * DQ * 2;
constexpr int NBUF = 3;
constexpr int LDS_BYTES = NBUF * SHM_V + NBUF * SHM_K + NW * 64 * 4;
constexpr int OSTAGE_OFF = 98304;
constexpr float THR = 8.f;
#define KSWZ(row, colB) ((row) * 128 + ((colB) ^ ((((row) >> 1) & 7) << 4)))
#define SBAR() __builtin_amdgcn_sched_barrier(0)
__device__ __forceinline__ int v_st(int k, int c) { const int kk = (k & ~0xC) | ((k & 4) << 1) | ((k & 8) >> 1); return ((kk >> 3) * 4 + (c >> 5)) * 512 + ((kk & 7) * 32 + (c & 31)) * 2; }
__device__ __forceinline__ int v_rd_base(int lane) { return ((lane & 3) << 3) | (((lane >> 2) & 3) << 6) | (((lane >> 4) & 1) << 5) | (((lane >> 5) & 1) << 8); }
constexpr int v_rd_off(int d0, int ks, int half) { return d0 * 512 + ks * 4096 + half * 2048; }
__device__ __forceinline__ int crow(int r, int hi) { return (r & 3) + 8 * (r >> 2) + 4 * hi; }
__device__ __forceinline__ unsigned cvtpk(float lo, float hi) { unsigned r; asm volatile("v_cvt_pk_bf16_f32 %0, %1, %2" : "=v"(r) : "v"(lo), "v"(hi)); return r; }
__device__ __forceinline__ bf16x8 load8(const bf16* p) { return *reinterpret_cast<const bf16x8*>(p); }
__device__ __forceinline__ void mask_tile(f32x16& p0, f32x16& p1, int dq) {
    const float NEG = -__builtin_inff();
#pragma unroll
    for (int r = 0; r < 16; ++r) { const int c = (r & 3) + 8 * (r >> 2); if (dq - c < 0) p0[r] = NEG; if (dq - c - 32 < 0) p1[r] = NEG; }
}
#define MX3(a, b, c) __builtin_fmaxf(__builtin_fmaxf((a), (b)), (c))
__device__ __forceinline__ void partialSM(f32x16& p0, f32x16& p1, float& m_reg, float& mn, float& alpha) {
    float ma = MX3(p0[0], p0[1], p0[2]), mb = MX3(p0[3], p0[4], p0[5]), mc = MX3(p1[0], p1[1], p1[2]), md = MX3(p1[3], p1[4], p1[5]);
    ma = MX3(ma, p0[6], p0[7]); mb = MX3(mb, p0[8], p0[9]); mc = MX3(mc, p1[6], p1[7]); md = MX3(md, p1[8], p1[9]);
    ma = MX3(ma, p0[10], p0[11]); mb = MX3(mb, p0[12], p0[13]); mc = MX3(mc, p1[10], p1[11]); md = MX3(md, p1[12], p1[13]);
    ma = MX3(ma, p0[14], p0[15]); mc = MX3(mc, p1[14], p1[15]);
    float pmax = __builtin_fmaxf(MX3(ma, mb, mc), md);
    { auto rr = __builtin_amdgcn_permlane32_swap(__float_as_uint(pmax), __float_as_uint(pmax), false, false); pmax = fmaxf(__uint_as_float(rr[0]), __uint_as_float(rr[1])); }
    if (__builtin_expect(__all((pmax - m_reg) <= THR), 1)) { mn = m_reg; alpha = 1.f; }
    else { mn = fmaxf(m_reg, pmax); alpha = __builtin_amdgcn_exp2f(m_reg - mn); m_reg = mn; }
#pragma unroll
    for (int r = 0; r < 16; ++r) p0[r] = p0[r] - mn;
#pragma unroll
    for (int r = 0; r < 16; ++r) p1[r] = p1[r] - mn;
#pragma unroll
    for (int r = 0; r < 16; ++r) p0[r] = __builtin_amdgcn_exp2f(p0[r]);
}
__device__ __forceinline__ void finishSM(f32x16& p0, f32x16& p1, float alpha, float& l_reg, bf16x8& pa0, bf16x8& pa1, bf16x8& pa2, bf16x8& pa3) {
#pragma unroll
    for (int r = 0; r < 16; ++r) p1[r] = __builtin_amdgcn_exp2f(p1[r]);
    float sa = p0[0] + p0[1], sb = p0[2] + p0[3], sc = p1[0] + p1[1], sd = p1[2] + p1[3];
#pragma unroll
    for (int r = 4; r < 16; r += 4) { sa += p0[r]; sb += p0[r + 2]; sc += p1[r]; sd += p1[r + 2]; sa += p0[r + 1]; sb += p0[r + 3]; sc += p1[r + 1]; sd += p1[r + 3]; }
    float ps = (sa + sb) + (sc + sd);
    { auto rr = __builtin_amdgcn_permlane32_swap(__float_as_uint(ps), __float_as_uint(ps), false, false); ps = __uint_as_float(rr[0]) + __uint_as_float(rr[1]); }
    l_reg = l_reg * alpha + ps;
#define PK4(P, B_, OUT) do { unsigned a0 = cvtpk(P[B_+0], P[B_+1]), a1 = cvtpk(P[B_+2], P[B_+3]);                          \
        unsigned b0 = cvtpk(P[B_+4], P[B_+5]), b1 = cvtpk(P[B_+6], P[B_+7]);                                             \
        auto r0 = __builtin_amdgcn_permlane32_swap(a0, b0, false, false); auto r1 = __builtin_amdgcn_permlane32_swap(a1, b1, false, false); \
        u32x4 w = {r0[0], r1[0], r0[1], r1[1]}; OUT = *reinterpret_cast<bf16x8*>(&w); } while (0)
    PK4(p0, 0, pa0); PK4(p0, 8, pa1); PK4(p1, 0, pa2); PK4(p1, 8, pa3);
#undef PK4
}
__device__ __forceinline__ void qkt(f32x16& p0, f32x16& p1, const char* K_buf, int r32, int hi, const bf16x8* qr) {
    p0 = f32x16{}; p1 = f32x16{};
#pragma unroll
    for (int d0 = 0; d0 < 4; ++d0) { const char* a = K_buf + KSWZ(r32, (d0 * 16 + hi * 8) * 2);
        bf16x8 b0 = *reinterpret_cast<const bf16x8*>(a);
        bf16x8 b1 = *reinterpret_cast<const bf16x8*>(a + 32 * 128);
        p0 = __builtin_amdgcn_mfma_f32_32x32x16_bf16(b0, qr[d0], p0, 0, 0, 0);
        p1 = __builtin_amdgcn_mfma_f32_32x32x16_bf16(b1, qr[d0], p1, 0, 0, 0); }
}
__device__ __forceinline__ void pv_tile(f32x16* o, int vb0, bf16x8 pa0, bf16x8 pa1, bf16x8 pa2, bf16x8 pa3) {
#define TRRD(dst, off) asm volatile("ds_read_b64_tr_b16 %0, %1 offset:%2" : "=&v"(dst) : "v"(vb0), "i"(off) : "memory")
#define PV_D0(d0) do { s16x4 l0, l1, l2, l3, h0, h1, h2, h3; constexpr int b_ = v_rd_off(d0, 0, 0);   \
        TRRD(l0, b_); TRRD(h0, b_ + 2048); TRRD(l1, b_ + 4096); TRRD(h1, b_ + 6144); TRRD(l2, b_ + 8192); TRRD(h2, b_ + 10240); TRRD(l3, b_ + 12288); TRRD(h3, b_ + 14336); \
        asm volatile("s_waitcnt lgkmcnt(0)" ::: "memory"); SBAR();   \
        o[d0] = __builtin_amdgcn_mfma_f32_32x32x16_bf16(pa0, (bf16x8){l0[0], l0[1], l0[2], l0[3], h0[0], h0[1], h0[2], h0[3]}, o[d0], 0, 0, 0);   \
        o[d0] = __builtin_amdgcn_mfma_f32_32x32x16_bf16(pa1, (bf16x8){l1[0], l1[1], l1[2], l1[3], h1[0], h1[1], h1[2], h1[3]}, o[d0], 0, 0, 0);   \
        o[d0] = __builtin_amdgcn_mfma_f32_32x32x16_bf16(pa2, (bf16x8){l2[0], l2[1], l2[2], l2[3], h2[0], h2[1], h2[2], h2[3]}, o[d0], 0, 0, 0);   \
        o[d0] = __builtin_amdgcn_mfma_f32_32x32x16_bf16(pa3, (bf16x8){l3[0], l3[1], l3[2], l3[3], h3[0], h3[1], h3[2], h3[3]}, o[d0], 0, 0, 0); } while (0)
    PV_D0(0); PV_D0(1); PV_D0(2); PV_D0(3);
#undef PV_D0
#undef TRRD
}
__device__ __forceinline__ void partialSM_noexp(f32x16& p0, f32x16& p1, float& m_reg, float& mn, float& alpha) {
    float pmax = p0[0];
#pragma unroll
    for (int r = 1; r < 16; ++r) pmax = fmaxf(pmax, p0[r]);
#pragma unroll
    for (int r = 0; r < 16; ++r) pmax = fmaxf(pmax, p1[r]);
    { auto rr = __builtin_amdgcn_permlane32_swap(__float_as_uint(pmax), __float_as_uint(pmax), false, false); pmax = fmaxf(__uint_as_float(rr[0]), __uint_as_float(rr[1])); }
    if (__builtin_expect(__all((pmax - m_reg) <= THR), 1)) { mn = m_reg; alpha = 1.f; }
    else { mn = fmaxf(m_reg, pmax); alpha = 1.f; m_reg = mn; }
#pragma unroll
    for (int r = 0; r < 16; ++r) p0[r] = p0[r] - mn;
#pragma unroll
    for (int r = 0; r < 16; ++r) p1[r] = p1[r] - mn;
}
__device__ __forceinline__ void finishSM_noexp(f32x16& p0, f32x16& p1, float alpha, float& l_reg, bf16x8& pa0, bf16x8& pa1, bf16x8& pa2, bf16x8& pa3) {
    float ps = 0;
#pragma unroll
    for (int r = 0; r < 16; ++r) ps += p0[r];
#pragma unroll
    for (int r = 0; r < 16; ++r) ps += p1[r];
    { auto rr = __builtin_amdgcn_permlane32_swap(__float_as_uint(ps), __float_as_uint(ps), false, false); ps = __uint_as_float(rr[0]) + __uint_as_float(rr[1]); }
    l_reg = l_reg * alpha + ps;
#define PK4(P, B_, OUT) do { unsigned a0 = cvtpk(P[B_+0], P[B_+1]), a1 = cvtpk(P[B_+2], P[B_+3]);                          \
        unsigned b0 = cvtpk(P[B_+4], P[B_+5]), b1 = cvtpk(P[B_+6], P[B_+7]);                                             \
        auto r0 = __builtin_amdgcn_permlane32_swap(a0, b0, false, false); auto r1 = __builtin_amdgcn_permlane32_swap(a1, b1, false, false); \
        u32x4 w = {r0[0], r1[0], r0[1], r1[1]}; OUT = *reinterpret_cast<bf16x8*>(&w); } while (0)
    PK4(p0, 0, pa0); PK4(p0, 8, pa1); PK4(p1, 0, pa2); PK4(p1, 8, pa3);
#undef PK4
}
__device__ __forceinline__ void qkt_nomma(f32x16& p0, f32x16& p1, const char* K_buf, int r32, int hi, const bf16x8* qr) {
    p0 = f32x16{}; p1 = f32x16{};
#pragma unroll
    for (int d0 = 0; d0 < 4; ++d0) { const char* a = K_buf + KSWZ(r32, (d0 * 16 + hi * 8) * 2);
        bf16x8 b0 = *reinterpret_cast<const bf16x8*>(a);
        bf16x8 b1 = *reinterpret_cast<const bf16x8*>(a + 32 * 128);
        p0[d0] += (float)b0[0] + (float)qr[d0][0]; p1[d0] += (float)b1[0]; }
}
__device__ __forceinline__ void pv_nomma(f32x16* o, int vb0, bf16x8 pa0, bf16x8 pa1, bf16x8 pa2, bf16x8 pa3) {
#define TRRD(dst, off) asm volatile("ds_read_b64_tr_b16 %0, %1 offset:%2" : "=&v"(dst) : "v"(vb0), "i"(off) : "memory")
#define PV_D0(d0) do { s16x4 l0, l1, l2, l3, h0, h1, h2, h3; constexpr int b_ = v_rd_off(d0, 0, 0);   \
        TRRD(l0, b_); TRRD(h0, b_ + 2048); TRRD(l1, b_ + 4096); TRRD(h1, b_ + 6144); TRRD(l2, b_ + 8192); TRRD(h2, b_ + 10240); TRRD(l3, b_ + 12288); TRRD(h3, b_ + 14336); \
        asm volatile("s_waitcnt lgkmcnt(0)" ::: "memory"); SBAR();   \
        o[d0][0] += (float)(l0[0] + h0[0] + l1[0] + h1[0] + l2[0] + h2[0] + l3[0] + h3[0]) + (float)pa0[0] + (float)pa1[0] + (float)pa2[0] + (float)pa3[0]; } while (0)
    PV_D0(0); PV_D0(1); PV_D0(2); PV_D0(3);
#undef PV_D0
#undef TRRD
}
struct BlockRef { const bf16* Q; const bf16* K; const bf16* V; bf16* O; int P0; };
struct Seam { bf16x8 qr[4]; bf16x8 st_v0, st_v1, st_k0; };
#define VMW() asm volatile("s_waitcnt vmcnt(0)" ::: "memory")
#define VMWN(n) asm volatile("s_waitcnt vmcnt(%0)" :: "i"(n) : "memory")
#define SLOAD_H(Kp, Vp, k0) do { S.st_v0 = load8((Vp) + (size_t)((k0) + sr) * PIN + sc); S.st_v1 = load8((Vp) + (size_t)((k0) + 32 + sr) * PIN + sc);   \
                                 S.st_k0 = load8((Kp) + (size_t)((k0) + ksr) * PIN + ksc); } while (0)
#define SWRITE_HK(bf) do { *(bf16x8*)(K_lds + (bf) * SHM_K + kws) = S.st_k0; } while (0)
#define SWRITE_HV(bf) do { *(bf16x8*)(V_lds + (bf) * SHM_V + vst0) = S.st_v0; *(bf16x8*)(V_lds + (bf) * SHM_V + vst1) = S.st_v1; } while (0)
#define SWRITE_H(bf) do { SWRITE_HV(bf); SWRITE_HK(bf); } while (0)
__device__ __forceinline__ void causal_prime(const BlockRef& cur, char* lds, Seam& S) {
    int tid_ = threadIdx.x; asm volatile("" : "+v"(tid_));
    const int tid = tid_, wid = __builtin_amdgcn_readfirstlane(tid >> 6), lane = tid & 63, r32 = lane & 31, hi = lane >> 5;
    const int sr = tid >> 4, sc = (tid & 15) * 8, ksr = tid >> 3, ksc = (tid & 7) * 8, kws = KSWZ(ksr, ksc * 2); char* K_lds = lds + NBUF * SHM_V;
#pragma unroll
    for (int d0 = 0; d0 < 4; ++d0) S.qr[d0] = load8(cur.Q + (size_t)(wid * QBLK + r32) * PIN + d0 * 16 + hi * 8);
    SLOAD_H(cur.K, cur.V, 0); VMW(); SWRITE_HK(0);
    __syncthreads();
}
template <int ABL = 0>
__device__ __forceinline__ void causal_block(const BlockRef& cur, const BlockRef& nxt, char* lds, Seam& S) {
    int tid_ = threadIdx.x; asm volatile("" : "+v"(tid_));
    const int tid = tid_, wid = __builtin_amdgcn_readfirstlane(tid >> 6), lane = tid & 63, r32 = lane & 31, hi = lane >> 5;
    const int NT = (cur.P0 + QB) / KVBLK;
    const int qlo = cur.P0 + wid * QBLK, qm = qlo + r32 - 4 * hi;
    char* V_lds = lds; char* K_lds = lds + NBUF * SHM_V;
    float* ws = (float*)(lds + NBUF * SHM_V + NBUF * SHM_K) + wid * 64; float* li_l = ws, * al_l = ws + 32;
    float m_reg = -1e30f, l_reg = 0; f32x16 o[4] = {};
    const int sr = tid >> 4, sc = (tid & 15) * 8, vst0 = v_st(sr, sc), vst1 = v_st(32 + sr, sc), ksr = tid >> 3, ksc = (tid & 7) * 8, kws = KSWZ(ksr, ksc * 2);
    const int vb0 = (int)(uintptr_t)V_lds + v_rd_base(lane);
    const bf16* Kh = cur.K; const bf16* Vh = cur.V;
#define RESC(a) do { if (__any((a) < 1.f)) { if (hi == 0) al_l[r32] = (a); asm volatile("s_waitcnt lgkmcnt(0)" ::: "memory");              \
                     _Pragma("unroll") for (int d_ = 0; d_ < 4; ++d_) _Pragma("unroll") for (int r = 0; r < 16; ++r) o[d_][r] *= al_l[crow(r, hi)]; } } while (0)
#define KBASE(t) ((t) * KVBLK)
#define MASKT(P0_, P1_, t) do { const int kb_ = KBASE(t); if (kb_ + KVBLK - 1 > qlo) { asm volatile("" ::: "memory"); mask_tile(P0_, P1_, qm - kb_); } } while (0)
    constexpr int NQL = 4;
#define SEAM_K0() do { VMWN(NQL); SWRITE_HK(0); SBAR(); } while (0)
    f32x16 pA0, pA1, pB0, pB1; float mnA, mnB, alA, alB; bf16x8 pa0, pa1, pa2, pa3;
    SWRITE_HV(0); SBAR();
    if (NT > 1) { SLOAD_H(Kh, Vh, KBASE(1)); }
    SBAR(); qkt(pA0, pA1, K_lds, r32, hi, S.qr);
    MASKT(pA0, pA1, 0); partialSM(pA0, pA1, m_reg, mnA, alA);
    if (NT > 1) { VMW(); SWRITE_H(1); }
    __syncthreads();
    int bt = 1, bp = 0, bn = 2;
#define ROTB() do { const int o_ = bp; bp = bt; bt = bn; bn = o_; } while (0)
#define HALF_STEP(PX0, PX1, mnX, alX, PY0, PY1, alY, t) do {                                                                 \
        SBAR(); if constexpr (ABL != 6 && ABL < 9) { if constexpr (ABL == 2) qkt_nomma(PX0, PX1, K_lds + bt * SHM_K, r32, hi, S.qr); else qkt(PX0, PX1, K_lds + bt * SHM_K, r32, hi, S.qr); } \
        if constexpr (ABL != 7 && ABL < 9) { if constexpr (ABL == 1) finishSM_noexp(PY0, PY1, alY, l_reg, pa0, pa1, pa2, pa3); else finishSM(PY0, PY1, alY, l_reg, pa0, pa1, pa2, pa3); } SBAR(); \
        if constexpr (ABL != 4 && ABL < 9) { if ((t) + 1 < NT) { SLOAD_H(Kh, Vh, KBASE((t) + 1)); SBAR(); } }                              \
        if constexpr (ABL != 5 && ABL < 9) { if constexpr (ABL == 2) pv_nomma(o, vb0 + bp * SHM_V, pa0, pa1, pa2, pa3); else pv_tile(o, vb0 + bp * SHM_V, pa0, pa1, pa2, pa3); } \
        MASKT(PX0, PX1, (t)); if constexpr (ABL != 7 && ABL < 9) { if constexpr (ABL == 1) partialSM_noexp(PX0, PX1, m_reg, mnX, alX); else partialSM(PX0, PX1, m_reg, mnX, alX); } else { alX = 1.f; } \
        if constexpr (ABL != 4 && ABL < 9) { if ((t) + 1 < NT) { VMW(); SWRITE_H(bn); } }                                                  \
        RESC(alX); if constexpr (ABL != 3 && ABL != 10) __syncthreads(); ROTB(); } while (0)
    for (int t = 1; t + 1 < NT && ABL != 8; t += 2) {
        HALF_STEP(pB0, pB1, mnB, alB, pA0, pA1, alA, t);
        HALF_STEP(pA0, pA1, mnA, alA, pB0, pB1, alB, t + 1);
    }
    const bool even = (NT & 1) == 0;
    if (even) { SBAR(); qkt(pB0, pB1, K_lds + bt * SHM_K, r32, hi, S.qr); SBAR(); }
    SLOAD_H(nxt.K, nxt.V, 0); SBAR();
#pragma unroll
    for (int d0 = 0; d0 < 4; ++d0) S.qr[d0] = load8(nxt.Q + (size_t)(wid * QBLK + r32) * PIN + d0 * 16 + hi * 8);
    SBAR();
    finishSM(pA0, pA1, alA, l_reg, pa0, pa1, pa2, pa3); SBAR();
    pv_tile(o, vb0 + (even ? bp : bt) * SHM_V, pa0, pa1, pa2, pa3);
    if (even) { MASKT(pB0, pB1, NT - 1); partialSM(pB0, pB1, m_reg, mnB, alB); __syncthreads(); RESC(alB);
        finishSM(pB0, pB1, alB, l_reg, pa0, pa1, pa2, pa3); SBAR(); pv_tile(o, vb0 + bt * SHM_V, pa0, pa1, pa2, pa3); }
    SBAR(); SEAM_K0();
    if (hi == 0) li_l[r32] = l_reg; asm volatile("s_waitcnt lgkmcnt(0)" ::: "memory");
    float rli[16];
#pragma unroll
    for (int r = 0; r < 16; ++r) rli[r] = __builtin_amdgcn_rcpf(li_l[crow(r, hi)]);
    bf16* Ow = cur.O + (size_t)(wid * QBLK) * POUT;
    bf16* stg = (bf16*)(lds + OSTAGE_OFF) + wid * 2048;
#pragma unroll
    for (int h2 = 0; h2 < 2; ++h2) {
#pragma unroll
        for (int r = 0; r < 16; ++r) { const int orow = crow(r, hi);
#pragma unroll
            for (int dd = 0; dd < 2; ++dd) stg[orow * 64 + dd * 32 + r32] = __float2bfloat16(o[2 * h2 + dd][r] * rli[r]); }
        asm volatile("s_waitcnt lgkmcnt(0)" ::: "memory");
#pragma unroll
        for (int i = 0; i < 4; ++i) { const int row = i * 8 + (lane >> 3), ch = lane & 7; const u32x4 v = *(const u32x4*)(stg + row * 64 + ch * 8);
            *(u32x4*)(Ow + (size_t)row * POUT + h2 * 64 + ch * 8) = v; }
        asm volatile("s_waitcnt lgkmcnt(0)" ::: "memory");
    }
    __syncthreads();
#undef RESC
#undef KBASE
#undef MASKT
#undef SEAM_K0
#undef HALF_STEP
#undef ROTB
}
#undef VMW
#undef VMWN
#undef SLOAD_H
#undef SWRITE_HK
#undef SWRITE_HV
#undef SWRITE_H
#undef KSWZ
#undef SBAR
}

namespace cg = cooperative_groups;
constexpr int NWAVES = 8;
#ifndef MK_N_LAUNCHES
#define MK_N_LAUNCHES 1
#endif
constexpr int NPHASE = 14;

constexpr int M = 16384, DMOD = 1024, SEQL = 2048, NBATCH = 8, DFF = 2816, INC = 3072;
constexpr int NMT_UP = 65;

constexpr size_t MiB = 1u << 20;
constexpr size_t WS_CTL = 0, CTL_ZERO_BYTES = 64 * 1024;
constexpr int CW_PANEL = 8192;
constexpr int CW_BAR = 1024;
constexpr size_t WS_IDENT = 128 * 1024;
constexpr size_t WS_SS = 1 * MiB;
constexpr size_t WS_ROPE = 2 * MiB;
constexpr size_t WS_W = 3 * MiB;
constexpr size_t W_IN_OFF = 0, W_OUT_OFF = 6 * MiB, W_UP_OFF = 8 * MiB, W_DOWN_OFF = 19 * MiB, W_LAYER = 24 * MiB + MiB / 2;
constexpr size_t WS_XB = 52 * MiB + MiB / 2;
constexpr size_t WS_PROJ = 85 * MiB;
constexpr size_t WS_ACT = 85 * MiB;
constexpr size_t WS_OB = 181 * MiB;
constexpr size_t WS_MIX = 213 * MiB;
constexpr size_t WS_END = 245 * MiB;
static_assert(WS_W + 2 * W_LAYER <= WS_XB - MiB / 2 && WS_XB + (size_t)M * DMOD * 2 + MiB / 2 <= WS_PROJ && WS_PROJ + (size_t)M * INC * 2 <= WS_OB && WS_ACT + (size_t)M * DFF * 2 <= WS_OB && WS_MIX + (size_t)M * DMOD * 2 <= WS_END, "d_ws map");

constexpr int RING_OFF = 0, RING_BYTES = 131072;
constexpr int DMASK_TBL_OFF = 86016;
constexpr int HALO_OFF = RING_BYTES;
constexpr int MISC_OFF = HALO_OFF + 4096;
constexpr int P0_SCR_BYTES = 64 * 65 * 4;
constexpr int LRSTD_OFF = MISC_OFF + 256;
constexpr int LROPE_OFF = LRSTD_OFF + 1024;
constexpr int LCW_OFF = LROPE_OFF + 16384;
constexpr int LDS_BYTES = 155648;
static_assert(attn_b::LDS_BYTES <= DMASK_TBL_OFF && NWAVES * P0_SCR_BYTES <= MISC_OFF && LCW_OFF + 1536 <= LDS_BYTES && LDS_BYTES <= 163840 && attn_body::ATTN_LDS_BYTES <= DMASK_TBL_OFF && DMASK_TBL_OFF + attn_body::DMASK_TBL_N * 4 <= attn_b::OSTAGE_OFF && attn_b::OSTAGE_OFF + 32768 <= RING_BYTES, "LDS map");

#define GAS __attribute__((address_space(1)))
#define LAS __attribute__((address_space(3)))
typedef unsigned short bf16;
typedef unsigned v4u __attribute__((ext_vector_type(4)));
typedef unsigned v2u __attribute__((ext_vector_type(2)));
typedef float f32x4 __attribute__((ext_vector_type(4)));
#define LDS_WAIT() asm volatile("s_waitcnt lgkmcnt(0)" ::: "memory")
__device__ __forceinline__ unsigned f2bf(float f) { unsigned u = __builtin_bit_cast(unsigned, f); return (u + 0x7fffu + ((u >> 16) & 1u)) >> 16; }
__device__ __forceinline__ unsigned pk2(float lo, float hi) { return f2bf(lo) | (f2bf(hi) << 16); }
__device__ __forceinline__ float bflo(unsigned w) { return __builtin_bit_cast(float, w << 16); }
__device__ __forceinline__ float bfhi(unsigned w) { return __builtin_bit_cast(float, w & 0xffff0000u); }
__device__ __forceinline__ float wave_sum(float v) {
#pragma unroll
    for (int o = 1; o < 64; o <<= 1) v += __shfl_xor(v, o);
    return v;
}

#define XB_TMO      128
#define XB_XCNT(j)  (256  + 64 * (j))
#define XB_XSUB(j)  (1280 + 64 * (j))
#define XB_XGEN(j)  (2304 + 64 * (j))
#define XB_TOP      3328
#define XB_TOPGEN   3392
#define XCD_BAR_WORDS 3456
#define XB_SPIN_CAP (1u << 18)

__device__ __forceinline__ unsigned xb_ld(unsigned* p)              { return __hip_atomic_load(p, __ATOMIC_RELAXED, __HIP_MEMORY_SCOPE_AGENT); }
__device__ __forceinline__ unsigned xb_add(unsigned* p, unsigned v) { return __hip_atomic_fetch_add(p, v, __ATOMIC_RELAXED, __HIP_MEMORY_SCOPE_AGENT); }
__device__ __forceinline__ unsigned xb_xcc_id() { return (unsigned)__builtin_amdgcn_s_getreg((3 << 11) | 20) & 0xFu; }
#define XB_SPIN(cond, bar) do { unsigned _sp = 0; while (cond) { __builtin_amdgcn_s_sleep(1); \
    if ((++_sp & 255u) == 0u) { if (xb_ld(&(bar)[XB_TMO])) break; if (_sp > XB_SPIN_CAP) { atomicAdd(&(bar)[XB_TMO], 1u); break; } } } } while (0)

struct XcdBarrier {
    unsigned* bar; unsigned x;
    volatile LAS unsigned* st;
};

__device__ __forceinline__ XcdBarrier xcd_barrier_post(unsigned* bar, volatile LAS unsigned* st) {
    XcdBarrier b; b.bar = bar; b.x = xb_xcc_id(); b.st = st;
    if (threadIdx.x == 0) (void)xb_add(&bar[XB_XCNT(b.x)], 1u);
    return b;
}
__device__ __forceinline__ void xcd_barrier_complete(unsigned* bar, unsigned x, unsigned& nloc, unsigned& nx) {
    const unsigned G = gridDim.x * gridDim.y * gridDim.z;
    unsigned sum, cnt, mine, sp = 0u;
    for (;;) {
        sum = 0u; cnt = 0u; mine = 0u;
#pragma unroll
        for (unsigned j = 0; j < 16; ++j) { const unsigned c = xb_ld(&bar[XB_XCNT(j)]); sum += c; cnt += (c > 0u) ? 1u : 0u; mine = (j == x) ? c : mine; }
        if (sum == G) break;
        __builtin_amdgcn_s_sleep(1);
        if ((++sp & 255u) == 0u) { if (xb_ld(&bar[XB_TMO])) break; if (sp > XB_SPIN_CAP) { atomicAdd(&bar[XB_TMO], 1u); break; } }
    }
    nloc = mine > 0u ? mine : 1u; nx = cnt > 0u ? cnt : 1u;
}

__device__ __forceinline__ void xcd_barrier(const XcdBarrier& b) {
    asm volatile("s_waitcnt vmcnt(0)" ::: "memory");
    __syncthreads();
    if (threadIdx.x == 0) {
        unsigned* bar = b.bar;
        __builtin_amdgcn_s_waitcnt(0);
        unsigned nloc = b.st[0], nx = b.st[1];
        if (nloc == 0u) { xcd_barrier_complete(bar, b.x, nloc, nx); b.st[0] = nloc; b.st[1] = nx; }
        const unsigned old = xb_add(&bar[XB_XSUB(b.x)], 1u);
        const unsigned gen = old / nloc;
        if (old + 1u == (gen + 1u) * nloc) {
            __builtin_amdgcn_fence(__ATOMIC_RELEASE, "agent");
            asm volatile("s_waitcnt vmcnt(0)" ::: "memory");
            const unsigned og = xb_add(&bar[XB_TOP], 1u);
            const unsigned tg = og / nx;
            if (og + 1u == (tg + 1u) * nx) xb_add(&bar[XB_TOPGEN], 1u);
            else XB_SPIN(xb_ld(&bar[XB_TOPGEN]) == tg, bar);
            __builtin_amdgcn_fence(__ATOMIC_ACQUIRE, "agent");
            xb_add(&bar[XB_XGEN(b.x)], 1u);
            asm volatile("s_waitcnt vmcnt(0)" ::: "memory");
        } else {
            XB_SPIN(xb_ld(&bar[XB_XGEN(b.x)]) == gen, bar);
            __builtin_amdgcn_fence(__ATOMIC_ACQUIRE, "agent");
            asm volatile("s_waitcnt vmcnt(0)" ::: "memory");
        }
    }
    __syncthreads();
}

struct Args { const float* in[16]; float* out; unsigned char* ws; int ph_lo, ph_hi; };
static_assert(sizeof(Args) == 16 * 8 + 8 + 8 + 8, "Args has no padding");

struct Frame {
    LAS unsigned char* lds;
    int tid, lane, wave, vcu, G;
    float* out; unsigned char* ws;
};
__device__ __forceinline__ const float* karg_in(int i) {
    const __attribute__((address_space(4))) char* kp = (const __attribute__((address_space(4))) char*)__builtin_amdgcn_kernarg_segment_ptr();
    asm volatile("" : "+s"(kp));
    return ((const float* const __attribute__((address_space(4)))*)kp)[i];
}

__device__ __forceinline__ void p0_transpose_item(const float* W, int K, int N, bf16* WT, int k0, int n0, int drow0, const float* gain, LAS float* scr, int lane) {
    const int lr = lane >> 4, lc = (lane & 15) * 4;
    f32x4 v[16];
#pragma unroll
    for (int i = 0; i < 16; ++i) v[i] = *(const f32x4*)(W + (size_t)(k0 + lr + 4 * i) * N + n0 + lc);
    if (gain) {
#pragma unroll
        for (int i = 0; i < 16; ++i) v[i] = v[i] * gain[k0 + lr + 4 * i];
    }
#pragma unroll
    for (int i = 0; i < 16; ++i) { LAS float* p = scr + (lr + 4 * i) * 65 + lc; p[0] = v[i].x; p[1] = v[i].y; p[2] = v[i].z; p[3] = v[i].w; }
    LDS_WAIT(); asm volatile("" ::: "memory");
    const int c = lane >> 3, nn = lane & 7;
#pragma unroll
    for (int j = 0; j < 8; ++j) { const int n = nn + 8 * j; const LAS float* q = scr + (8 * c) * 65 + n;
        v4u o; o.x = pk2(q[0 * 65], q[1 * 65]); o.y = pk2(q[2 * 65], q[3 * 65]); o.z = pk2(q[4 * 65], q[5 * 65]); o.w = pk2(q[6 * 65], q[7 * 65]);
        *(v4u*)(WT + (size_t)(drow0 + n) * K + k0 + 8 * c) = o; }
    LDS_WAIT(); asm volatile("" ::: "memory");
}
__device__ __forceinline__ int up_dest_row(int n0) { const int half = n0 >= DFF ? 1 : 0, n = n0 - half * DFF; return (n >> 7) * 256 + half * 128 + (n & 127); }

__device__ __forceinline__ void p0_convert_layer(Frame& F, int L, int widx, int nw, int part = 0) {
    { int t_ = threadIdx.x; asm volatile("" : "+v"(t_)); F.tid = t_; F.lane = t_ & 63; }
    LAS float* scr = (LAS float*)(F.lds + RING_OFF + F.wave * P0_SCR_BYTES);
    constexpr int I_IN = (DMOD / 64) * (INC / 64), I_OUT = (DMOD / 64) * (DMOD / 64), I_UP = (DMOD / 64) * (2 * DFF / 64), I_DN = (DFF / 64) * (DMOD / 64);
    constexpr int I_LAYER = I_IN + I_OUT + I_UP + I_DN;
    unsigned char* wl = F.ws + WS_W + (size_t)L * W_LAYER;
    const int it_lo = (part == 2) ? I_IN : 0, it_hi = (part == 1) ? I_IN : I_LAYER;
    for (int it = it_lo + widx; it < it_hi; it += nw) {
        int r = it;
        if (r < I_IN) { const int nb = INC / 64, kb = r / nb, n0 = 64 * (r % nb);
            p0_transpose_item(karg_in(3) + (size_t)L * DMOD * INC, DMOD, INC, (bf16*)(wl + W_IN_OFF), 64 * kb, n0, n0, karg_in(2) + L * DMOD, scr, F.lane); continue; }
        r -= I_IN;
        if (r < I_OUT) { const int nb = DMOD / 64, kb = r / nb, n0 = 64 * (r % nb);
            p0_transpose_item(karg_in(10) + (size_t)L * DMOD * DMOD, DMOD, DMOD, (bf16*)(wl + W_OUT_OFF), 64 * kb, n0, n0, nullptr, scr, F.lane); continue; }
        r -= I_OUT;
        if (r < I_UP) { const int nb = 2 * DFF / 64, kb = r / nb, n0 = 64 * (r % nb);
            p0_transpose_item(karg_in(12) + (size_t)L * DMOD * 2 * DFF, DMOD, 2 * DFF, (bf16*)(wl + W_UP_OFF), 64 * kb, n0, up_dest_row(n0), karg_in(11) + L * DMOD, scr, F.lane); continue; }
        r -= I_UP;
        { const int nb = DMOD / 64, kb = r / nb, n0 = 64 * (r % nb);
            p0_transpose_item(karg_in(14) + (size_t)L * DFF * DMOD, DFF, DMOD, (bf16*)(wl + W_DOWN_OFF), 64 * kb, n0, n0, nullptr, scr, F.lane); }
    }
}

__device__ __forceinline__ void p0_prologue(Frame& F) {
    const int gw = F.vcu * NWAVES + F.wave, NGW = F.G * NWAVES;
    p0_convert_layer(F, 0, gw, NGW, 1);
    bf16* XB = (bf16*)(F.ws + WS_XB); float* SS = (float*)(F.ws + WS_SS);
    for (int m = gw; m < M; m += NGW) {
        const f32x4* xr = (const f32x4*)(karg_in(0) + (size_t)m * DMOD) + F.lane;
        f32x4 v[4]; float s = 0.f;
#pragma unroll
        for (int j = 0; j < 4; ++j) { v[j] = xr[64 * j]; s += (v[j].x * v[j].x + v[j].y * v[j].y) + (v[j].z * v[j].z + v[j].w * v[j].w); }
        s = wave_sum(s);
        unsigned long long* o8 = (unsigned long long*)(XB + (size_t)m * DMOD) + F.lane;
#pragma unroll
        for (int j = 0; j < 4; ++j) o8[64 * j] = (unsigned long long)pk2(v[j].x, v[j].y) | ((unsigned long long)pk2(v[j].z, v[j].w) << 32);
        if (F.lane < 16) SS[(size_t)m * 16 + F.lane] = (F.lane == 0) ? s : 0.f;
    }
    if (gw == 0 && F.lane < 16) ((float*)(F.ws + WS_IDENT))[F.lane] = F.lane < 8 ? 1.0f : 0.0f;
    const int* pos = (const int*)karg_in(1); float* rope = (float*)(F.ws + WS_ROPE);
    const int gt = (F.vcu * NWAVES + F.wave) * 64 + F.lane, NGT = F.G * NWAVES * 64;
    for (int idx = gt; idx < M * 8; idx += NGT) {
        const int m = idx >> 3, i = idx & 7;
        const double invd = (i == 0) ? 1.0 : (i == 1) ? 0.19392274474868576 : (i == 2) ? 0.03760603093086393 : (i == 3) ? 0.007292664737217109 : (i == 4) ? 0.001414213562373095 :
                            (i == 5) ? 0.0002742481756762073 : (i == 6) ? 5.318295896944988e-05 : 1.031338537721246e-05;
        const double ang = (double)pos[m] * (double)(float)invd;
        const double k = __builtin_rint(ang * 0.15915494309189535);
        const float r = (float)(ang - k * 6.283185307179586);
        rope[(size_t)m * 16 + i] = cosf(r); rope[(size_t)m * 16 + 8 + i] = sinf(r);
    }
}

__device__ __forceinline__ void p_combine(Frame& F, int L) {
    { int t_ = threadIdx.x; asm volatile("" : "+v"(t_)); F.tid = t_; F.lane = t_ & 63; }
    const int gw = F.vcu * NWAVES + F.wave, NGW = F.G * NWAVES, lane = F.lane;
    const float lam_init = 0.8f - 0.6f * expf(-0.3f * (float)L);
    const float d1 = wave_sum(karg_in(4)[L * 64 + lane] * karg_in(5)[L * 64 + lane]), d2 = wave_sum(karg_in(6)[L * 64 + lane] * karg_in(7)[L * 64 + lane]);
    const float lam = expf(d1) - expf(d2) + lam_init, osc = 1.0f - lam_init;
    const bf16* OB = (const bf16*)(F.ws + WS_OB); const bf16* PROJ = (const bf16*)(F.ws + WS_PROJ); bf16* MIX = (bf16*)(F.ws + WS_MIX);
    const int h = lane >> 4, e0 = (lane & 15) * 8, c0 = lane * 4;
    const float* sg = karg_in(8) + L * 128 + e0; const f32x4 g0 = *(const f32x4*)sg, g1 = *(const f32x4*)(sg + 4);
    const float* cw = karg_in(9) + L * 3 * 256 + c0; const f32x4 w0 = *(const f32x4*)cw, w1 = *(const f32x4*)(cw + 256), w2 = *(const f32x4*)(cw + 512);
    constexpr int UR = 4;
    for (int mb = gw; mb < M; mb += UR * NGW) {
        v4u a[UR], b[UR]; v2u cb[UR], cc[UR][3], ch[UR][3]; float f1[UR], f2[UR];
#pragma unroll
        for (int u = 0; u < UR; ++u) {
            const int m = mb + u * NGW, t = m & (SEQL - 1);
            const bf16* ob = OB + (size_t)m * 1024 + h * 256 + e0;
            a[u] = *(const v4u*)ob; b[u] = *(const v4u*)(ob + 128);
            const bf16* pr = PROJ + (size_t)m * INC + c0;
            const int o1 = t >= 1 ? INC : 0, o2 = t >= 2 ? 2 * INC : 0;
            f1[u] = t >= 1 ? 1.f : 0.f; f2[u] = t >= 2 ? 1.f : 0.f;
            cb[u] = *(const v2u*)(pr + 2304);
            cc[u][2] = *(const v2u*)(pr + 2560); ch[u][2] = *(const v2u*)(pr + 2816);
            cc[u][1] = *(const v2u*)(pr - o1 + 2560); ch[u][1] = *(const v2u*)(pr - o1 + 2816);
            cc[u][0] = *(const v2u*)(pr - o2 + 2560); ch[u][0] = *(const v2u*)(pr - o2 + 2816);
        }
#pragma unroll
        for (int u = 0; u < UR; ++u) {
            const int m = mb + u * NGW;
            float o[8];
#pragma unroll
            for (int i = 0; i < 4; ++i) { o[2 * i] = bflo(a[u][i]) - lam * bflo(b[u][i]); o[2 * i + 1] = bfhi(a[u][i]) - lam * bfhi(b[u][i]); }
            float ss = 0.f;
#pragma unroll
            for (int i = 0; i < 8; ++i) ss += o[i] * o[i];
            ss += __shfl_xor(ss, 1); ss += __shfl_xor(ss, 2); ss += __shfl_xor(ss, 4); ss += __shfl_xor(ss, 8);
            const float rs = osc / sqrtf(ss * (1.0f / 128.0f) + 1e-5f);
            v4u w; w.x = pk2(o[0] * rs * g0[0], o[1] * rs * g0[1]); w.y = pk2(o[2] * rs * g0[2], o[3] * rs * g0[3]); w.z = pk2(o[4] * rs * g1[0], o[5] * rs * g1[1]); w.w = pk2(o[6] * rs * g1[2], o[7] * rs * g1[3]);
            *(v4u*)(MIX + (size_t)m * 1024 + 256 + h * 128 + e0) = w;
            f32x4 acc;
            acc[0] = w2[0] * bflo(cc[u][2][0]) * bflo(ch[u][2][0]); acc[1] = w2[1] * bfhi(cc[u][2][0]) * bfhi(ch[u][2][0]); acc[2] = w2[2] * bflo(cc[u][2][1]) * bflo(ch[u][2][1]); acc[3] = w2[3] * bfhi(cc[u][2][1]) * bfhi(ch[u][2][1]);
            { const f32x4 ww = w1 * f1[u];
              acc[0] += ww[0] * bflo(cc[u][1][0]) * bflo(ch[u][1][0]); acc[1] += ww[1] * bfhi(cc[u][1][0]) * bfhi(ch[u][1][0]); acc[2] += ww[2] * bflo(cc[u][1][1]) * bflo(ch[u][1][1]); acc[3] += ww[3] * bfhi(cc[u][1][1]) * bfhi(ch[u][1][1]); }
            { const f32x4 ww = w0 * f2[u];
              acc[0] += ww[0] * bflo(cc[u][0][0]) * bflo(ch[u][0][0]); acc[1] += ww[1] * bfhi(cc[u][0][0]) * bfhi(ch[u][0][0]); acc[2] += ww[2] * bflo(cc[u][0][1]) * bflo(ch[u][0][1]); acc[3] += ww[3] * bfhi(cc[u][0][1]) * bfhi(ch[u][0][1]); }
            v2u oc; oc.x = pk2(bflo(cb[u][0]) * acc[0], bfhi(cb[u][0]) * acc[1]); oc.y = pk2(bflo(cb[u][1]) * acc[2], bfhi(cb[u][1]) * acc[3]);
            *(v2u*)(MIX + (size_t)m * 1024 + 768 + c0) = oc;
        }
    }
}

__device__ __forceinline__ void p_final(Frame& F, float* dst) {
    { int t_ = threadIdx.x; asm volatile("" : "+v"(t_)); F.tid = t_; F.lane = t_ & 63; }
    const int gw = F.vcu * NWAVES + F.wave, NGW = F.G * NWAVES;
    const bf16* XBp = (const bf16*)(F.ws + WS_XB);
    const f32x4* gp = (const f32x4*)karg_in(15) + 2 * F.lane; f32x4 g[4];
#pragma unroll
    for (int j = 0; j < 2; ++j) { g[2 * j] = gp[128 * j]; g[2 * j + 1] = gp[128 * j + 1]; }
    for (int mb = gw; mb < M; mb += 2 * NGW) {
        v4u raw[2][2];
#pragma unroll
        for (int u = 0; u < 2; ++u)
#pragma unroll
            for (int j = 0; j < 2; ++j) raw[u][j] = *((const v4u*)(XBp + (size_t)(mb + u * NGW) * DMOD) + F.lane + 64 * j);
#pragma unroll
        for (int u = 0; u < 2; ++u) {
            f32x4 v[4]; float s = 0.f;
#pragma unroll
            for (int j = 0; j < 2; ++j) { const v4u r = raw[u][j];
                v[2 * j] = (f32x4){bflo(r.x), bfhi(r.x), bflo(r.y), bfhi(r.y)}; v[2 * j + 1] = (f32x4){bflo(r.z), bfhi(r.z), bflo(r.w), bfhi(r.w)}; }
#pragma unroll
            for (int j = 0; j < 4; ++j) s += (v[j].x * v[j].x + v[j].y * v[j].y) + (v[j].z * v[j].z + v[j].w * v[j].w);
            const float rs = 1.0f / sqrtf(wave_sum(s) * (1.0f / DMOD) + 1e-6f);
            f32x4* dr = (f32x4*)(dst + (size_t)(mb + u * NGW) * DMOD) + 2 * F.lane;
#pragma unroll
            for (int j = 0; j < 2; ++j) { dr[128 * j] = v[2 * j] * rs * g[2 * j]; dr[128 * j + 1] = v[2 * j + 1] * rs * g[2 * j + 1]; }
        }
    }
}

__device__ const unsigned short ATT_SCHED[256][8] = {
  {7,2,0,65535,65535,65535,65535,65535},{15,10,8,65535,65535,65535,65535,65535},{6,259,512,65535,65535,65535,65535,65535},{14,267,520,65535,65535,65535,65535,65535},
  {5,1,517,65535,65535,65535,65535,65535},{13,9,525,65535,65535,65535,65535,65535},{251,519,763,65535,65535,65535,65535,65535},{23,18,16,65535,65535,65535,65535,65535},
  {31,26,24,65535,65535,65535,65535,65535},{22,275,528,65535,65535,65535,65535,65535},{30,283,536,65535,65535,65535,65535,65535},{21,17,533,65535,65535,65535,65535,65535},
  {29,25,541,65535,65535,65535,65535,65535},{139,527,651,65535,65535,65535,65535,65535},{39,34,32,65535,65535,65535,65535,65535},{47,42,40,65535,65535,65535,65535,65535},
  {38,291,544,65535,65535,65535,65535,65535},{46,299,552,65535,65535,65535,65535,65535},{37,33,549,65535,65535,65535,65535,65535},{45,41,557,65535,65535,65535,65535,65535},
  {3,535,515,65535,65535,65535,65535,65535},{55,50,48,65535,65535,65535,65535,65535},{63,58,56,65535,65535,65535,65535,65535},{54,307,560,65535,65535,65535,65535,65535},
  {62,315,568,65535,65535,65535,65535,65535},{53,49,565,65535,65535,65535,65535,65535},{61,57,573,65535,65535,65535,65535,65535},{27,543,539,65535,65535,65535,65535,65535},
  {71,66,64,65535,65535,65535,65535,65535},{79,74,72,65535,65535,65535,65535,65535},{70,323,576,65535,65535,65535,65535,65535},{78,331,584,65535,65535,65535,65535,65535},
  {69,65,581,65535,65535,65535,65535,65535},{77,73,589,65535,65535,65535,65535,65535},{83,551,595,65535,65535,65535,65535,65535},{87,82,80,65535,65535,65535,65535,65535},
  {95,90,88,65535,65535,65535,65535,65535},{86,339,592,65535,65535,65535,65535,65535},{94,347,600,65535,65535,65535,65535,65535},{85,81,597,65535,65535,65535,65535,65535},
  {93,89,605,65535,65535,65535,65535,65535},{107,559,619,65535,65535,65535,65535,65535},{103,98,96,65535,65535,65535,65535,65535},{111,106,104,65535,65535,65535,65535,65535},
  {102,355,608,65535,65535,65535,65535,65535},{110,363,616,65535,65535,65535,65535,65535},{101,97,613,65535,65535,65535,65535,65535},{109,105,621,65535,65535,65535,65535,65535},
  {227,567,739,65535,65535,65535,65535,65535},{119,114,112,65535,65535,65535,65535,65535},{127,122,120,65535,65535,65535,65535,65535},{118,371,624,65535,65535,65535,65535,65535},
  {126,379,632,65535,65535,65535,65535,65535},{117,113,629,65535,65535,65535,65535,65535},{125,121,637,65535,65535,65535,65535,65535},{11,575,523,65535,65535,65535,65535,65535},
  {135,130,128,65535,65535,65535,65535,65535},{143,138,136,65535,65535,65535,65535,65535},{134,387,640,65535,65535,65535,65535,65535},{142,395,648,65535,65535,65535,65535,65535},
  {133,129,645,65535,65535,65535,65535,65535},{141,137,653,65535,65535,65535,65535,65535},{179,583,691,65535,65535,65535,65535,65535},{151,146,144,65535,65535,65535,65535,65535},
  {159,154,152,65535,65535,65535,65535,65535},{150,403,656,65535,65535,65535,65535,65535},{158,411,664,65535,65535,65535,65535,65535},{149,145,661,65535,65535,65535,65535,65535},
  {157,153,669,65535,65535,65535,65535,65535},{51,591,563,65535,65535,65535,65535,65535},{167,162,160,65535,65535,65535,65535,65535},{175,170,168,65535,65535,65535,65535,65535},
  {166,419,672,65535,65535,65535,65535,65535},{174,427,680,65535,65535,65535,65535,65535},{165,161,677,65535,65535,65535,65535,65535},{173,169,685,65535,65535,65535,65535,65535},
  {131,599,643,65535,65535,65535,65535,65535},{183,178,176,65535,65535,65535,65535,65535},{191,186,184,65535,65535,65535,65535,65535},{182,435,688,65535,65535,65535,65535,65535},
  {190,443,696,65535,65535,65535,65535,65535},{181,177,693,65535,65535,65535,65535,65535},{189,185,701,65535,65535,65535,65535,65535},{123,607,635,65535,65535,65535,65535,65535},
  {199,194,192,65535,65535,65535,65535,65535},{207,202,200,65535,65535,65535,65535,65535},{198,451,704,65535,65535,65535,65535,65535},{206,459,712,65535,65535,65535,65535,65535},
  {197,193,709,65535,65535,65535,65535,65535},{205,201,717,65535,65535,65535,65535,65535},{187,615,699,65535,65535,65535,65535,65535},{215,210,208,65535,65535,65535,65535,65535},
  {223,218,216,65535,65535,65535,65535,65535},{214,467,720,65535,65535,65535,65535,65535},{222,475,728,65535,65535,65535,65535,65535},{213,209,725,65535,65535,65535,65535,65535},
  {221,217,733,65535,65535,65535,65535,65535},{147,623,659,65535,65535,65535,65535,65535},{231,226,224,65535,65535,65535,65535,65535},{239,234,232,65535,65535,65535,65535,65535},
  {230,483,736,65535,65535,65535,65535,65535},{238,491,744,65535,65535,65535,65535,65535},{229,225,741,65535,65535,65535,65535,65535},{237,233,749,65535,65535,65535,65535,65535},
  {59,631,571,65535,65535,65535,65535,65535},{247,242,240,65535,65535,65535,65535,65535},{255,250,248,65535,65535,65535,65535,65535},{246,499,752,65535,65535,65535,65535,65535},
  {254,507,760,65535,65535,65535,65535,65535},{245,241,757,65535,65535,65535,65535,65535},{253,249,765,65535,65535,65535,65535,65535},{75,639,587,65535,65535,65535,65535,65535},
  {263,258,256,65535,65535,65535,65535,65535},{271,266,264,65535,65535,65535,65535,65535},{262,257,516,65535,65535,65535,65535,65535},{270,265,524,65535,65535,65535,65535,65535},
  {261,534,529,65535,65535,65535,65535,65535},{269,574,569,65535,65535,65535,65535,65535},{163,647,675,65535,65535,65535,65535,65535},{4,260,514,65535,65535,65535,65535,65535},
  {12,268,522,65535,65535,65535,65535,65535},{279,274,272,65535,65535,65535,65535,65535},{287,282,280,65535,65535,65535,65535,65535},{278,273,532,65535,65535,65535,65535,65535},
  {286,281,540,65535,65535,65535,65535,65535},{285,542,537,65535,65535,65535,65535,65535},{277,750,745,65535,65535,65535,65535,65535},{203,655,715,65535,65535,65535,65535,65535},
  {20,276,530,65535,65535,65535,65535,65535},{28,284,538,65535,65535,65535,65535,65535},{295,290,288,65535,65535,65535,65535,65535},{303,298,296,65535,65535,65535,65535,65535},
  {294,289,548,65535,65535,65535,65535,65535},{302,297,556,65535,65535,65535,65535,65535},{301,686,681,65535,65535,65535,65535,65535},{293,710,705,65535,65535,65535,65535,65535},
  {219,663,731,65535,65535,65535,65535,65535},{36,292,546,65535,65535,65535,65535,65535},{44,300,554,65535,65535,65535,65535,65535},{311,306,304,65535,65535,65535,65535,65535},
  {319,314,312,65535,65535,65535,65535,65535},{310,305,564,65535,65535,65535,65535,65535},{318,313,572,65535,65535,65535,65535,65535},{309,590,585,65535,65535,65535,65535,65535},
  {317,630,625,65535,65535,65535,65535,65535},{99,671,611,65535,65535,65535,65535,65535},{52,308,562,65535,65535,65535,65535,65535},{60,316,570,65535,65535,65535,65535,65535},
  {327,322,320,65535,65535,65535,65535,65535},{335,330,328,65535,65535,65535,65535,65535},{326,321,580,65535,65535,65535,65535,65535},{334,329,588,65535,65535,65535,65535,65535},
  {333,638,633,65535,65535,65535,65535,65535},{325,678,673,65535,65535,65535,65535,65535},{67,679,579,65535,65535,65535,65535,65535},{68,324,578,65535,65535,65535,65535,65535},
  {76,332,586,65535,65535,65535,65535,65535},{343,338,336,65535,65535,65535,65535,65535},{351,346,344,65535,65535,65535,65535,65535},{342,337,596,65535,65535,65535,65535,65535},
  {350,345,604,65535,65535,65535,65535,65535},{341,550,545,65535,65535,65535,65535,65535},{349,726,721,65535,65535,65535,65535,65535},{43,687,555,65535,65535,65535,65535,65535},
  {84,340,594,65535,65535,65535,65535,65535},{92,348,602,65535,65535,65535,65535,65535},{359,354,352,65535,65535,65535,65535,65535},{367,362,360,65535,65535,65535,65535,65535},
  {358,353,612,65535,65535,65535,65535,65535},{366,361,620,65535,65535,65535,65535,65535},{365,558,553,65535,65535,65535,65535,65535},{357,670,665,65535,65535,65535,65535,65535},
  {243,695,755,65535,65535,65535,65535,65535},{100,356,610,65535,65535,65535,65535,65535},{108,364,618,65535,65535,65535,65535,65535},{375,370,368,65535,65535,65535,65535,65535},
  {383,378,376,65535,65535,65535,65535,65535},{374,369,628,65535,65535,65535,65535,65535},{382,377,636,65535,65535,65535,65535,65535},{381,606,601,65535,65535,65535,65535,65535},
  {373,702,697,65535,65535,65535,65535,65535},{115,703,627,65535,65535,65535,65535,65535},{116,372,626,65535,65535,65535,65535,65535},{124,380,634,65535,65535,65535,65535,65535},
  {391,386,384,65535,65535,65535,65535,65535},{399,394,392,65535,65535,65535,65535,65535},{390,385,644,65535,65535,65535,65535,65535},{398,393,652,65535,65535,65535,65535,65535},
  {397,526,521,65535,65535,65535,65535,65535},{389,598,593,65535,65535,65535,65535,65535},{35,711,547,65535,65535,65535,65535,65535},{132,388,642,65535,65535,65535,65535,65535},
  {140,396,650,65535,65535,65535,65535,65535},{407,402,400,65535,65535,65535,65535,65535},{415,410,408,65535,65535,65535,65535,65535},{406,401,660,65535,65535,65535,65535,65535},
  {414,409,668,65535,65535,65535,65535,65535},{405,622,617,65535,65535,65535,65535,65535},{413,734,729,65535,65535,65535,65535,65535},{235,719,747,65535,65535,65535,65535,65535},
  {148,404,658,65535,65535,65535,65535,65535},{156,412,666,65535,65535,65535,65535,65535},{423,418,416,65535,65535,65535,65535,65535},{431,426,424,65535,65535,65535,65535,65535},
  {422,417,676,65535,65535,65535,65535,65535},{430,425,684,65535,65535,65535,65535,65535},{421,646,641,65535,65535,65535,65535,65535},{429,758,753,65535,65535,65535,65535,65535},
  {91,727,603,65535,65535,65535,65535,65535},{164,420,674,65535,65535,65535,65535,65535},{172,428,682,65535,65535,65535,65535,65535},{439,434,432,65535,65535,65535,65535,65535},
  {447,442,440,65535,65535,65535,65535,65535},{438,433,692,65535,65535,65535,65535,65535},{446,441,700,65535,65535,65535,65535,65535},{437,582,577,65535,65535,65535,65535,65535},
  {445,614,609,65535,65535,65535,65535,65535},{155,735,667,65535,65535,65535,65535,65535},{180,436,690,65535,65535,65535,65535,65535},{188,444,698,65535,65535,65535,65535,65535},
  {455,450,448,65535,65535,65535,65535,65535},{463,458,456,65535,65535,65535,65535,65535},{454,449,708,65535,65535,65535,65535,65535},{462,457,716,65535,65535,65535,65535,65535},
  {461,654,649,65535,65535,65535,65535,65535},{453,742,737,65535,65535,65535,65535,65535},{195,743,707,65535,65535,65535,65535,65535},{196,452,706,65535,65535,65535,65535,65535},
  {204,460,714,65535,65535,65535,65535,65535},{471,466,464,65535,65535,65535,65535,65535},{479,474,472,65535,65535,65535,65535,65535},{470,465,724,65535,65535,65535,65535,65535},
  {478,473,732,65535,65535,65535,65535,65535},{477,662,657,65535,65535,65535,65535,65535},{469,766,761,65535,65535,65535,65535,65535},{19,751,531,65535,65535,65535,65535,65535},
  {212,468,722,65535,65535,65535,65535,65535},{220,476,730,65535,65535,65535,65535,65535},{487,482,480,65535,65535,65535,65535,65535},{495,490,488,65535,65535,65535,65535,65535},
  {486,481,740,65535,65535,65535,65535,65535},{494,489,748,65535,65535,65535,65535,65535},{485,566,561,65535,65535,65535,65535,65535},{493,718,713,65535,65535,65535,65535,65535},
  {171,759,683,65535,65535,65535,65535,65535},{228,484,738,65535,65535,65535,65535,65535},{236,492,746,65535,65535,65535,65535,65535},{503,498,496,65535,65535,65535,65535,65535},
  {511,506,504,65535,65535,65535,65535,65535},{502,497,756,65535,65535,65535,65535,65535},{510,505,764,65535,65535,65535,65535,65535},{509,518,513,65535,65535,65535,65535,65535},
  {501,694,689,65535,65535,65535,65535,65535},{211,767,723,65535,65535,65535,65535,65535},{244,500,754,65535,65535,65535,65535,65535},{252,508,762,65535,65535,65535,65535,65535},
};

__device__ __forceinline__ attn_b::BlockRef bref(const attn_b::bf16* PROJ, attn_b::bf16* OB, int id) {
    const int qb = id & 7, pr = (id >> 3) & 1, h = (id >> 4) & 3, b = id >> 6;
    attn_b::BlockRef r; const size_t row0 = (size_t)b * SEQL;
    r.Q = PROJ + (row0 + qb * 256) * INC + 768 + h * 128 + pr * 64;
    r.K = PROJ + row0 * INC + 1280 + h * 128 + pr * 64;
    r.V = PROJ + row0 * INC + 1792 + h * 128;
    r.O = OB + (row0 + qb * 256) * 1024 + h * 256 + pr * 128;
    r.P0 = qb * 256;
    return r;
}
__device__ __forceinline__ void p_attention(Frame& F, unsigned char* ldsg, int kind = 0) {
    using abf = attn_body::bf16;
    const abf* PROJ = (const abf*)(F.ws + WS_PROJ); abf* OB = (abf*)(F.ws + WS_OB); abf* MIX = (abf*)(F.ws + WS_MIX);
    { int t_ = threadIdx.x; asm volatile("" : "+v"(t_)); LAS float* tb = (LAS float*)(F.lds + DMASK_TBL_OFF);
      for (int x = t_; x < attn_body::DMASK_TBL_N; x += NWAVES * 64) tb[x] = attn_body::dwl(2047 - x);
      __syncthreads(); }
    const unsigned tbl = (unsigned)(uintptr_t)(ldsg + DMASK_TBL_OFF);
    constexpr int NSL = 8;
    const bool tab = (F.G == 256);
    auto unit_id = [&](int i) -> int { if (tab) return i < NSL ? (int)ATT_SCHED[F.vcu][i] : 0xFFFF; const int id = F.vcu + i * F.G; return id < 768 ? id : 0xFFFF; };
    if (kind != 1) {
        int i = 0, id = unit_id(0);
        while (id != 0xFFFF && id >= 512) id = unit_id(++i);
        if (id != 0xFFFF) {
            attn_b::Seam S; attn_b::BlockRef cur = bref(PROJ, OB, id);
            attn_b::causal_prime(cur, (char*)ldsg, S);
            for (;;) {
                int idn = unit_id(++i);
                while (idn != 0xFFFF && idn >= 512) idn = unit_id(++i);
                const bool last = (idn == 0xFFFF);
                const attn_b::BlockRef nxt = last ? cur : bref(PROJ, OB, idn);
#if defined(PRB_ABL) && PRB_ABL > 0
                if (kind == 2) attn_b::causal_block<PRB_ABL>(cur, nxt, (char*)ldsg, S); else
#endif
                attn_b::causal_block<0>(cur, nxt, (char*)ldsg, S);
                if (last) break;
                cur = nxt;
            }
        }
    }
    if (kind != 2) {
        for (int i = 0;; ++i) {
            const int id = unit_id(i);
            if (id == 0xFFFF) break;
            if (id < 512) continue;
            const int k = id - 512, qb = k & 7, h = (k >> 3) & 3, b = k >> 5;
            attn_body::attn_unit<8, 1>(b, qb, PROJ + h * 64, PROJ + 256 + h * 64, PROJ + 512 + h * 64, MIX + h * 64, 1024, (char*)ldsg, tbl);
        }
    }
}

__global__ void __launch_bounds__(NWAVES * 64, 2) hybrid_fwd(Args args) {
    extern __shared__ __attribute__((aligned(16))) unsigned char lds[];
    Frame F;
    F.lds = (LAS unsigned char*)lds;
    F.tid = threadIdx.x; F.lane = F.tid & 63; F.wave = __builtin_amdgcn_readfirstlane(F.tid >> 6);
    F.G = gridDim.x; { const int bx = blockIdx.x; F.vcu = (F.G % 8 == 0) ? (bx % 8) * (F.G / 8) + bx / 8 : bx; }
    F.out = args.out; F.ws = args.ws;
    const int lo = args.ph_lo, hi = args.ph_hi;
#if MK_N_LAUNCHES == 1
    if (hi > NPHASE) cg::this_grid().sync();
#endif
#if MK_N_LAUNCHES == 1
    for (int u = F.tid; u < 64; u += NWAVES * 64) ((LAS unsigned*)(F.lds + MISC_OFF))[u] = 0u;
    __syncthreads();
    const XcdBarrier bar = xcd_barrier_post((unsigned*)(F.ws + WS_CTL) + CW_BAR, (volatile LAS unsigned*)(F.lds + MISC_OFF) + 8);
#endif
#ifndef DBG_MASK
#define DBG_MASK 0xffffffu
#endif
#define IN(k) (((DBG_MASK >> ((k) > 6 && (k) < 13 ? (k) - 6 : (k))) & 1u) && lo <= (k) && (k) < hi)
#if MK_N_LAUNCHES == 1
#define SEAM(k) do { if (IN(k) && IN((k) + 1)) { xcd_barrier(bar); } } while (0)
#else
#define SEAM(k) do { } while (0)
#endif
    bf16* XB = (bf16*)(F.ws + WS_XB); float* SS = (float*)(F.ws + WS_SS);

#ifndef PRB_P0
#define PRB_P0 0
#endif
#ifndef PRB_IN
#define PRB_IN 0
#endif
#ifndef PRB_ATT
#define PRB_ATT 0
#endif
#ifndef PRB_ATT_KIND
#define PRB_ATT_KIND 0
#endif
#ifndef PRB_CMB
#define PRB_CMB 0
#endif
#ifndef PRB_OUT
#define PRB_OUT 0
#endif
#ifndef PRB_UP
#define PRB_UP 0
#endif
#ifndef PRB_DN
#define PRB_DN 0
#endif
#ifndef PRB_FIN
#define PRB_FIN 0
#endif
#if MK_N_LAUNCHES == 1
#define XSEAM() xcd_barrier(bar)
#else
#define XSEAM() do { } while (0)
#endif
    const bool fuse_final = (MK_N_LAUNCHES == 1) && (F.G == 256) && (PRB_FIN == 0);
    for (int r_ = 0; r_ < PRB_P0; ++r_) { p0_prologue(F); XSEAM(); }
    if (IN(0)) { p0_prologue(F); } SEAM(0);
#ifdef PRB_BAR
    for (int r_ = 0; r_ < PRB_BAR; ++r_) xcd_barrier(bar);
#endif

#pragma unroll 1
    for (int L = 0; L < 2; ++L) {
        const int pb = 1 + 6 * L;
        unsigned char* wl = F.ws + WS_W + (size_t)L * W_LAYER;
        for (int r_ = 0; r_ < ((L == 0) ? 1 + PRB_IN : 1); ++r_) {
        if (r_) XSEAM();
        if (IN(pb)) {
            pg8::Gemm g{XB, (const bf16*)(wl + W_IN_OFF), DMOD, 256}; pg8::StaticOrder S; S.init(M / 256, INC / 256, F.G, (int)blockIdx.x);
            pg8::EpiInProj E{(bf16*)(F.ws + WS_PROJ), SS, (const float*)(F.ws + WS_ROPE), (LAS float*)(F.lds + LRSTD_OFF), (LAS float*)(F.lds + LROPE_OFF)};
            pg8::gemm_phase<pg8::EpiInProj, pg8::StaticOrder, true, true>(F.lds + RING_OFF, g, S, E);
        }
        }
        SEAM(pb);
        for (int r_ = 0; r_ < ((L == 0) ? 1 + PRB_ATT : 1); ++r_) { if (r_) XSEAM(); if (IN(pb + 1)) { p_attention(F, lds + RING_OFF, (r_ + 1 < ((L == 0) ? 1 + PRB_ATT : 1)) ? PRB_ATT_KIND : 0); } }
        if (IN(pb + 1) && L == 0) { __syncthreads(); p0_convert_layer(F, 0, F.vcu * NWAVES + F.wave, F.G * NWAVES, 2); }
        SEAM(pb + 1);
        for (int r_ = 0; r_ < ((L == 0) ? 1 + PRB_CMB : 1); ++r_) { if (r_) XSEAM(); if (IN(pb + 2)) { p_combine(F, L); } }
        SEAM(pb + 2);
        for (int r_ = 0, nr_ = ((L == 0) ? 1 + PRB_OUT : 1); r_ < nr_; ++r_) {
        if (r_) XSEAM();
        if (IN(pb + 3)) {
            pg8::Gemm g{(const bf16*)(F.ws + WS_MIX), (const bf16*)(wl + W_OUT_OFF), DMOD, 256}; pg8::StaticOrder S; S.init(M / 256, DMOD / 256, F.G, (int)blockIdx.x);
            pg8::EpiResid E{XB, (r_ + 1 < nr_) ? (bf16*)(F.ws + WS_PROJ) : XB, SS};
            pg8::gemm_phase<pg8::EpiResid, pg8::StaticOrder, true, true>(F.lds + RING_OFF, g, S, E);
        }
        }
        SEAM(pb + 3);
        for (int r_ = 0; r_ < ((L == 0) ? 1 + PRB_UP : 1); ++r_) {
        if (r_) XSEAM();
        if (IN(pb + 4)) {
            pg8::Gemm g{XB - 2 * DMOD, (const bf16*)(wl + W_UP_OFF), DMOD, 254}; pg8::StaticOrder S; S.init(NMT_UP, 2 * DFF / 256, F.G, (int)blockIdx.x);
            pg8::EpiGlu E{(bf16*)(F.ws + WS_ACT), SS, karg_in(13) + (size_t)L * 3 * DFF, (LAS float*)(F.lds + HALO_OFF), (LAS float*)(F.lds + LRSTD_OFF), (LAS float*)(F.lds + LCW_OFF)};
            pg8::gemm_phase<pg8::EpiGlu, pg8::StaticOrder, true, true>(F.lds + RING_OFF, g, S, E);
            if (L == 0 && r_ == 0) { const int nfull = NMT_UP * (2 * DFF / 256) - (NMT_UP * (2 * DFF / 256) / F.G) * F.G;
                if (nfull > 0 && nfull < F.G) { if ((int)blockIdx.x >= nfull) p0_convert_layer(F, 1, ((int)blockIdx.x - nfull) * NWAVES + F.wave, (F.G - nfull) * NWAVES); }
                else p0_convert_layer(F, 1, F.vcu * NWAVES + F.wave, F.G * NWAVES); }
        }
        }
        SEAM(pb + 4);
        for (int r_ = 0, nr_ = ((L == 0) ? 1 + PRB_DN : 1); r_ < nr_; ++r_) {
        if (r_) XSEAM();
        if (IN(pb + 5)) {
            pg8::Gemm g{(const bf16*)(F.ws + WS_ACT), (const bf16*)(wl + W_DOWN_OFF), DFF, 256}; pg8::StaticOrder S; S.init(M / 256, DMOD / 256, F.G, (int)blockIdx.x);
            if (L == 1 && r_ + 1 == nr_ && fuse_final) {
                pg8::EpiResidFinal E{XB, F.out, SS, karg_in(15), (unsigned*)(F.ws + WS_CTL) + CW_PANEL, (LAS unsigned*)(F.lds + MISC_OFF) + 20};
                pg8::gemm_phase<pg8::EpiResidFinal, pg8::StaticOrder, true, true>(F.lds + RING_OFF, g, S, E);
            } else {
            pg8::EpiResid E{XB, (r_ + 1 < nr_) ? (bf16*)(F.ws + WS_OB) : XB, SS};
            pg8::gemm_phase<pg8::EpiResid, pg8::StaticOrder, true, true>(F.lds + RING_OFF, g, S, E);
            }
        }
        }
        if (!(L == 1 && fuse_final)) SEAM(pb + 5);
    }
    for (int r_ = 0; r_ < PRB_FIN; ++r_) { p_final(F, (float*)(F.ws + WS_OB)); XSEAM(); }
    if (IN(13) && !fuse_final) { p_final(F, F.out); }
#undef IN
#undef SEAM
}

extern "C" void kernel_launch(void* const* d_in, const int* in_sizes, int n_in, void* d_out, int out_size, void* d_ws, size_t ws_size, hipStream_t stream) {
    static int grid = 0;
    if (grid == 0) {
        if (n_in != 16 || in_sizes[0] != M * DMOD || out_size != M * DMOD || ws_size < WS_END) { fprintf(stderr, "kernel_launch: unexpected shapes (n_in %d, in0 %d, out %d, ws %zu)\n", n_in, n_in > 0 ? in_sizes[0] : -1, out_size, ws_size); grid = -1; return; }
        int dev = 0, cus = 0, per_cu = 0;
        if (hipGetDevice(&dev) != hipSuccess || hipDeviceGetAttribute(&cus, hipDeviceAttributeMultiprocessorCount, dev) != hipSuccess) { grid = -1; return; }
        if (hipFuncSetAttribute((const void*)hybrid_fwd, hipFuncAttributeMaxDynamicSharedMemorySize, LDS_BYTES) != hipSuccess) { fprintf(stderr, "kernel_launch: hipFuncSetAttribute failed\n"); grid = -1; return; }
        if (hipOccupancyMaxActiveBlocksPerMultiprocessor(&per_cu, (const void*)hybrid_fwd, NWAVES * 64, LDS_BYTES) != hipSuccess || per_cu < 1) { fprintf(stderr, "kernel_launch: occupancy query says %d blocks per CU\n", per_cu); per_cu = 1; }
        (void)hipGetLastError();
        grid = cus;
    }
    if (grid < 0) return;
    Args a{};
    for (int i = 0; i < 16; ++i) a.in[i] = (const float*)d_in[i];
    a.out = (float*)d_out; a.ws = (unsigned char*)d_ws;
#if MK_N_LAUNCHES == 1
    if (hipMemsetAsync((char*)d_ws + WS_CTL, 0, CTL_ZERO_BYTES, stream) != hipSuccess) { fprintf(stderr, "kernel_launch: memset of the control words failed\n"); return; }
    a.ph_lo = 0; a.ph_hi = NPHASE;
    void* kargs[] = {&a};
    hipError_t e = hipLaunchCooperativeKernel((const void*)hybrid_fwd, dim3(grid), dim3(NWAVES * 64), kargs, LDS_BYTES, stream);
    if (e != hipSuccess) fprintf(stderr, "kernel_launch: cooperative launch failed: %s (grid %d)\n", hipGetErrorString(e), grid);
#else
    for (int p = 0; p < NPHASE; ++p) {
        a.ph_lo = p; a.ph_hi = p + 1;
        hipLaunchKernelGGL(hybrid_fwd, dim3(grid), dim3(NWAVES * 64), LDS_BYTES, stream, a);
    }
#endif
}
```

```cpp
#include <hip/hip_runtime.h>
#include <hip/hip_cooperative_groups.h>
#include <hip/hip_bf16.h>
#include <cstdio>
#include <cstdint>
#include <cmath>
namespace pg8 {
#define PG8_LAS __attribute__((address_space(3)))
typedef unsigned short bf16_t;
typedef short bf16x8 __attribute__((ext_vector_type(8)));
typedef float f32x4 __attribute__((ext_vector_type(4)));
typedef unsigned u32x4 __attribute__((ext_vector_type(4)));
constexpr int BM = 256, BK = 64, HALF = 128, HTB = HALF * BK * 2  , STAGE_BYTES = 8 * HTB, NXCD = 8, WGM = 8;

__host__ __device__ __forceinline__ int lds_byte(int r, int c) { const int st = (r >> 4) * 2 + (c >> 5), rr = r & 15, cc = c & 31, ob = rr * 64 + cc * 2; return st * 1024 + (ob ^ (((ob >> 9) & 1) << 5)); }
__host__ __device__ __forceinline__ void stage_rc(int b, int& R, int& C) { const int st = b / 1024, sb = b % 1024, swz = sb ^ (((sb >> 9) & 1) << 5); R = (st >> 1) * 16 + swz / 64; C = (st & 1) * 32 + (swz % 64) / 2; }
__host__ __device__ __forceinline__ int perm32(int rho) { const int n = rho >> 4, i = rho & 15; return 8 * (i >> 2) + 4 * n + (i & 3); }

struct Unit { int pm, pn; };
struct Gemm { const bf16_t* A; const bf16_t* Bt; int K; int a_rows; };

struct StaticOrder {
    int nM, nN, nwg, G, c;
    __host__ __device__ void init(int nM_, int nN_, int G_, int c_) { nM = nM_; nN = nN_; nwg = nM * nN; G = G_; c = c_; }
    __host__ __device__ bool next(int i, Unit& u) const {
        const long L = (long)i * G + c; if (L >= nwg) return false;
        int wgid = (int)L; { const int q = nwg / NXCD, r = nwg % NXCD, xcd = wgid % NXCD, off = wgid / NXCD; wgid = (xcd < r ? xcd * (q + 1) : r * (q + 1) + (xcd - r) * q) + off; }
        const int nig = WGM * nN, gid = wgid / nig, fm = gid * WGM, gsz = (nM - fm) < WGM ? (nM - fm) : WGM;
        u.pm = fm + ((wgid % nig) % gsz); u.pn = (wgid % nig) / gsz; return true;
    }
    __device__ __forceinline__ void a_ready(const Unit&) const {}
    __device__ __forceinline__ void done(const Unit&) const {}
};


__device__ __forceinline__ unsigned cvt_pk_bf16(float lo, float hi) { unsigned r; asm volatile("v_cvt_pk_bf16_f32 %0, %1, %2" : "=v"(r) : "v"(lo), "v"(hi)); return r; }
constexpr int MROWS = 16384, DMODEL = 1024;
constexpr float QK_C2 = 0.125f * 1.4426950408889634f;

__device__ __forceinline__ f32x4 rstd_load(const float* SS, int row, int fq) { return *(const f32x4*)(SS + (size_t)row * 16 + 4 * fq); }
__device__ __forceinline__ float rstd_finish(f32x4 a) {
    float s = (a[0] + a[1]) + (a[2] + a[3]);
    s += __shfl_xor(s, 16); s += __shfl_xor(s, 32);
    return __builtin_amdgcn_rsqf(s * (1.0f / 1024.0f) + 1e-6f);
}

struct NoPrep { };
struct EpiInProj {
    static constexpr bool PERM = true, AFTER_DRAIN = false, HAS_INIT = false, HAS_PREP = true;
    bf16_t* O; const float* SS; const float* rope;
    PG8_LAS float* lrstd; PG8_LAS float* lrope;
    struct Prep { f32x4 s0, s1, r0, r1; };
    static __device__ __forceinline__ bool tile_rope(int pn) { return (pn <= 1) || (pn >= 3 && pn <= 6); }
    __device__ __forceinline__ void prep_load(Prep& P, const Unit& u, int tid) const {
        asm volatile("" : "+v"(tid));
        const int row = u.pm * BM + (tid >> 1), h = tid & 1;
        const f32x4* sp = (const f32x4*)(SS + (size_t)row * 16 + 8 * h); P.s0 = sp[0]; P.s1 = sp[1];
        const f32x4* rp = (const f32x4*)(rope + (size_t)row * 16 + 8 * h); P.r0 = rp[0]; P.r1 = rp[1];
    }
    __device__ __forceinline__ void prep_store(const Prep& P, const Unit& u, int tid) const {
        asm volatile("" : "+v"(tid));
        float s = ((P.s0[0] + P.s0[1]) + (P.s0[2] + P.s0[3])) + ((P.s1[0] + P.s1[1]) + (P.s1[2] + P.s1[3]));
        s += __shfl_xor(s, 1);
        if ((tid & 1) == 0) lrstd[tid >> 1] = __builtin_amdgcn_rsqf(s * (1.0f / 1024.0f) + 1e-6f);
        PG8_LAS f32x4* d = (PG8_LAS f32x4*)(lrope + (tid >> 1) * 16 + 8 * (tid & 1)); d[0] = P.r0; d[1] = P.r1;
    }
    __device__ __forceinline__ void operator()(f32x4 (&acc)[2][2][4][2], const Unit& u, const Unit& nxt, bool has_next, int wr, int wc, int fr, int fq, int tid) const {
        Prep P;
        asm volatile("" : "+v"(fr), "+v"(fq));
        const int pn = u.pn;
        const bool is_q = (pn == 0) || (pn == 3) || (pn == 4);
        const float qs = is_q ? QK_C2 : 1.0f;
        const bool wrot = tile_rope(pn) && ((wc & 1) == 0);
        const bool lrot = wrot && fq < 2;
        const float sgn = (fq == 0) ? -1.0f : 1.0f;
        const int rl0 = wr * 64 + fr, row0 = u.pm * BM + rl0, col0 = pn * BM + wc * 32 + 8 * fq;
#pragma unroll
        for (int ai = 0; ai < 2; ++ai) {
            if (ai == 1 && has_next) prep_load(P, nxt, tid);
#pragma unroll
            for (int m = 0; m < 4; ++m) {
                const int rl = rl0 + ai * HALF + m * 16;
                const float rs = lrstd[rl] * qs;
                const PG8_LAS f32x4* rp = (const PG8_LAS f32x4*)(lrope + rl * 16);
                const f32x4 one = {1.f, 1.f, 1.f, 1.f}, zero = {0.f, 0.f, 0.f, 0.f};
                const f32x4 cs0 = lrot ? rp[0] : one, cs1 = lrot ? rp[1] : one, sn0 = lrot ? rp[2] * sgn : zero, sn1 = lrot ? rp[3] * sgn : zero;
#pragma unroll
                for (int bj = 0; bj < 2; ++bj) {
                    f32x4 v0 = acc[ai][bj][m][0] * rs, v1 = acc[ai][bj][m][1] * rs;
                    if (wrot) {
                        f32x4 p0, p1;
#pragma unroll
                        for (int j = 0; j < 4; ++j) { p0[j] = __shfl_xor(v0[j], 16); p1[j] = __shfl_xor(v1[j], 16); }
                        v0 = v0 * cs0 + p0 * sn0; v1 = v1 * cs1 + p1 * sn1;
                    }
                    u32x4 w; w.x = cvt_pk_bf16(v0[0], v0[1]); w.y = cvt_pk_bf16(v0[2], v0[3]); w.z = cvt_pk_bf16(v1[0], v1[1]); w.w = cvt_pk_bf16(v1[2], v1[3]);
                    *(u32x4*)(O + (size_t)(row0 + ai * HALF + m * 16) * 3072 + col0 + bj * HALF) = w;
                }
                if (m & 1) asm volatile("" ::: "memory");
            }
        }
        asm volatile("s_waitcnt lgkmcnt(0)" ::: "memory"); __builtin_amdgcn_s_barrier(); asm volatile("" ::: "memory");
        if (has_next) prep_store(P, nxt, tid);
    }
};

__device__ __forceinline__ void resid_init_load(u32x4 (&raw)[16], const bf16_t* xin, const Unit& u, int wr, int wc, int fr, int fq) {
    const int row0 = u.pm * BM + wr * 64 + fr, col0 = u.pn * BM + wc * 32 + 8 * fq;
#pragma unroll
    for (int ai = 0; ai < 2; ++ai)
#pragma unroll
        for (int m = 0; m < 4; ++m)
#pragma unroll
            for (int bj = 0; bj < 2; ++bj) raw[(ai * 4 + m) * 2 + bj] = *(const u32x4*)(xin + (size_t)(row0 + ai * HALF + m * 16) * DMODEL + col0 + bj * HALF);
}
__device__ __forceinline__ void resid_init_acc(f32x4 (&acc)[2][2][4][2], const u32x4 (&raw)[16]) {
#pragma unroll
    for (int ai = 0; ai < 2; ++ai)
#pragma unroll
        for (int m = 0; m < 4; ++m)
#pragma unroll
            for (int bj = 0; bj < 2; ++bj) { const u32x4 x = raw[(ai * 4 + m) * 2 + bj];
                acc[ai][bj][m][0] = (f32x4){__builtin_bit_cast(float, x.x << 16), __builtin_bit_cast(float, x.x & 0xffff0000u), __builtin_bit_cast(float, x.y << 16), __builtin_bit_cast(float, x.y & 0xffff0000u)};
                acc[ai][bj][m][1] = (f32x4){__builtin_bit_cast(float, x.z << 16), __builtin_bit_cast(float, x.z & 0xffff0000u), __builtin_bit_cast(float, x.w << 16), __builtin_bit_cast(float, x.w & 0xffff0000u)}; }
}

struct EpiResid {
    static constexpr bool PERM = true, AFTER_DRAIN = false, HAS_INIT = true, HAS_PREP = false;
    typedef NoPrep Prep;
    const bf16_t* xin; bf16_t* xo; float* SS;
    __device__ __forceinline__ void init_load(u32x4 (&raw)[16], const Unit& u, int wr, int wc, int fr, int fq) const { resid_init_load(raw, xin, u, wr, wc, fr, fq); }
    __device__ __forceinline__ void init_acc(f32x4 (&acc)[2][2][4][2], const u32x4 (&raw)[16]) const { resid_init_acc(acc, raw); }
    __device__ __forceinline__ void operator()(f32x4 (&acc)[2][2][4][2], const Unit& u, const Unit& nxt, bool has_next, int wr, int wc, int fr, int fq, int tid) const {
        const int row0 = u.pm * BM + wr * 64 + fr, col0 = u.pn * BM + wc * 32 + 8 * fq;
#pragma unroll
        for (int ai = 0; ai < 2; ++ai)
#pragma unroll
            for (int m = 0; m < 4; ++m) {
                const int row = row0 + ai * HALF + m * 16; float ssq = 0.f;
#pragma unroll
                for (int bj = 0; bj < 2; ++bj) {
                    const size_t off = (size_t)row * DMODEL + col0 + bj * HALF;
                    const f32x4 h0 = acc[ai][bj][m][0], h1 = acc[ai][bj][m][1];
                    u32x4 w; w.x = cvt_pk_bf16(h0[0], h0[1]); w.y = cvt_pk_bf16(h0[2], h0[3]); w.z = cvt_pk_bf16(h1[0], h1[1]); w.w = cvt_pk_bf16(h1[2], h1[3]);
                    *(u32x4*)(xo + off) = w;
                    ssq += ((h0[0] * h0[0] + h0[1] * h0[1]) + (h0[2] * h0[2] + h0[3] * h0[3])) + ((h1[0] * h1[0] + h1[1] * h1[1]) + (h1[2] * h1[2] + h1[3] * h1[3]));
                }
                ssq += __shfl_xor(ssq, 16); ssq += __shfl_xor(ssq, 32);
                if (fq == 0) SS[(size_t)row * 16 + u.pn * 4 + wc] = ssq;
            }
    }
};

struct EpiResidFinal {
    static constexpr bool PERM = true, AFTER_DRAIN = false, HAS_INIT = true, HAS_PREP = false;
    typedef NoPrep Prep;
    const bf16_t* xin; float* out; float* SS; const float* g; unsigned* cnt; PG8_LAS unsigned* flag;
    __device__ __forceinline__ void init_load(u32x4 (&raw)[16], const Unit& u, int wr, int wc, int fr, int fq) const { resid_init_load(raw, xin, u, wr, wc, fr, fq); }
    __device__ __forceinline__ void init_acc(f32x4 (&acc)[2][2][4][2], const u32x4 (&raw)[16]) const { resid_init_acc(acc, raw); }
    __device__ __forceinline__ void operator()(f32x4 (&acc)[2][2][4][2], const Unit& u, const Unit& nxt, bool has_next, int wr, int wc, int fr, int fq, int tid) const {
        const int row0 = u.pm * BM + wr * 64 + fr, col0 = u.pn * BM + wc * 32 + 8 * fq;
#pragma unroll
        for (int ai = 0; ai < 2; ++ai) {
#pragma unroll
            for (int m = 0; m < 4; ++m) {
                const int row = row0 + ai * HALF + m * 16; float ssq = 0.f;
#pragma unroll
                for (int bj = 0; bj < 2; ++bj) {
                    const f32x4 h0 = acc[ai][bj][m][0], h1 = acc[ai][bj][m][1];
                    ssq += ((h0[0] * h0[0] + h0[1] * h0[1]) + (h0[2] * h0[2] + h0[3] * h0[3])) + ((h1[0] * h1[0] + h1[1] * h1[1]) + (h1[2] * h1[2] + h1[3] * h1[3]));
                }
                ssq += __shfl_xor(ssq, 16); ssq += __shfl_xor(ssq, 32);
                if (fq == 0) __hip_atomic_store(SS + (size_t)row * 16 + u.pn * 4 + wc, ssq, __ATOMIC_RELAXED, __HIP_MEMORY_SCOPE_AGENT);
            }
        }
        asm volatile("s_waitcnt vmcnt(0)" ::: "memory");
        __builtin_amdgcn_s_barrier(); asm volatile("" ::: "memory");
        if (wr == 0 && wc == 0 && fr == 0 && fq == 0) {
            __hip_atomic_fetch_add(cnt + 64 * u.pm, 1u, __ATOMIC_RELAXED, __HIP_MEMORY_SCOPE_AGENT);
            unsigned spins = 0;
            while (__hip_atomic_load(cnt + 64 * u.pm, __ATOMIC_RELAXED, __HIP_MEMORY_SCOPE_AGENT) < 4u) { __builtin_amdgcn_s_sleep(2); if (++spins > (1u << 22)) break; }
            __builtin_amdgcn_fence(__ATOMIC_ACQUIRE, "agent");
            asm volatile("s_waitcnt vmcnt(0)" ::: "memory");
            flag[0] = 1u;
        }
        asm volatile("s_waitcnt lgkmcnt(0)" ::: "memory"); __builtin_amdgcn_s_barrier(); asm volatile("" ::: "memory");
        f32x4 part[2][4];
#pragma unroll
        for (int ai = 0; ai < 2; ++ai)
#pragma unroll
            for (int m = 0; m < 4; ++m) { float* sp = SS + (size_t)(row0 + ai * HALF + m * 16) * 16 + 4 * fq;
#pragma unroll
                for (int j = 0; j < 4; ++j) part[ai][m][j] = __hip_atomic_load(sp + j, __ATOMIC_RELAXED, __HIP_MEMORY_SCOPE_AGENT); }
        f32x4 gv[2][2];
#pragma unroll
        for (int bj = 0; bj < 2; ++bj) { gv[bj][0] = *(const f32x4*)(g + col0 + bj * HALF); gv[bj][1] = *(const f32x4*)(g + col0 + bj * HALF + 4); }
#pragma unroll
        for (int ai = 0; ai < 2; ++ai)
#pragma unroll
            for (int m = 0; m < 4; ++m) {
                const float rs = rstd_finish(part[ai][m]);
                float* rowp = out + (size_t)(row0 + ai * HALF + m * 16) * DMODEL + col0;
#pragma unroll
                for (int bj = 0; bj < 2; ++bj) { __builtin_nontemporal_store(acc[ai][bj][m][0] * rs * gv[bj][0], (f32x4*)(rowp + bj * HALF)); __builtin_nontemporal_store(acc[ai][bj][m][1] * rs * gv[bj][1], (f32x4*)(rowp + bj * HALF + 4)); }
            }
    }
};

template <int N> __device__ __forceinline__ float dpp_ror(float v) { return __builtin_bit_cast(float, __builtin_amdgcn_update_dpp(0, __builtin_bit_cast(int, v), 0x120 + N, 0xf, 0xf, false)); }

struct EpiGlu {
    static constexpr bool PERM = true, AFTER_DRAIN = false, HAS_INIT = false, HAS_PREP = true;
    bf16_t* ACT; const float* SS; const float* cw;
    PG8_LAS float* halo;
    PG8_LAS float* lrstd;
    PG8_LAS float* lcw;
    struct Prep { f32x4 s0, s1, w; };
    __device__ __forceinline__ void prep_load(Prep& P, const Unit& u, int tid) const {
        asm volatile("" : "+v"(tid));
        int row = u.pm * 254 - 2 + (tid >> 1); row = row < 0 ? 0 : (row >= MROWS ? MROWS - 1 : row);
        const f32x4* sp = (const f32x4*)(SS + (size_t)row * 16 + 8 * (tid & 1)); P.s0 = sp[0]; P.s1 = sp[1];
        if (tid < 96) P.w = *(const f32x4*)(cw + (tid >> 5) * 2816 + u.pn * 128 + 4 * (tid & 31));
    }
    __device__ __forceinline__ void prep_store(const Prep& P, const Unit& u, int tid) const {
        asm volatile("" : "+v"(tid));
        float s = ((P.s0[0] + P.s0[1]) + (P.s0[2] + P.s0[3])) + ((P.s1[0] + P.s1[1]) + (P.s1[2] + P.s1[3]));
        s += __shfl_xor(s, 1);
        if ((tid & 1) == 0) lrstd[tid >> 1] = __builtin_amdgcn_rsqf(s * (1.0f / 1024.0f) + 1e-6f);
        if (tid < 96) *(PG8_LAS f32x4*)(lcw + 4 * tid) = P.w;
    }
    __device__ __forceinline__ void operator()(f32x4 (&acc)[2][2][4][2], const Unit& u, const Unit& nxt, bool has_next, int wr, int wc, int fr, int fq, int tid) const {
        const int lane = fr + 16 * fq;
        const int grow0 = u.pm * 254 - 2;
        const int cl = wc * 32 + 8 * fq;
        const int hcol = u.pn * 128 + cl;
#pragma unroll
        for (int ai = 0; ai < 2; ++ai)
#pragma unroll
            for (int m = 0; m < 4; ++m) {
                const float rs = lrstd[ai * HALF + wr * 64 + m * 16 + fr];
#pragma unroll
                for (int bj = 0; bj < 2; ++bj) { acc[ai][bj][m][0] = acc[ai][bj][m][0] * rs; acc[ai][bj][m][1] = acc[ai][bj][m][1] * rs; }
            }
        const f32x4 w0a = *(const PG8_LAS f32x4*)(lcw + cl), w0b = *(const PG8_LAS f32x4*)(lcw + cl + 4);
        const f32x4 w1a = *(const PG8_LAS f32x4*)(lcw + 128 + cl), w1b = *(const PG8_LAS f32x4*)(lcw + 128 + cl + 4);
        const f32x4 w2a = *(const PG8_LAS f32x4*)(lcw + 256 + cl), w2b = *(const PG8_LAS f32x4*)(lcw + 256 + cl + 4);
        if (fr >= 14) {
#pragma unroll
            for (int ai = 0; ai < 2; ++ai) { PG8_LAS float* hp = halo + ((2 * ai + wr) * 2 + (fr - 14)) * 128 + cl;
                *(PG8_LAS f32x4*)hp = acc[ai][0][3][0]; *(PG8_LAS f32x4*)(hp + 4) = acc[ai][0][3][1]; }
        }
        asm volatile("s_waitcnt lgkmcnt(0)" ::: "memory"); __builtin_amdgcn_s_barrier(); asm volatile("" ::: "memory");
        Prep P;
#pragma unroll
        for (int ai = 0; ai < 2; ++ai) {
            if (ai == 1 && has_next) prep_load(P, nxt, tid);
            const int q = 2 * ai + wr;
            f32x4 pv0 = {0.f, 0.f, 0.f, 0.f}, pv1 = pv0;
            if (fr >= 14 && q > 0) { const PG8_LAS float* hp = halo + ((q - 1) * 2 + (fr - 14)) * 128 + cl; pv0 = *(const PG8_LAS f32x4*)hp; pv1 = *(const PG8_LAS f32x4*)(hp + 4); }
#pragma unroll
            for (int m = 0; m < 4; ++m) {
                const int rl = ai * HALF + wr * 64 + m * 16 + fr, grow = grow0 + rl;
                const int tpos = grow & 2047;
                const f32x4 gp0 = (m == 0) ? pv0 : acc[ai][0][m - 1][0], gp1 = (m == 0) ? pv1 : acc[ai][0][m - 1][1];
                f32x4 r0, r1;
#pragma unroll
                for (int j = 0; j < 4; ++j) {
                    { const float cur = acc[ai][0][m][0][j];
                      float p1 = dpp_ror<1>((fr == 15) ? gp0[j] : cur), p2 = dpp_ror<2>((fr >= 14) ? gp0[j] : cur);
                      if (tpos < 1) p1 = 0.f; if (tpos < 2) p2 = 0.f;
                      const float cv = w0a[j] * p2 + w1a[j] * p1 + w2a[j] * cur;
                      r0[j] = cv * __builtin_amdgcn_rcpf(1.0f + __builtin_amdgcn_exp2f(-1.4426950408889634f * cv)) * acc[ai][1][m][0][j]; }
                    { const float cur = acc[ai][0][m][1][j];
                      float p1 = dpp_ror<1>((fr == 15) ? gp1[j] : cur), p2 = dpp_ror<2>((fr >= 14) ? gp1[j] : cur);
                      if (tpos < 1) p1 = 0.f; if (tpos < 2) p2 = 0.f;
                      const float cv = w0b[j] * p2 + w1b[j] * p1 + w2b[j] * cur;
                      r1[j] = cv * __builtin_amdgcn_rcpf(1.0f + __builtin_amdgcn_exp2f(-1.4426950408889634f * cv)) * acc[ai][1][m][1][j]; }
                }
                if (rl >= 2 && grow < MROWS) {
                    u32x4 w; w.x = cvt_pk_bf16(r0[0], r0[1]); w.y = cvt_pk_bf16(r0[2], r0[3]); w.z = cvt_pk_bf16(r1[0], r1[1]); w.w = cvt_pk_bf16(r1[2], r1[3]);
                    *(u32x4*)(ACT + (size_t)grow * 2816 + hcol) = w;
                }
            }
        }
        if (has_next) prep_store(P, nxt, tid);
    }
};
template <class Epi, class Sched, bool ALIGN_EPI = false, bool SP2 = false>
__device__ __forceinline__ void gemm_phase(PG8_LAS unsigned char* lds, const Gemm g, const Sched& S, const Epi& E) {
    int tid_ = threadIdx.x; asm volatile("" : "+v"(tid_));
    const int tid = tid_, wid = __builtin_amdgcn_readfirstlane(tid >> 6), lane = tid & 63, wr = wid >> 2, wc = wid & 3, fr = lane & 15, fq = lane >> 4;
    const int K = g.K, nt = K / BK;
    unsigned voffA[2], voffB[2];
#pragma unroll
    for (int i = 0; i < 2; ++i) { int R, C; stage_rc(tid * 16 + i * 8192, R, C); const int Rb = Epi::PERM ? ((R & ~31) + perm32(R & 31)) : R;
        voffA[i] = (unsigned)(R * K + C) * 2u; voffB[i] = (unsigned)(Rb * K + C) * 2u; }
    const size_t kstep = (size_t)(BK * 2);
    const size_t hstep = (size_t)HALF * K * 2;
    const size_t tstep = 2 * hstep;
    const size_t tstepA = (size_t)g.a_rows * K * 2;
    const unsigned ldsw = (unsigned)wid * 1024u;
    const int aoff = lds_byte(wr * 64 + fr, fq * 8), boff = lds_byte(wc * 32 + fr, fq * 8);
#define PG8_SA(b, h) (((b) * 2 + (h)) * HTB)
#define PG8_SB(b, h) ((4 + (b) * 2 + (h)) * HTB)
#define PG8_STAGE(bufoff, gbase, voff) do { _Pragma("unroll") for (int _i = 0; _i < 2; ++_i) \
        __builtin_amdgcn_global_load_lds((const unsigned*)((const char*)(gbase) + (voff)[_i]), (PG8_LAS unsigned*)(lds + (bufoff) + ldsw + _i * 8192), 16, 0, 0); } while (0)
#define PG8_LDA(dst, b, h) do { _Pragma("unroll") for (int m = 0; m < 4; ++m) _Pragma("unroll") for (int k = 0; k < 2; ++k) dst[m][k] = *(const PG8_LAS bf16x8*)(lds + PG8_SA(b, h) + aoff + m * 2048 + k * 1024); } while (0)
#define PG8_LDB(dst, b, h) do { _Pragma("unroll") for (int n = 0; n < 2; ++n) _Pragma("unroll") for (int k = 0; k < 2; ++k) dst[n][k] = *(const PG8_LAS bf16x8*)(lds + PG8_SB(b, h) + boff + n * 2048 + k * 1024); } while (0)
#define PG8_MMA(ai, bj, At, Bt) do { __builtin_amdgcn_s_setprio(1); _Pragma("unroll") for (int m = 0; m < 4; ++m) _Pragma("unroll") for (int n = 0; n < 2; ++n) _Pragma("unroll") for (int k = 0; k < 2; ++k) \
        acc[ai][bj][m][n] = __builtin_amdgcn_mfma_f32_16x16x32_bf16(Bt[n][k], At[m][k], acc[ai][bj][m][n], 0, 0, 0); __builtin_amdgcn_s_setprio(0); } while (0)
#define PG8_WAIT_V(n) asm volatile("s_waitcnt vmcnt(" #n ")" ::: "memory")
#define PG8_WAIT_L(n) asm volatile("s_waitcnt lgkmcnt(" #n ")" ::: "memory")
#define PG8_BAR __builtin_amdgcn_s_barrier()
#define PG8_SCHED __builtin_amdgcn_sched_barrier(0)
    Unit cur, nxt; int ui = 0;
    if (!S.next(0, cur)) return;
    f32x4 acc[2][2][4][2];
    u32x4 iraw[Epi::HAS_INIT ? 16 : 1];
    if constexpr (Epi::HAS_INIT) E.init_load(iraw, cur, wr, wc, fr, fq);
    typename Epi::Prep prep;
    if constexpr (Epi::HAS_PREP) E.prep_load(prep, cur, tid);
    bf16x8 At[4][2], B0[2][2], B1[2][2];
    const char* cA = (const char*)g.A + (size_t)cur.pm * tstepA; const char* cB = (const char*)g.Bt + (size_t)cur.pn * tstep;
    S.a_ready(cur);
    if constexpr (SP2) {
        PG8_STAGE(PG8_SB(0, 0), cB, voffB); PG8_STAGE(PG8_SB(0, 1), cB + hstep, voffB); PG8_STAGE(PG8_SA(0, 0), cA, voffA); PG8_STAGE(PG8_SA(0, 1), cA + hstep, voffA);
        if (wr == 1) PG8_BAR;
        PG8_WAIT_V(2); PG8_BAR;
        PG8_STAGE(PG8_SB(1, 0), cB + kstep, voffB); PG8_STAGE(PG8_SA(1, 0), cA + kstep, voffA); PG8_STAGE(PG8_SB(1, 1), cB + hstep + kstep, voffB);
        PG8_WAIT_V(6); PG8_BAR;
    } else {
        PG8_STAGE(PG8_SB(0, 0), cB, voffB); PG8_STAGE(PG8_SA(0, 0), cA, voffA); PG8_STAGE(PG8_SB(0, 1), cB + hstep, voffB); PG8_STAGE(PG8_SA(0, 1), cA + hstep, voffA);
        if (wr == 1) PG8_BAR;
        PG8_WAIT_V(4); PG8_BAR;
        PG8_STAGE(PG8_SB(1, 0), cB + kstep, voffB); PG8_STAGE(PG8_SA(1, 0), cA + kstep, voffA); PG8_STAGE(PG8_SB(1, 1), cB + hstep + kstep, voffB);
        PG8_WAIT_V(6); PG8_BAR;
    }
    if constexpr (Epi::HAS_PREP) E.prep_store(prep, cur, tid);
    if constexpr (Epi::HAS_INIT) { E.init_acc(acc, iraw); }
    else {
#pragma unroll
        for (int a = 0; a < 2; ++a)
#pragma unroll
            for (int b = 0; b < 2; ++b)
#pragma unroll
                for (int m = 0; m < 4; ++m)
#pragma unroll
                    for (int n = 0; n < 2; ++n) acc[a][b][m][n] = (f32x4){0.f, 0.f, 0.f, 0.f};
    }
    for (;;) {
        const bool has_next = S.next(ui + 1, nxt);
        const char* nA = has_next ? (const char*)g.A + (size_t)nxt.pm * tstepA : cA; const char* nB = has_next ? (const char*)g.Bt + (size_t)nxt.pn * tstep : cB;
        for (int t = 0; t < nt; t += 2) {
            const bool last = (t == nt - 2);
            const char* a1 = cA + (size_t)(t + 1) * kstep;
            const char* a2 = last ? nA : cA + (size_t)(t + 2) * kstep; const char* b2 = last ? nB : cB + (size_t)(t + 2) * kstep;
            const char* a3 = a2 + kstep; const char* b3 = b2 + kstep;
            if (last && has_next) S.a_ready(nxt);
            if constexpr (SP2) {
            PG8_LDB(B0, 0, 0); PG8_LDB(B1, 0, 1); PG8_SCHED; PG8_LDA(At, 0, 0); PG8_STAGE(PG8_SA(1, 1), a1 + hstep, voffA);
            PG8_WAIT_V(8); PG8_WAIT_L(0); PG8_BAR; PG8_MMA(0, 0, At, B0); PG8_MMA(0, 1, At, B1); PG8_BAR; PG8_SCHED;
            PG8_LDA(At, 0, 1); PG8_STAGE(PG8_SB(0, 0), b2, voffB); PG8_STAGE(PG8_SB(0, 1), b2 + hstep, voffB); PG8_STAGE(PG8_SA(0, 0), a2, voffA);
            PG8_WAIT_V(8); PG8_WAIT_L(0); PG8_BAR; PG8_MMA(1, 0, At, B0); PG8_MMA(1, 1, At, B1); PG8_BAR; PG8_SCHED;
            PG8_LDB(B0, 1, 0); PG8_LDB(B1, 1, 1); PG8_SCHED; PG8_LDA(At, 1, 0); PG8_STAGE(PG8_SA(0, 1), a2 + hstep, voffA);
            PG8_WAIT_V(8); PG8_WAIT_L(0); PG8_BAR; PG8_MMA(0, 0, At, B0); PG8_MMA(0, 1, At, B1); PG8_BAR; PG8_SCHED;
            PG8_LDA(At, 1, 1); PG8_STAGE(PG8_SB(1, 0), b3, voffB); PG8_STAGE(PG8_SB(1, 1), b3 + hstep, voffB); PG8_STAGE(PG8_SA(1, 0), a3, voffA);
            PG8_WAIT_V(8); PG8_WAIT_L(0); PG8_BAR; PG8_MMA(1, 0, At, B0); PG8_MMA(1, 1, At, B1); PG8_BAR; PG8_SCHED;
            } else {
            PG8_LDB(B0, 0, 0); PG8_SCHED; PG8_LDA(At, 0, 0); PG8_STAGE(PG8_SA(1, 1), a1 + hstep, voffA);
            PG8_WAIT_L(8); PG8_BAR; PG8_WAIT_L(0); PG8_MMA(0, 0, At, B0); PG8_BAR; PG8_SCHED;
            PG8_LDB(B1, 0, 1); PG8_STAGE(PG8_SB(0, 0), b2, voffB);
            PG8_BAR; PG8_WAIT_L(0); PG8_MMA(0, 1, At, B1); PG8_BAR;
            PG8_LDA(At, 0, 1); PG8_STAGE(PG8_SA(0, 0), a2, voffA);
            PG8_BAR; PG8_WAIT_L(0); PG8_MMA(1, 0, At, B0); PG8_BAR; PG8_SCHED;
            PG8_STAGE(PG8_SB(0, 1), b2 + hstep, voffB);
            PG8_WAIT_V(6); PG8_BAR; PG8_MMA(1, 1, At, B1); PG8_BAR;
            PG8_LDB(B0, 1, 0); PG8_SCHED; PG8_LDA(At, 1, 0); PG8_STAGE(PG8_SA(0, 1), a2 + hstep, voffA);
            PG8_WAIT_L(8); PG8_BAR; PG8_WAIT_L(0); PG8_MMA(0, 0, At, B0); PG8_BAR; PG8_SCHED;
            PG8_LDB(B1, 1, 1); PG8_STAGE(PG8_SB(1, 0), b3, voffB);
            PG8_BAR; PG8_WAIT_L(0); PG8_MMA(0, 1, At, B1); PG8_BAR;
            PG8_LDA(At, 1, 1); PG8_STAGE(PG8_SA(1, 0), a3, voffA);
            PG8_BAR; PG8_WAIT_L(0); PG8_MMA(1, 0, At, B0); PG8_BAR; PG8_SCHED;
            PG8_STAGE(PG8_SB(1, 1), b3 + hstep, voffB);
            PG8_WAIT_V(6); PG8_BAR; PG8_MMA(1, 1, At, B1); PG8_BAR;
            }
        }
        if constexpr (ALIGN_EPI) { if (wr == 0) PG8_BAR; }
        if constexpr (!Epi::AFTER_DRAIN) { E(acc, cur, nxt, has_next, wr, wc, fr, fq, tid); S.done(cur); }
        if (!has_next) break;
        if constexpr (Epi::HAS_INIT) { E.init_load(iraw, nxt, wr, wc, fr, fq); E.init_acc(acc, iraw); }
        else {
#pragma unroll
        for (int a = 0; a < 2; ++a)
#pragma unroll
            for (int b = 0; b < 2; ++b)
#pragma unroll
                for (int m = 0; m < 4; ++m)
#pragma unroll
                    for (int n = 0; n < 2; ++n) acc[a][b][m][n] = (f32x4){0.f, 0.f, 0.f, 0.f};
        }
        cur = nxt; cA = nA; cB = nB; ++ui;
        if constexpr (ALIGN_EPI) { if (wr == 1) PG8_BAR; }
    }
    PG8_WAIT_V(0);
    if constexpr (!ALIGN_EPI) { if (wr == 0) PG8_BAR; }
    PG8_BAR;
    if constexpr (Epi::AFTER_DRAIN) { E.fused(acc, cur, wr, wc, fr, fq, lds, wid, lane); S.done(cur); }
#undef PG8_SA
#undef PG8_SB
#undef PG8_STAGE
#undef PG8_LDA
#undef PG8_LDB
#undef PG8_MMA
#undef PG8_WAIT_V
#undef PG8_WAIT_L
#undef PG8_BAR
#undef PG8_SCHED
}
}
namespace attn_body {
using bf16=__hip_bfloat16;
using bf16x8=__attribute__((ext_vector_type(8)))short;
using s16x4=__attribute__((ext_vector_type(4)))short;
using f32x16=__attribute__((ext_vector_type(16)))float;
using u32x4=__attribute__((ext_vector_type(4)))unsigned;
constexpr int BATCH=8,SEQ=2048,D=64,DM=3072;
constexpr int NW=8,QBLK=32,QB=QBLK*NW,KVBLK=64,NQB=SEQ/QB;
constexpr int ATTN_UNIT_ROWS=QB;
__device__ __forceinline__ int crow(int r,int hi){return (r&3)+8*(r>>2)+4*hi;}
#define SBAR() __builtin_amdgcn_sched_barrier(0)
__device__ __forceinline__ void cmask(f32x16&p0,f32x16&p1,int jb,int qrel,int hi){
  const float NEG=-INFINITY; int kb=64*jb+4*hi;
  #pragma unroll
  for(int r=0;r<16;++r){int kv=kb+(r&3)+8*(r>>2); if(kv>qrel)p0[r]=NEG; if(kv+32>qrel)p1[r]=NEG;}
}

__device__ __forceinline__ float dwl(int d){
  const int w=(int)(d<=128)+(int)(((d&3)==0)&&(d<=512))+(int)((d&15)==0);
  const float a=(w==0)?-INFINITY:(w==1)?0.f:(w==2)?1.f:1.5849625007f;
  return d<0?-INFINITY:a;
}
typedef __attribute__((address_space(3))) const float* ldsf_cptr;
typedef float f32x2m __attribute__((ext_vector_type(2)));
constexpr int DMASK_TBL_N=2368;
#define DMASK_BATCH(o_) asm volatile("ds_read2_b32 %0, %8 offset0:" #o_ "+0 offset1:" #o_ "+1\n\tds_read2_b32 %1, %8 offset0:" #o_ "+2 offset1:" #o_ "+3\n\t" \
      "ds_read2_b32 %2, %8 offset0:" #o_ "+8 offset1:" #o_ "+9\n\tds_read2_b32 %3, %8 offset0:" #o_ "+10 offset1:" #o_ "+11\n\t" \
      "ds_read2_b32 %4, %8 offset0:" #o_ "+16 offset1:" #o_ "+17\n\tds_read2_b32 %5, %8 offset0:" #o_ "+18 offset1:" #o_ "+19\n\t" \
      "ds_read2_b32 %6, %8 offset0:" #o_ "+24 offset1:" #o_ "+25\n\tds_read2_b32 %7, %8 offset0:" #o_ "+26 offset1:" #o_ "+27\n\ts_waitcnt lgkmcnt(0)" \
      :"=&v"(t0),"=&v"(t1),"=&v"(t2),"=&v"(t3),"=&v"(t4),"=&v"(t5),"=&v"(t6),"=&v"(t7):"v"(a):"memory")
__device__ __forceinline__ void dmask(f32x16&p0,f32x16&p1,int base,unsigned tbl_addr){
  const unsigned a=tbl_addr+(unsigned)(2047-base)*4u;
  f32x2m t0,t1,t2,t3,t4,t5,t6,t7;
  DMASK_BATCH(0);
  p0[0]+=t0.x;p0[1]+=t0.y;p0[2]+=t1.x;p0[3]+=t1.y;p0[4]+=t2.x;p0[5]+=t2.y;p0[6]+=t3.x;p0[7]+=t3.y;
  p0[8]+=t4.x;p0[9]+=t4.y;p0[10]+=t5.x;p0[11]+=t5.y;p0[12]+=t6.x;p0[13]+=t6.y;p0[14]+=t7.x;p0[15]+=t7.y;
  DMASK_BATCH(32);
  p1[0]+=t0.x;p1[1]+=t0.y;p1[2]+=t1.x;p1[3]+=t1.y;p1[4]+=t2.x;p1[5]+=t2.y;p1[6]+=t3.x;p1[7]+=t3.y;
  p1[8]+=t4.x;p1[9]+=t4.y;p1[10]+=t5.x;p1[11]+=t5.y;p1[12]+=t6.x;p1[13]+=t6.y;p1[14]+=t7.x;p1[15]+=t7.y;
}

constexpr int NSLOT=3, SLOTB=8192;
constexpr int LDS_K=0, LDS_V=NSLOT*SLOTB, LDS_WS=2*NSLOT*SLOTB, LDS_OST=LDS_WS+NW*64*4, LDS_BYTES=LDS_OST+NW*4096;
constexpr float C2=0.125f*1.4426950408889634f;
__device__ __forceinline__ void glds16(const void*gsrc,unsigned lds_dst){unsigned keep;
  asm volatile("s_mov_b32 %0, m0\n\ts_mov_b32 m0, %2\n\ts_nop 0\n\tglobal_load_lds_dwordx4 %1, off\n\ts_mov_b32 m0, %0":"=&s"(keep):"v"(gsrc),"s"(lds_dst):"memory");}
__device__ __forceinline__ float max3f(float a,float b,float c){float r;asm("v_max3_f32 %0, %1, %2, %3":"=v"(r):"v"(a),"v"(b),"v"(c));return r;}
__device__ __forceinline__ float max2f(float a,float b){float r;asm("v_max_f32_e32 %0, %1, %2":"=v"(r):"v"(a),"v"(b));return r;}
__device__ __forceinline__ float fadd_s(float a,float b){float r;asm("v_add_f32_e32 %0, %1, %2":"=v"(r):"v"(a),"v"(b));return r;}
__device__ __forceinline__ float fsub_s(float a,float b){float r;asm("v_sub_f32_e32 %0, %1, %2":"=v"(r):"v"(a),"v"(b));return r;}
typedef float f32x2_t __attribute__((ext_vector_type(2))); typedef __bf16 bf16x2_t __attribute__((ext_vector_type(2)));
__device__ __forceinline__ unsigned cvtpk_s(float lo,float hi){f32x2_t v={lo,hi};bf16x2_t b=__builtin_convertvector(v,bf16x2_t);return __builtin_bit_cast(unsigned,b);}
#define WAIT_BAR(N) asm volatile("s_waitcnt vmcnt(" #N ") lgkmcnt(0)\n\ts_barrier":::"memory")

__device__ __forceinline__ void qkt(f32x16&p0,f32x16&p1,const char*Kslot,const bf16x8*qr,const f32x16&negm,int r32,int hi){
  const char*kb=Kslot+hi*1024+r32*16;
  #pragma unroll
  for(int d0=0;d0<4;++d0){
    const bf16x8 b0=*reinterpret_cast<const bf16x8*>(kb+d0*2048);
    const bf16x8 b1=*reinterpret_cast<const bf16x8*>(kb+d0*2048+512);
    if(d0==0){p0=__builtin_amdgcn_mfma_f32_32x32x16_bf16(b0,qr[0],negm,0,0,0);p1=__builtin_amdgcn_mfma_f32_32x32x16_bf16(b1,qr[0],negm,0,0,0);}
    else{p0=__builtin_amdgcn_mfma_f32_32x32x16_bf16(b0,qr[d0],p0,0,0,0);p1=__builtin_amdgcn_mfma_f32_32x32x16_bf16(b1,qr[d0],p1,0,0,0);}}
}
typedef __attribute__((address_space(3))) const char* lds_cptr;
typedef short v4i16_t __attribute__((ext_vector_type(4)));
__device__ __forceinline__ void kload8(bf16x8*kf,lds_cptr kp){
  kf[0]=*(const __attribute__((address_space(3))) bf16x8*)(kp);      kf[1]=*(const __attribute__((address_space(3))) bf16x8*)(kp+512);
  kf[2]=*(const __attribute__((address_space(3))) bf16x8*)(kp+2048); kf[3]=*(const __attribute__((address_space(3))) bf16x8*)(kp+2560);
  kf[4]=*(const __attribute__((address_space(3))) bf16x8*)(kp+4096); kf[5]=*(const __attribute__((address_space(3))) bf16x8*)(kp+4608);
  kf[6]=*(const __attribute__((address_space(3))) bf16x8*)(kp+6144); kf[7]=*(const __attribute__((address_space(3))) bf16x8*)(kp+6656);
}
__device__ __forceinline__ void kload2(bf16x8*kf,lds_cptr kp,int j){ kf[2*j]=*(const __attribute__((address_space(3))) bf16x8*)(kp+j*2048); kf[2*j+1]=*(const __attribute__((address_space(3))) bf16x8*)(kp+j*2048+512); }
__device__ __forceinline__ s16x4 vtr(lds_cptr p){ return __builtin_bit_cast(s16x4,__builtin_amdgcn_ds_read_tr16_b64_v4i16((__attribute__((address_space(3))) v4i16_t*)p)); }
__device__ __forceinline__ float rowmax(const f32x16&p0,const f32x16&p1){
  float a=max3f(p0[0],p0[1],p1[0]),b=max3f(p0[2],p0[3],p1[1]);a=max3f(a,p1[2],p1[3]);
  #pragma unroll
  for(int r=4;r<16;r+=4){a=max3f(a,p0[r],p0[r+1]);b=max3f(b,p0[r+2],p0[r+3]);a=max3f(a,p1[r],p1[r+1]);b=max3f(b,p1[r+2],p1[r+3]);}
  const float m=max2f(a,b);
  auto rr=__builtin_amdgcn_permlane32_swap(__float_as_uint(m),__float_as_uint(m),false,false);
  return max2f(__uint_as_float(rr[0]),__uint_as_float(rr[1]));
}
__device__ __forceinline__ void pv(f32x16*o,int vb,bf16x8 pa0,bf16x8 pa1,bf16x8 pa2,bf16x8 pa3){
  #pragma unroll
  for(int d0=0;d0<2;++d0){s16x4 lo[4],hi[4];
    #pragma unroll
    for(int ks=0;ks<4;++ks){
      asm volatile("ds_read_b64_tr_b16 %0,%1 offset:%c2":"=&v"(lo[ks]):"v"(vb),"i"(d0*4096+ks*1024):"memory");
      asm volatile("ds_read_b64_tr_b16 %0,%1 offset:%c2":"=&v"(hi[ks]):"v"(vb),"i"(d0*4096+ks*1024+512):"memory");}
    asm volatile("s_waitcnt lgkmcnt(0)":::"memory");SBAR();
    #define PK(k) (bf16x8){lo[k][0],lo[k][1],lo[k][2],lo[k][3],hi[k][0],hi[k][1],hi[k][2],hi[k][3]}
    o[d0]=__builtin_amdgcn_mfma_f32_32x32x16_bf16(pa0,PK(0),o[d0],0,0,0);
    o[d0]=__builtin_amdgcn_mfma_f32_32x32x16_bf16(pa1,PK(1),o[d0],0,0,0);
    o[d0]=__builtin_amdgcn_mfma_f32_32x32x16_bf16(pa2,PK(2),o[d0],0,0,0);
    o[d0]=__builtin_amdgcn_mfma_f32_32x32x16_bf16(pa3,PK(3),o[d0],0,0,0);
    #undef PK
  }
}

#ifndef ATTN_STORE16
#define ATTN_STORE16(p,v) (*(u32x4*)(p)=(v))
#endif
template<int THRL,int MODE> __device__ __forceinline__ void attn_unit(int b,int qb,const bf16*Q,const bf16*__restrict__ K,const bf16*__restrict__ V,bf16*O,int opitch,char*shm,unsigned tbl){
  int tid_=threadIdx.x; asm volatile("":"+v"(tid_));
  const int tid=tid_,lane=tid&63,r32=lane&31,hi=lane>>5; const int wid=__builtin_amdgcn_readfirstlane(tid>>6);
  const long rowbase=(long)b*SEQ; const int q0=qb*QB;
  const bf16*Qw=Q+(rowbase+q0+wid*QBLK)*DM;
  const bf16*Kh=K+rowbase*DM,*Vh=V+rowbase*DM;
  const unsigned lds0=(unsigned)(uintptr_t)shm;
  float*wsf=(float*)(shm+LDS_WS)+wid*64;
  const bf16*ksrc=Kh+(long)lane*DM+wid*8;
  const bf16*vsrc=Vh+(long)(16*(wid&3)+(lane>>2))*DM+(wid>>2)*32+(lane&3)*8;
  const unsigned kdst=lds0+LDS_K+wid*1024, vdst=lds0+LDS_V+wid*1024;
  #define DMA_K(t,slot) glds16(ksrc+(long)(t)*KVBLK*DM,(unsigned)__builtin_amdgcn_readfirstlane(kdst+(slot)))
  #define DMA_V(t,slot) glds16(vsrc+(long)(t)*KVBLK*DM,(unsigned)__builtin_amdgcn_readfirstlane(vdst+(slot)))
  const int vb0=(int)(lds0+LDS_V)+((lane>>4)&1)*32+(lane&3)*8+(4*hi+((lane&15)>>2))*64;
  const char*Kbase=shm+LDS_K; bf16x8 kf[8];
  const lds_cptr shm3=(lds_cptr)shm; const lds_cptr kp0=shm3+LDS_K+hi*1024+r32*16; const lds_cptr vp0=shm3+LDS_V+((lane>>4)&1)*32+(lane&3)*8+(4*hi+((lane&15)>>2))*64;
  const int NT=(q0+QB)/KVBLK;
  DMA_K(0,0);DMA_V(0,0);DMA_K(1,SLOTB);
  bf16x8 qr[4];
  #pragma unroll
  for(int d0=0;d0<4;++d0)qr[d0]=*reinterpret_cast<const bf16x8*>(&Qw[(long)r32*DM+d0*16+hi*8]);
  float mhat=0.f,l_reg=0.f;f32x16 o[2];o[0]=f32x16{};o[1]=f32x16{};f32x16 negm=f32x16{};asm volatile("":"+v"(negm));
  const int qrel=wid*QBLK+r32;
  #define CMASK(P0,P1,t) do{ if constexpr(MODE==0){int jb_=(t)-(NT-4); if(jb_>=0)cmask(P0,P1,jb_,qrel,hi);} else if constexpr(MODE==1) { dmask(P0,P1,q0+qrel-64*(t)-4*hi,tbl); } }while(0)
  bool resc=false;
  #define START(P0,P1) do{ const float rm=rowmax(P0,P1); resc=false; \
    { const float dl=rm; mhat=fadd_s(mhat,dl); \
      _Pragma("unroll") for(int r=0;r<16;++r){P0[r]=fsub_s(P0[r],dl);P1[r]=fsub_s(P1[r],dl);} \
      _Pragma("unroll") for(int r=0;r<16;++r)negm[r]=-mhat; asm volatile("":"+v"(negm)); } \
    _Pragma("unroll") for(int r=0;r<16;++r)P0[r]=__builtin_amdgcn_exp2f(P0[r]); }while(0)
  #define RESC() do{ if(resc){ asm volatile("s_waitcnt lgkmcnt(0)":::"memory"); \
      _Pragma("unroll") for(int d_=0;d_<2;++d_) _Pragma("unroll") for(int r=0;r<16;++r)o[d_][r]*=wsf[crow(r,hi)]; } }while(0)
  f32x16 pA0,pA1,pB0,pB1;
  int sl_prev=0,sl_cur=0,sl_next=SLOTB;
  #define ROT() do{sl_prev=sl_cur;sl_cur=sl_next;sl_next=(sl_next==(NSLOT-1)*SLOTB)?0:sl_next+SLOTB;}while(0)
  DMA_K(2,2*SLOTB);
  WAIT_BAR(3);
  qkt(pA0,pA1,Kbase,qr,negm,r32,hi);asm volatile("s_nop 15\n\ts_nop 7":"+v"(pA0),"+v"(pA1));CMASK(pA0,pA1,0);
  START(pA0,pA1);
  _Pragma("unroll") for(int r=0;r<16;++r)pA1[r]=__builtin_amdgcn_exp2f(pA1[r]);
  WAIT_BAR(0);
  DMA_K(3,0);DMA_V(1,SLOTB);
  ROT();
  kload8(kf,kp0+sl_cur);
  WAIT_BAR(2);
  s16x4 vlo[8],vhi[8]; u32x4 pw0,pw1,pw2,pw3;
  #define PKW(P,B) cvtpk_s(P[B],P[B+1])
  #define PAF(k) __builtin_bit_cast(bf16x8,pw##k)
  #define VFR(i) (bf16x8){vlo[i][0],vlo[i][1],vlo[i][2],vlo[i][3],vhi[i][0],vhi[i][1],vhi[i][2],vhi[i][3]}
  #define PIN(x) asm volatile("":"+v"(x))
  #define MX3(a,b,c) __builtin_fmaxf(__builtin_fmaxf((a),(b)),(c))
  #define GAPA(MF,A0,A1,A2,A3,W0,W1,PW) do{ MF; sacc+=A0; sacc+=A1; sacc+=A2; sacc+=A3; PIN(sacc); W0; W1; PIN(PW); SBAR(); }while(0)
  #define EX(v) __builtin_amdgcn_exp2f(v)
  #define GAPB(MF,X,B) do{ MF; X[B]=EX(X[B]); X[B+1]=EX(X[B+1]); X[B+2]=EX(X[B+2]); X[B+3]=EX(X[B+3]); PIN(X); SBAR(); }while(0)
  #define VRD(i) do{ vlo[i]=vtr(vp_+(((i)>>2)*4096+((i)&3)*1024)); vhi[i]=vtr(vp_+(((i)>>2)*4096+((i)&3)*1024+512)); }while(0)
  #define KRD(G,j) do{ if(G){ kload2(kf,kp0+sl_next,j); SBAR(); } }while(0)
  #define STEP(C0,C1,P0,P1,t,GK,GV,GL) do{ SBAR(); \
    const lds_cptr vp_=vp0+sl_prev; \
    VRD(0); SBAR(); float sacc=(P0[0]+P0[1]); \
    GAPA(C0=__builtin_amdgcn_mfma_f32_32x32x16_bf16(kf[0],qr[0],negm,0,0,0), P0[2],P0[3],P0[4],P0[5],     pw0[0]=PKW(P0,0), pw0[1]=PKW(P0,2), pw0); \
    VRD(4); SBAR(); GAPA(C1=__builtin_amdgcn_mfma_f32_32x32x16_bf16(kf[1],qr[0],negm,0,0,0), P0[6],P0[7],P0[8],P0[9],     pw0[2]=PKW(P0,4), pw0[3]=PKW(P0,6), pw0); \
    VRD(1); SBAR(); GAPA(C0=__builtin_amdgcn_mfma_f32_32x32x16_bf16(kf[2],qr[1],C0,0,0,0),   P0[10],P0[11],P0[12],P0[13], pw1[0]=PKW(P0,8), pw1[1]=PKW(P0,10), pw1); \
    VRD(5); SBAR(); GAPA(C1=__builtin_amdgcn_mfma_f32_32x32x16_bf16(kf[3],qr[1],C1,0,0,0),   P0[14],P0[15],P1[0],P1[1],   pw1[2]=PKW(P0,12),pw1[3]=PKW(P0,14), pw1); \
    VRD(2); SBAR(); GAPA(C0=__builtin_amdgcn_mfma_f32_32x32x16_bf16(kf[4],qr[2],C0,0,0,0),   P1[2],P1[3],P1[4],P1[5],     pw2[0]=PKW(P1,0), pw2[1]=PKW(P1,2), pw2); \
    VRD(6); SBAR(); GAPA(C1=__builtin_amdgcn_mfma_f32_32x32x16_bf16(kf[5],qr[2],C1,0,0,0),   P1[6],P1[7],P1[8],P1[9],     pw2[2]=PKW(P1,4), pw2[3]=PKW(P1,6), pw2); \
    VRD(3); SBAR(); GAPA(C0=__builtin_amdgcn_mfma_f32_32x32x16_bf16(kf[6],qr[3],C0,0,0,0),   P1[10],P1[11],P1[12],P1[13], pw3[0]=PKW(P1,8), pw3[1]=PKW(P1,10), pw3); \
    VRD(7); SBAR(); GAPA(C1=__builtin_amdgcn_mfma_f32_32x32x16_bf16(kf[7],qr[3],C1,0,0,0),   P1[14],P1[15],0.f,0.f,       pw3[2]=PKW(P1,12),pw3[3]=PKW(P1,14), pw3); \
    l_reg+=sacc; \
    if(GK){DMA_K((t)+3,sl_cur);} if(GV){DMA_V((t)+1,sl_next);} \
    CMASK(C0,C1,t); \
    { float a=MX3(C0[0],C0[1],C1[0]),b=MX3(C0[2],C0[3],C1[1]); a=MX3(a,C1[2],C1[3]); \
      _Pragma("unroll") for(int r=4;r<16;r+=4){a=MX3(a,C0[r],C0[r+1]);b=MX3(b,C0[r+2],C0[r+3]);a=MX3(a,C1[r],C1[r+1]);b=MX3(b,C1[r+2],C1[r+3]);} \
      float rm=__builtin_fmaxf(a,b); { auto rr=__builtin_amdgcn_permlane32_swap(__float_as_uint(rm),__float_as_uint(rm),false,false); rm=__builtin_fmaxf(__uint_as_float(rr[0]),__uint_as_float(rr[1])); } \
      resc=false; \
      if(__builtin_expect(__any(rm>(float)THRL),0)){ const float dl=__builtin_fmaxf(rm,0.f); mhat+=dl; \
        _Pragma("unroll") for(int r=0;r<16;++r){C0[r]-=dl;C1[r]-=dl;} \
        _Pragma("unroll") for(int r=0;r<16;++r)negm[r]=-mhat; asm volatile("":"+v"(negm)); \
        const float f=__builtin_amdgcn_exp2f(-dl); l_reg*=f; if(hi==0)wsf[r32]=f; resc=true; } } \
    SBAR(); \
    GAPB(o[0]=__builtin_amdgcn_mfma_f32_32x32x16_bf16(PAF(0),VFR(0),o[0],0,0,0), C0,0); \
    GAPB(o[1]=__builtin_amdgcn_mfma_f32_32x32x16_bf16(PAF(0),VFR(4),o[1],0,0,0), C0,4); \
    KRD(GL,0); GAPB(o[0]=__builtin_amdgcn_mfma_f32_32x32x16_bf16(PAF(1),VFR(1),o[0],0,0,0), C0,8); \
    KRD(GL,1); GAPB(o[1]=__builtin_amdgcn_mfma_f32_32x32x16_bf16(PAF(1),VFR(5),o[1],0,0,0), C0,12); \
    KRD(GL,2); GAPB(o[0]=__builtin_amdgcn_mfma_f32_32x32x16_bf16(PAF(2),VFR(2),o[0],0,0,0), C1,0); \
    KRD(GL,3); GAPB(o[1]=__builtin_amdgcn_mfma_f32_32x32x16_bf16(PAF(2),VFR(6),o[1],0,0,0), C1,4); \
    GAPB(o[0]=__builtin_amdgcn_mfma_f32_32x32x16_bf16(PAF(3),VFR(3),o[0],0,0,0), C1,8); \
    GAPB(o[1]=__builtin_amdgcn_mfma_f32_32x32x16_bf16(PAF(3),VFR(7),o[1],0,0,0), C1,12); \
    }while(0)
  int t=1;
  #undef CMASK
  #define CMASK(P0,P1,t) do{ if constexpr(MODE==1){ dmask(P0,P1,q0+qrel-64*(t)-4*hi,tbl); } }while(0)
  for(;t+5<NT;t+=2){
    STEP(pB0,pB1,pA0,pA1,t,true,true,true);     WAIT_BAR(2); RESC(); ROT();
    STEP(pA0,pA1,pB0,pB1,t+1,true,true,true);   WAIT_BAR(2); RESC(); ROT();
  }
  #undef CMASK
  #define CMASK(P0,P1,t) do{ if constexpr(MODE==0){int jb_=(t)-(NT-4); if(jb_>=0)cmask(P0,P1,jb_,qrel,hi);} else if constexpr(MODE==1) { dmask(P0,P1,q0+qrel-64*(t)-4*hi,tbl); } }while(0)
  #define ENDW(tt) do{ if((tt)+3<NT){WAIT_BAR(2);} else if((tt)+2<NT){WAIT_BAR(1);} else {WAIT_BAR(0);} }while(0)
  for(;t+1<NT;t+=2){
    STEP(pB0,pB1,pA0,pA1,t,(t+3<NT),(t+1<NT),(t+1<NT));       ENDW(t);   RESC(); ROT();
    STEP(pA0,pA1,pB0,pB1,t+1,(t+4<NT),(t+2<NT),(t+2<NT));     ENDW(t+1); RESC(); ROT();
  }
  STEP(pB0,pB1,pA0,pA1,NT-1,false,false,false); RESC();
  { float sacc=pB0[0]+pB0[1]; _Pragma("unroll") for(int r=2;r<16;++r)sacc+=pB0[r]; _Pragma("unroll") for(int r=0;r<16;++r)sacc+=pB1[r]; l_reg+=sacc;
    pw0=(u32x4){PKW(pB0,0),PKW(pB0,2),PKW(pB0,4),PKW(pB0,6)};pw1=(u32x4){PKW(pB0,8),PKW(pB0,10),PKW(pB0,12),PKW(pB0,14)};pw2=(u32x4){PKW(pB1,0),PKW(pB1,2),PKW(pB1,4),PKW(pB1,6)};pw3=(u32x4){PKW(pB1,8),PKW(pB1,10),PKW(pB1,12),PKW(pB1,14)};
    SBAR(); pv(o,vb0+sl_cur,PAF(0),PAF(1),PAF(2),PAF(3)); }
  #undef PKW
  #undef PAF
  #undef VFR
  #undef PIN
  #undef MX3
  #undef GAPA
  #undef GAPB
  #undef EX
  #undef VRD
  #undef KRD
  #undef STEP
  #undef ENDW
  {auto rr=__builtin_amdgcn_permlane32_swap(__float_as_uint(l_reg),__float_as_uint(l_reg),false,false);l_reg=__uint_as_float(rr[0])+__uint_as_float(rr[1]);}
  if(hi==0)wsf[32+r32]=l_reg;asm volatile("s_waitcnt lgkmcnt(0)":::"memory");
  float rli[16];
  #pragma unroll
  for(int r=0;r<16;++r)rli[r]=__builtin_amdgcn_rcpf(wsf[32+crow(r,hi)]);
  bf16*Ow=O+(rowbase+q0+wid*QBLK)*(long)opitch;
  { bf16*stg=(bf16*)(shm+LDS_OST)+wid*2048;
    #pragma unroll
    for(int r=0;r<16;++r){const int orow=crow(r,hi);
      #pragma unroll
      for(int d0=0;d0<2;++d0)stg[orow*64+d0*32+r32]=__float2bfloat16(o[d0][r]*rli[r]);}
    asm volatile("s_waitcnt lgkmcnt(0)":::"memory");
    #pragma unroll
    for(int i=0;i<4;++i){const int row=i*8+(lane>>3),ch=lane&7; const u32x4 v=*(const u32x4*)(stg+row*64+ch*8); ATTN_STORE16(Ow+(long)row*opitch+ch*8,v);} }
  asm volatile("s_waitcnt lgkmcnt(0)\n\ts_barrier":::"memory");
  #undef DMA_K
  #undef DMA_V
  #undef CMASK
  #undef START
  #undef RESC
  #undef ROT
}
constexpr int ATTN_LDS_BYTES=LDS_BYTES;
#undef SBAR
#undef WAIT_BAR
}

namespace attn_b {
using bf16 = __hip_bfloat16;
typedef short bf16x8 __attribute__((ext_vector_type(8)));
typedef short s16x4 __attribute__((ext_vector_type(4)));
typedef float f32x16 __attribute__((ext_vector_type(16)));
typedef float f32x4 __attribute__((ext_vector_type(4)));
typedef unsigned u32x4 __attribute__((ext_vector_type(4)));
constexpr int DQ = 64, DV = 128, PIN = 3072, POUT = 1024;
constexpr int NW = 8, QBLK = 32, KVBLK = 64, QB = NW * QBLK;
constexpr int SHM_V = KVBLK * DV * 2, SHM_K = KVBLK * DQ * 2;
constexpr int NBUF = 3;
constexpr int LDS_BYTES = NBUF * SHM_V + NBUF * SHM_K + NW * 64 * 4;
constexpr int OSTAGE_OFF = 98304;
constexpr float THR = 8.f;
#define KSWZ(row, colB) ((row) * 128 + ((colB) ^ ((((row) >> 1) & 7) << 4)))
#define SBAR() __builtin_amdgcn_sched_barrier(0)
__device__ __forceinline__ int v_st(int k, int c) { const int kk = (k & ~0xC) | ((k & 4) << 1) | ((k & 8) >> 1); return ((kk >> 3) * 4 + (c >> 5)) * 512 + ((kk & 7) * 32 + (c & 31)) * 2; }
__device__ __forceinline__ int v_rd_base(int lane) { return ((lane & 3) << 3) | (((lane >> 2) & 3) << 6) | (((lane >> 4) & 1) << 5) | (((lane >> 5) & 1) << 8); }
constexpr int v_rd_off(int d0, int ks, int half) { return d0 * 512 + ks * 4096 + half * 2048; }
__device__ __forceinline__ int crow(int r, int hi) { return (r & 3) + 8 * (r >> 2) + 4 * hi; }
__device__ __forceinline__ unsigned cvtpk(float lo, float hi) { unsigned r; asm volatile("v_cvt_pk_bf16_f32 %0, %1, %2" : "=v"(r) : "v"(lo), "v"(hi)); return r; }
__device__ __forceinline__ bf16x8 load8(const bf16* p) { return *reinterpret_cast<const bf16x8*>(p); }
__device__ __forceinline__ void mask_tile(f32x16& p0, f32x16& p1, int dq) {
    const float NEG = -__builtin_inff();
#pragma unroll
    for (int r = 0; r < 16; ++r) { const int c = (r & 3) + 8 * (r >> 2); if (dq - c < 0) p0[r] = NEG; if (dq - c - 32 < 0) p1[r] = NEG; }
}
#define MX3(a, b, c) __builtin_fmaxf(__builtin_fmaxf((a), (b)), (c))
__device__ __forceinline__ void partialSM(f32x16& p0, f32x16& p1, float& m_reg, float& mn, float& alpha) {
    float ma = MX3(p0[0], p0[1], p0[2]), mb = MX3(p0[3], p0[4], p0[5]), mc = MX3(p1[0], p1[1], p1[2]), md = MX3(p1[3], p1[4], p1[5]);
    ma = MX3(ma, p0[6], p0[7]); mb = MX3(mb, p0[8], p0[9]); mc = MX3(mc, p1[6], p1[7]); md = MX3(md, p1[8], p1[9]);
    ma = MX3(ma, p0[10], p0[11]); mb = MX3(mb, p0[12], p0[13]); mc = MX3(mc, p1[10], p1[11]); md = MX3(md, p1[12], p1[13]);
    ma = MX3(ma, p0[14], p0[15]); mc = MX3(mc, p1[14], p1[15]);
    float pmax = __builtin_fmaxf(MX3(ma, mb, mc), md);
    { auto rr = __builtin_amdgcn_permlane32_swap(__float_as_uint(pmax), __float_as_uint(pmax), false, false); pmax = fmaxf(__uint_as_float(rr[0]), __uint_as_float(rr[1])); }
    if (__builtin_expect(__all((pmax - m_reg) <= THR), 1)) { mn = m_reg; alpha = 1.f; }
    else { mn = fmaxf(m_reg, pmax); alpha = __builtin_amdgcn_exp2f(m_reg - mn); m_reg = mn; }
#pragma unroll
    for (int r = 0; r < 16; ++r) p0[r] = p0[r] - mn;
#pragma unroll
    for (int r = 0; r < 16; ++r) p1[r] = p1[r] - mn;
#pragma unroll
    for (int r = 0; r < 16; ++r) p0[r] = __builtin_amdgcn_exp2f(p0[r]);
}
__device__ __forceinline__ void finishSM(f32x16& p0, f32x16& p1, float alpha, float& l_reg, bf16x8& pa0, bf16x8& pa1, bf16x8& pa2, bf16x8& pa3) {
#pragma unroll
    for (int r = 0; r < 16; ++r) p1[r] = __builtin_amdgcn_exp2f(p1[r]);
    float sa = p0[0] + p0[1], sb = p0[2] + p0[3], sc = p1[0] + p1[1], sd = p1[2] + p1[3];
#pragma unroll
    for (int r = 4; r < 16; r += 4) { sa += p0[r]; sb += p0[r + 2]; sc += p1[r]; sd += p1[r + 2]; sa += p0[r + 1]; sb += p0[r + 3]; sc += p1[r + 1]; sd += p1[r + 3]; }
    float ps = (sa + sb) + (sc + sd);
    { auto rr = __builtin_amdgcn_permlane32_swap(__float_as_uint(ps), __float_as_uint(ps), false, false); ps = __uint_as_float(rr[0]) + __uint_as_float(rr[1]); }
    l_reg = l_reg * alpha + ps;
#define PK4(P, B_, OUT) do { unsigned a0 = cvtpk(P[B_+0], P[B_+1]), a1 = cvtpk(P[B_+2], P[B_+3]);                          \
        unsigned b0 = cvtpk(P[B_+4], P[B_+5]), b1 = cvtpk(P[B_+6], P[B_+7]);                                             \
        auto r0 = __builtin_amdgcn_permlane32_swap(a0, b0, false, false); auto r1 = __builtin_amdgcn_permlane32_swap(a1, b1, false, false); \
        u32x4 w = {r0[0], r1[0], r0[1], r1[1]}; OUT = *reinterpret_cast<bf16x8*>(&w); } while (0)
    PK4(p0, 0, pa0); PK4(p0, 8, pa1); PK4(p1, 0, pa2); PK4(p1, 8, pa3);
#undef PK4
}
__device__ __forceinline__ void qkt(f32x16& p0, f32x16& p1, const char* K_buf, int r32, int hi, const bf16x8* qr) {
    p0 = f32x16{}; p1 = f32x16{};
#pragma unroll
    for (int d0 = 0; d0 < 4; ++d0) { const char* a = K_buf + KSWZ(r32, (d0 * 16 + hi * 8) * 2);
        bf16x8 b0 = *reinterpret_cast<const bf16x8*>(a);
        bf16x8 b1 = *reinterpret_cast<const bf16x8*>(a + 32 * 128);
        p0 = __builtin_amdgcn_mfma_f32_32x32x16_bf16(b0, qr[d0], p0, 0, 0, 0);
        p1 = __builtin_amdgcn_mfma_f32_32x32x16_bf16(b1, qr[d0], p1, 0, 0, 0); }
}
__device__ __forceinline__ void qkt_shift(f32x16& p0, f32x16& p1, const char* K_buf, int r32, int hi, const bf16x8* qr, const f32x16& negm) {
#pragma unroll
    for (int d0 = 0; d0 < 4; ++d0) { const char* a = K_buf + KSWZ(r32, (d0 * 16 + hi * 8) * 2);
        bf16x8 b0 = *reinterpret_cast<const bf16x8*>(a);
        bf16x8 b1 = *reinterpret_cast<const bf16x8*>(a + 32 * 128);
        if (d0 == 0) { p0 = __builtin_amdgcn_mfma_f32_32x32x16_bf16(b0, qr[0], negm, 0, 0, 0); p1 = __builtin_amdgcn_mfma_f32_32x32x16_bf16(b1, qr[0], negm, 0, 0, 0); }
        else { p0 = __builtin_amdgcn_mfma_f32_32x32x16_bf16(b0, qr[d0], p0, 0, 0, 0); p1 = __builtin_amdgcn_mfma_f32_32x32x16_bf16(b1, qr[d0], p1, 0, 0, 0); } }
}
__device__ __forceinline__ void partialSM_shift(f32x16& p0, f32x16& p1, float& m_reg, f32x16& negm, float& alpha) {
    float ma = MX3(p0[0], p0[1], p0[2]), mb = MX3(p0[3], p0[4], p0[5]), mc = MX3(p1[0], p1[1], p1[2]), md = MX3(p1[3], p1[4], p1[5]);
    ma = MX3(ma, p0[6], p0[7]); mb = MX3(mb, p0[8], p0[9]); mc = MX3(mc, p1[6], p1[7]); md = MX3(md, p1[8], p1[9]);
    ma = MX3(ma, p0[10], p0[11]); mb = MX3(mb, p0[12], p0[13]); mc = MX3(mc, p1[10], p1[11]); md = MX3(md, p1[12], p1[13]);
    ma = MX3(ma, p0[14], p0[15]); mc = MX3(mc, p1[14], p1[15]);
    float pmax = __builtin_fmaxf(MX3(ma, mb, mc), md);
    { auto rr = __builtin_amdgcn_permlane32_swap(__float_as_uint(pmax), __float_as_uint(pmax), false, false); pmax = fmaxf(__uint_as_float(rr[0]), __uint_as_float(rr[1])); }
    if (__builtin_expect(__all(pmax <= THR), 1)) { alpha = 1.f; }
    else { const float dl = fmaxf(pmax, 0.f); alpha = __builtin_amdgcn_exp2f(-dl); m_reg += dl;
#pragma unroll
        for (int r = 0; r < 16; ++r) { p0[r] = p0[r] - dl; p1[r] = p1[r] - dl; }
#pragma unroll
        for (int r = 0; r < 16; ++r) negm[r] = -m_reg;
        asm volatile("" : "+v"(negm)); }
#pragma unroll
    for (int r = 0; r < 16; ++r) p0[r] = __builtin_amdgcn_exp2f(p0[r]);
}
__device__ __forceinline__ void pv_tile(f32x16* o, int vb0, bf16x8 pa0, bf16x8 pa1, bf16x8 pa2, bf16x8 pa3) {
#define TRRD(dst, off) asm volatile("ds_read_b64_tr_b16 %0, %1 offset:%2" : "=&v"(dst) : "v"(vb0), "i"(off) : "memory")
#define PV_D0(d0) do { s16x4 l0, l1, l2, l3, h0, h1, h2, h3; constexpr int b_ = v_rd_off(d0, 0, 0);   \
        TRRD(l0, b_); TRRD(h0, b_ + 2048); TRRD(l1, b_ + 4096); TRRD(h1, b_ + 6144); TRRD(l2, b_ + 8192); TRRD(h2, b_ + 10240); TRRD(l3, b_ + 12288); TRRD(h3, b_ + 14336); \
        asm volatile("s_waitcnt lgkmcnt(0)" ::: "memory"); SBAR();   \
        o[d0] = __builtin_amdgcn_mfma_f32_32x32x16_bf16(pa0, (bf16x8){l0[0], l0[1], l0[2], l0[3], h0[0], h0[1], h0[2], h0[3]}, o[d0], 0, 0, 0);   \
        o[d0] = __builtin_amdgcn_mfma_f32_32x32x16_bf16(pa1, (bf16x8){l1[0], l1[1], l1[2], l1[3], h1[0], h1[1], h1[2], h1[3]}, o[d0], 0, 0, 0);   \
        o[d0] = __builtin_amdgcn_mfma_f32_32x32x16_bf16(pa2, (bf16x8){l2[0], l2[1], l2[2], l2[3], h2[0], h2[1], h2[2], h2[3]}, o[d0], 0, 0, 0);   \
        o[d0] = __builtin_amdgcn_mfma_f32_32x32x16_bf16(pa3, (bf16x8){l3[0], l3[1], l3[2], l3[3], h3[0], h3[1], h3[2], h3[3]}, o[d0], 0, 0, 0); } while (0)
    PV_D0(0); PV_D0(1); PV_D0(2); PV_D0(3);
#undef PV_D0
#undef TRRD
}
__device__ __forceinline__ void partialSM_noexp(f32x16& p0, f32x16& p1, float& m_reg, float& mn, float& alpha) {
    float pmax = p0[0];
#pragma unroll
    for (int r = 1; r < 16; ++r) pmax = fmaxf(pmax, p0[r]);
#pragma unroll
    for (int r = 0; r < 16; ++r) pmax = fmaxf(pmax, p1[r]);
    { auto rr = __builtin_amdgcn_permlane32_swap(__float_as_uint(pmax), __float_as_uint(pmax), false, false); pmax = fmaxf(__uint_as_float(rr[0]), __uint_as_float(rr[1])); }
    if (__builtin_expect(__all((pmax - m_reg) <= THR), 1)) { mn = m_reg; alpha = 1.f; }
    else { mn = fmaxf(m_reg, pmax); alpha = 1.f; m_reg = mn; }
#pragma unroll
    for (int r = 0; r < 16; ++r) p0[r] = p0[r] - mn;
#pragma unroll
    for (int r = 0; r < 16; ++r) p1[r] = p1[r] - mn;
}
__device__ __forceinline__ void finishSM_noexp(f32x16& p0, f32x16& p1, float alpha, float& l_reg, bf16x8& pa0, bf16x8& pa1, bf16x8& pa2, bf16x8& pa3) {
    float ps = 0;
#pragma unroll
    for (int r = 0; r < 16; ++r) ps += p0[r];
#pragma unroll
    for (int r = 0; r < 16; ++r) ps += p1[r];
    { auto rr = __builtin_amdgcn_permlane32_swap(__float_as_uint(ps), __float_as_uint(ps), false, false); ps = __uint_as_float(rr[0]) + __uint_as_float(rr[1]); }
    l_reg = l_reg * alpha + ps;
#define PK4(P, B_, OUT) do { unsigned a0 = cvtpk(P[B_+0], P[B_+1]), a1 = cvtpk(P[B_+2], P[B_+3]);                          \
        unsigned b0 = cvtpk(P[B_+4], P[B_+5]), b1 = cvtpk(P[B_+6], P[B_+7]);                                             \
        auto r0 = __builtin_amdgcn_permlane32_swap(a0, b0, false, false); auto r1 = __builtin_amdgcn_permlane32_swap(a1, b1, false, false); \
        u32x4 w = {r0[0], r1[0], r0[1], r1[1]}; OUT = *reinterpret_cast<bf16x8*>(&w); } while (0)
    PK4(p0, 0, pa0); PK4(p0, 8, pa1); PK4(p1, 0, pa2); PK4(p1, 8, pa3);
#undef PK4
}
__device__ __forceinline__ void qkt_nomma(f32x16& p0, f32x16& p1, const char* K_buf, int r32, int hi, const bf16x8* qr) {
    p0 = f32x16{}; p1 = f32x16{};
#pragma unroll
    for (int d0 = 0; d0 < 4; ++d0) { const char* a = K_buf + KSWZ(r32, (d0 * 16 + hi * 8) * 2);
        bf16x8 b0 = *reinterpret_cast<const bf16x8*>(a);
        bf16x8 b1 = *reinterpret_cast<const bf16x8*>(a + 32 * 128);
        p0[d0] += (float)b0[0] + (float)qr[d0][0]; p1[d0] += (float)b1[0]; }
}
__device__ __forceinline__ void pv_nomma(f32x16* o, int vb0, bf16x8 pa0, bf16x8 pa1, bf16x8 pa2, bf16x8 pa3) {
#define TRRD(dst, off) asm volatile("ds_read_b64_tr_b16 %0, %1 offset:%2" : "=&v"(dst) : "v"(vb0), "i"(off) : "memory")
#define PV_D0(d0) do { s16x4 l0, l1, l2, l3, h0, h1, h2, h3; constexpr int b_ = v_rd_off(d0, 0, 0);   \
        TRRD(l0, b_); TRRD(h0, b_ + 2048); TRRD(l1, b_ + 4096); TRRD(h1, b_ + 6144); TRRD(l2, b_ + 8192); TRRD(h2, b_ + 10240); TRRD(l3, b_ + 12288); TRRD(h3, b_ + 14336); \
        asm volatile("s_waitcnt lgkmcnt(0)" ::: "memory"); SBAR();   \
        o[d0][0] += (float)(l0[0] + h0[0] + l1[0] + h1[0] + l2[0] + h2[0] + l3[0] + h3[0]) + (float)pa0[0] + (float)pa1[0] + (float)pa2[0] + (float)pa3[0]; } while (0)
    PV_D0(0); PV_D0(1); PV_D0(2); PV_D0(3);
#undef PV_D0
#undef TRRD
}
struct BlockRef { const bf16* Q; const bf16* K; const bf16* V; bf16* O; int P0; };
struct Seam { bf16x8 qr[4]; bf16x8 st_v0, st_v1, st_k0; };
#define VMW() asm volatile("s_waitcnt vmcnt(0)" ::: "memory")
#define VMWN(n) asm volatile("s_waitcnt vmcnt(%0)" :: "i"(n) : "memory")
#define SLOAD_H(Kp, Vp, k0) do { S.st_v0 = load8((Vp) + (size_t)((k0) + sr) * PIN + sc); S.st_v1 = load8((Vp) + (size_t)((k0) + 32 + sr) * PIN + sc);   \
                                 S.st_k0 = load8((Kp) + (size_t)((k0) + ksr) * PIN + ksc); } while (0)
#define SWRITE_HK(bf) do { *(bf16x8*)(K_lds + (bf) * SHM_K + kws) = S.st_k0; } while (0)
#define SWRITE_HV(bf) do { *(bf16x8*)(V_lds + (bf) * SHM_V + vst0) = S.st_v0; *(bf16x8*)(V_lds + (bf) * SHM_V + vst1) = S.st_v1; } while (0)
#define SWRITE_H(bf) do { SWRITE_HV(bf); SWRITE_HK(bf); } while (0)
__device__ __forceinline__ void causal_prime(const BlockRef& cur, char* lds, Seam& S) {
    int tid_ = threadIdx.x; asm volatile("" : "+v"(tid_));
    const int tid = tid_, wid = __builtin_amdgcn_readfirstlane(tid >> 6), lane = tid & 63, r32 = lane & 31, hi = lane >> 5;
    const int sr = tid >> 4, sc = (tid & 15) * 8, ksr = tid >> 3, ksc = (tid & 7) * 8, kws = KSWZ(ksr, ksc * 2); char* K_lds = lds + NBUF * SHM_V;
#pragma unroll
    for (int d0 = 0; d0 < 4; ++d0) S.qr[d0] = load8(cur.Q + (size_t)(wid * QBLK + r32) * PIN + d0 * 16 + hi * 8);
    SLOAD_H(cur.K, cur.V, 0); VMW(); SWRITE_HK(0);
    __syncthreads();
}
template <int ABL = 0>
__device__ __forceinline__ void causal_block(const BlockRef& cur, const BlockRef& nxt, char* lds, Seam& S) {
    int tid_ = threadIdx.x; asm volatile("" : "+v"(tid_));
    const int tid = tid_, wid = __builtin_amdgcn_readfirstlane(tid >> 6), lane = tid & 63, r32 = lane & 31, hi = lane >> 5;
    const int NT = (cur.P0 + QB) / KVBLK;
    const int qlo = cur.P0 + wid * QBLK, qm = qlo + r32 - 4 * hi;
    char* V_lds = lds; char* K_lds = lds + NBUF * SHM_V;
    float* ws = (float*)(lds + NBUF * SHM_V + NBUF * SHM_K) + wid * 64; float* li_l = ws, * al_l = ws + 32;
    float m_reg = -1e30f, l_reg = 0; f32x16 o[4] = {};
    const int sr = tid >> 4, sc = (tid & 15) * 8, vst0 = v_st(sr, sc), vst1 = v_st(32 + sr, sc), ksr = tid >> 3, ksc = (tid & 7) * 8, kws = KSWZ(ksr, ksc * 2);
    const int vb0 = (int)(uintptr_t)V_lds + v_rd_base(lane);
    const bf16* Kh = cur.K; const bf16* Vh = cur.V;
#define RESC(a) do { if (__any((a) < 1.f)) { if (hi == 0) al_l[r32] = (a); asm volatile("s_waitcnt lgkmcnt(0)" ::: "memory");              \
                     _Pragma("unroll") for (int d_ = 0; d_ < 4; ++d_) _Pragma("unroll") for (int r = 0; r < 16; ++r) o[d_][r] *= al_l[crow(r, hi)]; } } while (0)
#define KBASE(t) ((t) * KVBLK)
#define MASKT(P0_, P1_, t) do { const int kb_ = KBASE(t); if (kb_ + KVBLK - 1 > qlo) { asm volatile("" ::: "memory"); mask_tile(P0_, P1_, qm - kb_); } } while (0)
    constexpr int NQL = 4;
#define SEAM_K0() do { VMWN(NQL); SWRITE_HK(0); SBAR(); } while (0)
    f32x16 pA0, pA1, pB0, pB1; float mnA, mnB, alA, alB; bf16x8 pa0, pa1, pa2, pa3;
    SWRITE_HV(0); SBAR();
    if (NT > 1) { SLOAD_H(Kh, Vh, KBASE(1)); }
    SBAR(); qkt(pA0, pA1, K_lds, r32, hi, S.qr);
    MASKT(pA0, pA1, 0); partialSM(pA0, pA1, m_reg, mnA, alA);
    f32x16 negm;
#pragma unroll
    for (int r = 0; r < 16; ++r) negm[r] = -m_reg;
    asm volatile("" : "+v"(negm));
    if (NT > 1) { VMW(); SWRITE_H(1); }
    __syncthreads();
    int bt = 1, bp = 0, bn = 2;
#define ROTB() do { const int o_ = bp; bp = bt; bt = bn; bn = o_; } while (0)
#define HALF_STEP(PX0, PX1, mnX, alX, PY0, PY1, alY, t) do {                                                                 \
        SBAR(); if constexpr (ABL != 6 && ABL < 9) { if constexpr (ABL == 2) qkt_nomma(PX0, PX1, K_lds + bt * SHM_K, r32, hi, S.qr); else qkt_shift(PX0, PX1, K_lds + bt * SHM_K, r32, hi, S.qr, negm); } \
        if constexpr (ABL != 7 && ABL < 9) { if constexpr (ABL == 1) finishSM_noexp(PY0, PY1, alY, l_reg, pa0, pa1, pa2, pa3); else finishSM(PY0, PY1, alY, l_reg, pa0, pa1, pa2, pa3); } SBAR(); \
        if constexpr (ABL != 4 && ABL < 9) { if ((t) + 1 < NT) { SLOAD_H(Kh, Vh, KBASE((t) + 1)); SBAR(); } }                              \
        if constexpr (ABL != 5 && ABL < 9) { if constexpr (ABL == 2) pv_nomma(o, vb0 + bp * SHM_V, pa0, pa1, pa2, pa3); else pv_tile(o, vb0 + bp * SHM_V, pa0, pa1, pa2, pa3); } \
        MASKT(PX0, PX1, (t)); if constexpr (ABL != 7 && ABL < 9) { if constexpr (ABL == 1) partialSM_noexp(PX0, PX1, m_reg, mnX, alX); else partialSM_shift(PX0, PX1, m_reg, negm, alX); } else { alX = 1.f; } \
        if constexpr (ABL != 4 && ABL < 9) { if ((t) + 1 < NT) { VMW(); SWRITE_H(bn); } }                                                  \
        RESC(alX); if constexpr (ABL != 3 && ABL != 10) __syncthreads(); ROTB(); } while (0)
    for (int t = 1; t + 1 < NT && ABL != 8; t += 2) {
        HALF_STEP(pB0, pB1, mnB, alB, pA0, pA1, alA, t);
        HALF_STEP(pA0, pA1, mnA, alA, pB0, pB1, alB, t + 1);
    }
    const bool even = (NT & 1) == 0;
    if (even) { SBAR(); qkt_shift(pB0, pB1, K_lds + bt * SHM_K, r32, hi, S.qr, negm); SBAR(); }
    SLOAD_H(nxt.K, nxt.V, 0); SBAR();
#pragma unroll
    for (int d0 = 0; d0 < 4; ++d0) S.qr[d0] = load8(nxt.Q + (size_t)(wid * QBLK + r32) * PIN + d0 * 16 + hi * 8);
    SBAR();
    finishSM(pA0, pA1, alA, l_reg, pa0, pa1, pa2, pa3); SBAR();
    pv_tile(o, vb0 + (even ? bp : bt) * SHM_V, pa0, pa1, pa2, pa3);
    if (even) { MASKT(pB0, pB1, NT - 1); partialSM_shift(pB0, pB1, m_reg, negm, alB); __syncthreads(); RESC(alB);
        finishSM(pB0, pB1, alB, l_reg, pa0, pa1, pa2, pa3); SBAR(); pv_tile(o, vb0 + bt * SHM_V, pa0, pa1, pa2, pa3); }
    SBAR(); SEAM_K0();
    if (hi == 0) li_l[r32] = l_reg; asm volatile("s_waitcnt lgkmcnt(0)" ::: "memory");
    float rli[16];
#pragma unroll
    for (int r = 0; r < 16; ++r) rli[r] = __builtin_amdgcn_rcpf(li_l[crow(r, hi)]);
    bf16* Ow = cur.O + (size_t)(wid * QBLK) * POUT;
    bf16* stg = (bf16*)(lds + OSTAGE_OFF) + wid * 2048;
#pragma unroll
    for (int h2 = 0; h2 < 2; ++h2) {
#pragma unroll
        for (int r = 0; r < 16; ++r) { const int orow = crow(r, hi);
#pragma unroll
            for (int dd = 0; dd < 2; ++dd) stg[orow * 64 + dd * 32 + r32] = __float2bfloat16(o[2 * h2 + dd][r] * rli[r]); }
        asm volatile("s_waitcnt lgkmcnt(0)" ::: "memory");
#pragma unroll
        for (int i = 0; i < 4; ++i) { const int row = i * 8 + (lane >> 3), ch = lane & 7; const u32x4 v = *(const u32x4*)(stg + row * 64 + ch * 8);
            *(u32x4*)(Ow + (size_t)row * POUT + h2 * 64 + ch * 8) = v; }
        asm volatile("s_waitcnt lgkmcnt(0)" ::: "memory");
    }
    __syncthreads();
#undef RESC
#undef KBASE
#undef MASKT
#undef SEAM_K0
#undef HALF_STEP
#undef ROTB
}
#undef VMW
#undef VMWN
#undef SLOAD_H
#undef SWRITE_HK
#undef SWRITE_HV
#undef SWRITE_H
#undef KSWZ
#undef SBAR
}

namespace cg = cooperative_groups;
constexpr int NWAVES = 8;
#ifndef MK_N_LAUNCHES
#define MK_N_LAUNCHES 1
#endif
constexpr int NPHASE = 14;

constexpr int M = 16384, DMOD = 1024, SEQL = 2048, NBATCH = 8, DFF = 2816, INC = 3072;
constexpr int NMT_UP = 65;

constexpr size_t MiB = 1u << 20;
constexpr size_t WS_CTL = 0, CTL_ZERO_BYTES = 64 * 1024;
constexpr int CW_PANEL = 8192;
constexpr int CW_BAR = 1024;
constexpr size_t WS_IDENT = 128 * 1024;
constexpr size_t WS_SS = 1 * MiB;
constexpr size_t WS_ROPE = 2 * MiB;
constexpr size_t WS_W = 3 * MiB;
constexpr size_t W_IN_OFF = 0, W_OUT_OFF = 6 * MiB, W_UP_OFF = 8 * MiB, W_DOWN_OFF = 19 * MiB, W_LAYER = 24 * MiB + MiB / 2;
constexpr size_t WS_XB = 52 * MiB + MiB / 2;
constexpr size_t WS_PROJ = 85 * MiB;
constexpr size_t WS_ACT = 85 * MiB;
constexpr size_t WS_OB = 181 * MiB;
constexpr size_t WS_MIX = 213 * MiB;
constexpr size_t WS_END = 245 * MiB;
static_assert(WS_W + 2 * W_LAYER <= WS_XB - MiB / 2 && WS_XB + (size_t)M * DMOD * 2 + MiB / 2 <= WS_PROJ && WS_PROJ + (size_t)M * INC * 2 <= WS_OB && WS_ACT + (size_t)M * DFF * 2 <= WS_OB && WS_MIX + (size_t)M * DMOD * 2 <= WS_END, "d_ws map");

constexpr int RING_OFF = 0, RING_BYTES = 131072;
constexpr int DMASK_TBL_OFF = 86016;
constexpr int HALO_OFF = RING_BYTES;
constexpr int MISC_OFF = HALO_OFF + 4096;
constexpr int P0_SCR_BYTES = 64 * 65 * 4;
constexpr int LRSTD_OFF = MISC_OFF + 256;
constexpr int LROPE_OFF = LRSTD_OFF + 1024;
constexpr int LCW_OFF = LROPE_OFF + 16384;
constexpr int LDS_BYTES = 155648;
static_assert(attn_b::LDS_BYTES <= DMASK_TBL_OFF && NWAVES * P0_SCR_BYTES <= MISC_OFF && LCW_OFF + 1536 <= LDS_BYTES && LDS_BYTES <= 163840 && attn_body::ATTN_LDS_BYTES <= DMASK_TBL_OFF && DMASK_TBL_OFF + attn_body::DMASK_TBL_N * 4 <= attn_b::OSTAGE_OFF && attn_b::OSTAGE_OFF + 32768 <= RING_BYTES, "LDS map");

#define GAS __attribute__((address_space(1)))
#define LAS __attribute__((address_space(3)))
typedef unsigned short bf16;
typedef unsigned v4u __attribute__((ext_vector_type(4)));
typedef unsigned v2u __attribute__((ext_vector_type(2)));
typedef float f32x4 __attribute__((ext_vector_type(4)));
#define LDS_WAIT() asm volatile("s_waitcnt lgkmcnt(0)" ::: "memory")
__device__ __forceinline__ unsigned f2bf(float f) { unsigned u = __builtin_bit_cast(unsigned, f); return (u + 0x7fffu + ((u >> 16) & 1u)) >> 16; }
__device__ __forceinline__ unsigned pk2(float lo, float hi) { return f2bf(lo) | (f2bf(hi) << 16); }
__device__ __forceinline__ float bflo(unsigned w) { return __builtin_bit_cast(float, w << 16); }
__device__ __forceinline__ float bfhi(unsigned w) { return __builtin_bit_cast(float, w & 0xffff0000u); }
__device__ __forceinline__ float wave_sum(float v) {
#pragma unroll
    for (int o = 1; o < 64; o <<= 1) v += __shfl_xor(v, o);
    return v;
}

#define XB_TMO      128
#define XB_XCNT(j)  (256  + 64 * (j))
#define XB_XSUB(j)  (1280 + 64 * (j))
#define XB_XGEN(j)  (2304 + 64 * (j))
#define XB_TOP      3328
#define XB_TOPGEN   3392
#define XCD_BAR_WORDS 3456
#define XB_SPIN_CAP (1u << 18)

__device__ __forceinline__ unsigned xb_ld(unsigned* p)              { return __hip_atomic_load(p, __ATOMIC_RELAXED, __HIP_MEMORY_SCOPE_AGENT); }
__device__ __forceinline__ unsigned xb_add(unsigned* p, unsigned v) { return __hip_atomic_fetch_add(p, v, __ATOMIC_RELAXED, __HIP_MEMORY_SCOPE_AGENT); }
__device__ __forceinline__ unsigned xb_xcc_id() { return (unsigned)__builtin_amdgcn_s_getreg((3 << 11) | 20) & 0xFu; }
#define XB_SPIN(cond, bar) do { unsigned _sp = 0; while (cond) { __builtin_amdgcn_s_sleep(1); \
    if ((++_sp & 255u) == 0u) { if (xb_ld(&(bar)[XB_TMO])) break; if (_sp > XB_SPIN_CAP) { atomicAdd(&(bar)[XB_TMO], 1u); break; } } } } while (0)

struct XcdBarrier {
    unsigned* bar; unsigned x;
    volatile LAS unsigned* st;
};

__device__ __forceinline__ XcdBarrier xcd_barrier_post(unsigned* bar, volatile LAS unsigned* st) {
    XcdBarrier b; b.bar = bar; b.x = xb_xcc_id(); b.st = st;
    if (threadIdx.x == 0) (void)xb_add(&bar[XB_XCNT(b.x)], 1u);
    return b;
}
__device__ __forceinline__ void xcd_barrier_complete(unsigned* bar, unsigned x, unsigned& nloc, unsigned& nx) {
    const unsigned G = gridDim.x * gridDim.y * gridDim.z;
    unsigned sum, cnt, mine, sp = 0u;
    for (;;) {
        sum = 0u; cnt = 0u; mine = 0u;
#pragma unroll
        for (unsigned j = 0; j < 16; ++j) { const unsigned c = xb_ld(&bar[XB_XCNT(j)]); sum += c; cnt += (c > 0u) ? 1u : 0u; mine = (j == x) ? c : mine; }
        if (sum == G) break;
        __builtin_amdgcn_s_sleep(1);
        if ((++sp & 255u) == 0u) { if (xb_ld(&bar[XB_TMO])) break; if (sp > XB_SPIN_CAP) { atomicAdd(&bar[XB_TMO], 1u); break; } }
    }
    nloc = mine > 0u ? mine : 1u; nx = cnt > 0u ? cnt : 1u;
}

__device__ __forceinline__ void xcd_barrier(const XcdBarrier& b) {
    asm volatile("s_waitcnt vmcnt(0)" ::: "memory");
    __syncthreads();
    if (threadIdx.x == 0) {
        unsigned* bar = b.bar;
        __builtin_amdgcn_s_waitcnt(0);
        unsigned nloc = b.st[0], nx = b.st[1];
        if (nloc == 0u) { xcd_barrier_complete(bar, b.x, nloc, nx); b.st[0] = nloc; b.st[1] = nx; }
        const unsigned old = xb_add(&bar[XB_XSUB(b.x)], 1u);
        const unsigned gen = old / nloc;
        if (old + 1u == (gen + 1u) * nloc) {
            __builtin_amdgcn_fence(__ATOMIC_RELEASE, "agent");
            asm volatile("s_waitcnt vmcnt(0)" ::: "memory");
            const unsigned og = xb_add(&bar[XB_TOP], 1u);
            const unsigned tg = og / nx;
            if (og + 1u == (tg + 1u) * nx) xb_add(&bar[XB_TOPGEN], 1u);
            else XB_SPIN(xb_ld(&bar[XB_TOPGEN]) == tg, bar);
            __builtin_amdgcn_fence(__ATOMIC_ACQUIRE, "agent");
            xb_add(&bar[XB_XGEN(b.x)], 1u);
            asm volatile("s_waitcnt vmcnt(0)" ::: "memory");
        } else {
            XB_SPIN(xb_ld(&bar[XB_XGEN(b.x)]) == gen, bar);
            __builtin_amdgcn_fence(__ATOMIC_ACQUIRE, "agent");
            asm volatile("s_waitcnt vmcnt(0)" ::: "memory");
        }
    }
    __syncthreads();
}

struct Args { const float* in[16]; float* out; unsigned char* ws; int ph_lo, ph_hi; };
static_assert(sizeof(Args) == 16 * 8 + 8 + 8 + 8, "Args has no padding");

struct Frame {
    LAS unsigned char* lds;
    int tid, lane, wave, vcu, G;
    float* out; unsigned char* ws;
};
__device__ __forceinline__ const float* karg_in(int i) {
    const __attribute__((address_space(4))) char* kp = (const __attribute__((address_space(4))) char*)__builtin_amdgcn_kernarg_segment_ptr();
    asm volatile("" : "+s"(kp));
    return ((const float* const __attribute__((address_space(4)))*)kp)[i];
}

__device__ __forceinline__ void p0_transpose_item(const float* W, int K, int N, bf16* WT, int k0, int n0, int drow0, const float* gain, LAS float* scr, int lane) {
    const int lr = lane >> 4, lc = (lane & 15) * 4;
    f32x4 v[16];
#pragma unroll
    for (int i = 0; i < 16; ++i) v[i] = __builtin_nontemporal_load((const f32x4*)(W + (size_t)(k0 + lr + 4 * i) * N + n0 + lc));
    if (gain) {
#pragma unroll
        for (int i = 0; i < 16; ++i) v[i] = v[i] * gain[k0 + lr + 4 * i];
    }
#pragma unroll
    for (int i = 0; i < 16; ++i) { LAS float* p = scr + (lr + 4 * i) * 65 + lc; p[0] = v[i].x; p[1] = v[i].y; p[2] = v[i].z; p[3] = v[i].w; }
    LDS_WAIT(); asm volatile("" ::: "memory");
    const int c = lane >> 3, nn = lane & 7;
#pragma unroll
    for (int j = 0; j < 8; ++j) { const int n = nn + 8 * j; const LAS float* q = scr + (8 * c) * 65 + n;
        v4u o; o.x = pk2(q[0 * 65], q[1 * 65]); o.y = pk2(q[2 * 65], q[3 * 65]); o.z = pk2(q[4 * 65], q[5 * 65]); o.w = pk2(q[6 * 65], q[7 * 65]);
        *(v4u*)(WT + (size_t)(drow0 + n) * K + k0 + 8 * c) = o; }
    LDS_WAIT(); asm volatile("" ::: "memory");
}
__device__ __forceinline__ int up_dest_row(int n0) { const int half = n0 >= DFF ? 1 : 0, n = n0 - half * DFF; return (n >> 7) * 256 + half * 128 + (n & 127); }

__device__ __forceinline__ void p0_convert_layer(Frame& F, int L, int widx, int nw, int part = 0) {
    { int t_ = threadIdx.x; asm volatile("" : "+v"(t_)); F.tid = t_; F.lane = t_ & 63; }
    LAS float* scr = (LAS float*)(F.lds + RING_OFF + F.wave * P0_SCR_BYTES);
    constexpr int I_IN = (DMOD / 64) * (INC / 64), I_OUT = (DMOD / 64) * (DMOD / 64), I_UP = (DMOD / 64) * (2 * DFF / 64), I_DN = (DFF / 64) * (DMOD / 64);
    constexpr int I_LAYER = I_IN + I_OUT + I_UP + I_DN;
    unsigned char* wl = F.ws + WS_W + (size_t)L * W_LAYER;
    const int it_lo = (part == 2) ? I_IN : 0, it_hi = (part == 1) ? I_IN : I_LAYER;
    for (int it = it_lo + widx; it < it_hi; it += nw) {
        int r = it;
        if (r < I_IN) { const int nb = INC / 64, kb = r / nb, n0 = 64 * (r % nb);
            p0_transpose_item(karg_in(3) + (size_t)L * DMOD * INC, DMOD, INC, (bf16*)(wl + W_IN_OFF), 64 * kb, n0, n0, karg_in(2) + L * DMOD, scr, F.lane); continue; }
        r -= I_IN;
        if (r < I_OUT) { const int nb = DMOD / 64, kb = r / nb, n0 = 64 * (r % nb);
            p0_transpose_item(karg_in(10) + (size_t)L * DMOD * DMOD, DMOD, DMOD, (bf16*)(wl + W_OUT_OFF), 64 * kb, n0, n0, nullptr, scr, F.lane); continue; }
        r -= I_OUT;
        if (r < I_UP) { const int nb = 2 * DFF / 64, kb = r / nb, n0 = 64 * (r % nb);
            p0_transpose_item(karg_in(12) + (size_t)L * DMOD * 2 * DFF, DMOD, 2 * DFF, (bf16*)(wl + W_UP_OFF), 64 * kb, n0, up_dest_row(n0), karg_in(11) + L * DMOD, scr, F.lane); continue; }
        r -= I_UP;
        { const int nb = DMOD / 64, kb = r / nb, n0 = 64 * (r % nb);
            p0_transpose_item(karg_in(14) + (size_t)L * DFF * DMOD, DFF, DMOD, (bf16*)(wl + W_DOWN_OFF), 64 * kb, n0, n0, nullptr, scr, F.lane); }
    }
}

__device__ __forceinline__ void p0_prologue(Frame& F) {
    const int gw = F.vcu * NWAVES + F.wave, NGW = F.G * NWAVES;
    p0_convert_layer(F, 0, gw, NGW, 1);
    bf16* XB = (bf16*)(F.ws + WS_XB); float* SS = (float*)(F.ws + WS_SS);
    for (int m = gw; m < M; m += NGW) {
        const f32x4* xr = (const f32x4*)(karg_in(0) + (size_t)m * DMOD) + F.lane;
        f32x4 v[4]; float s = 0.f;
#pragma unroll
        for (int j = 0; j < 4; ++j) { v[j] = __builtin_nontemporal_load(xr + 64 * j); s += (v[j].x * v[j].x + v[j].y * v[j].y) + (v[j].z * v[j].z + v[j].w * v[j].w); }
        s = wave_sum(s);
        unsigned long long* o8 = (unsigned long long*)(XB + (size_t)m * DMOD) + F.lane;
#pragma unroll
        for (int j = 0; j < 4; ++j) o8[64 * j] = (unsigned long long)pk2(v[j].x, v[j].y) | ((unsigned long long)pk2(v[j].z, v[j].w) << 32);
        if (F.lane < 16) SS[(size_t)m * 16 + F.lane] = (F.lane == 0) ? s : 0.f;
    }
    if (gw == 0 && F.lane < 16) ((float*)(F.ws + WS_IDENT))[F.lane] = F.lane < 8 ? 1.0f : 0.0f;
    const int* pos = (const int*)karg_in(1); float* rope = (float*)(F.ws + WS_ROPE);
    const int gt = (F.vcu * NWAVES + F.wave) * 64 + F.lane, NGT = F.G * NWAVES * 64;
    for (int idx = gt; idx < M * 8; idx += NGT) {
        const int m = idx >> 3, i = idx & 7;
        const double invd = (i == 0) ? 1.0 : (i == 1) ? 0.19392274474868576 : (i == 2) ? 0.03760603093086393 : (i == 3) ? 0.007292664737217109 : (i == 4) ? 0.001414213562373095 :
                            (i == 5) ? 0.0002742481756762073 : (i == 6) ? 5.318295896944988e-05 : 1.031338537721246e-05;
        const double ang = (double)pos[m] * (double)(float)invd;
        const double k = __builtin_rint(ang * 0.15915494309189535);
        const float r = (float)(ang - k * 6.283185307179586);
        rope[(size_t)m * 16 + i] = cosf(r); rope[(size_t)m * 16 + 8 + i] = sinf(r);
    }
}

__device__ __forceinline__ void p_combine(Frame& F, int L) {
    { int t_ = threadIdx.x; asm volatile("" : "+v"(t_)); F.tid = t_; F.lane = t_ & 63; }
    const int gw = F.vcu * NWAVES + F.wave, NGW = F.G * NWAVES, lane = F.lane;
    const float lam_init = 0.8f - 0.6f * expf(-0.3f * (float)L);
    const float d1 = wave_sum(karg_in(4)[L * 64 + lane] * karg_in(5)[L * 64 + lane]), d2 = wave_sum(karg_in(6)[L * 64 + lane] * karg_in(7)[L * 64 + lane]);
    const float lam = expf(d1) - expf(d2) + lam_init, osc = 1.0f - lam_init;
    const bf16* OB = (const bf16*)(F.ws + WS_OB); const bf16* PROJ = (const bf16*)(F.ws + WS_PROJ); bf16* MIX = (bf16*)(F.ws + WS_MIX);
    const int h = lane >> 4, e0 = (lane & 15) * 8, c0 = lane * 4;
    const float* sg = karg_in(8) + L * 128 + e0; const f32x4 g0 = *(const f32x4*)sg, g1 = *(const f32x4*)(sg + 4);
    const float* cw = karg_in(9) + L * 3 * 256 + c0; const f32x4 w0 = *(const f32x4*)cw, w1 = *(const f32x4*)(cw + 256), w2 = *(const f32x4*)(cw + 512);
    constexpr int UR = 4;
    for (int mb = gw; mb < M; mb += UR * NGW) {
        v4u a[UR], b[UR]; v2u cb[UR], cc[UR][3], ch[UR][3]; float f1[UR], f2[UR];
#pragma unroll
        for (int u = 0; u < UR; ++u) {
            const int m = mb + u * NGW, t = m & (SEQL - 1);
            const bf16* ob = OB + (size_t)m * 1024 + h * 256 + e0;
            a[u] = __builtin_nontemporal_load((const v4u*)ob); b[u] = __builtin_nontemporal_load((const v4u*)(ob + 128));
            const bf16* pr = PROJ + (size_t)m * INC + c0;
            const int o1 = t >= 1 ? INC : 0, o2 = t >= 2 ? 2 * INC : 0;
            f1[u] = t >= 1 ? 1.f : 0.f; f2[u] = t >= 2 ? 1.f : 0.f;
            cb[u] = *(const v2u*)(pr + 2304);
            cc[u][2] = *(const v2u*)(pr + 2560); ch[u][2] = *(const v2u*)(pr + 2816);
            cc[u][1] = *(const v2u*)(pr - o1 + 2560); ch[u][1] = *(const v2u*)(pr - o1 + 2816);
            cc[u][0] = *(const v2u*)(pr - o2 + 2560); ch[u][0] = *(const v2u*)(pr - o2 + 2816);
        }
#pragma unroll
        for (int u = 0; u < UR; ++u) {
            const int m = mb + u * NGW;
            float o[8];
#pragma unroll
            for (int i = 0; i < 4; ++i) { o[2 * i] = bflo(a[u][i]) - lam * bflo(b[u][i]); o[2 * i + 1] = bfhi(a[u][i]) - lam * bfhi(b[u][i]); }
            float ss = 0.f;
#pragma unroll
            for (int i = 0; i < 8; ++i) ss += o[i] * o[i];
            ss += __shfl_xor(ss, 1); ss += __shfl_xor(ss, 2); ss += __shfl_xor(ss, 4); ss += __shfl_xor(ss, 8);
            const float rs = osc / sqrtf(ss * (1.0f / 128.0f) + 1e-5f);
            v4u w; w.x = pk2(o[0] * rs * g0[0], o[1] * rs * g0[1]); w.y = pk2(o[2] * rs * g0[2], o[3] * rs * g0[3]); w.z = pk2(o[4] * rs * g1[0], o[5] * rs * g1[1]); w.w = pk2(o[6] * rs * g1[2], o[7] * rs * g1[3]);
            *(v4u*)(MIX + (size_t)m * 1024 + 256 + h * 128 + e0) = w;
            f32x4 acc;
            acc[0] = w2[0] * bflo(cc[u][2][0]) * bflo(ch[u][2][0]); acc[1] = w2[1] * bfhi(cc[u][2][0]) * bfhi(ch[u][2][0]); acc[2] = w2[2] * bflo(cc[u][2][1]) * bflo(ch[u][2][1]); acc[3] = w2[3] * bfhi(cc[u][2][1]) * bfhi(ch[u][2][1]);
            { const f32x4 ww = w1 * f1[u];
              acc[0] += ww[0] * bflo(cc[u][1][0]) * bflo(ch[u][1][0]); acc[1] += ww[1] * bfhi(cc[u][1][0]) * bfhi(ch[u][1][0]); acc[2] += ww[2] * bflo(cc[u][1][1]) * bflo(ch[u][1][1]); acc[3] += ww[3] * bfhi(cc[u][1][1]) * bfhi(ch[u][1][1]); }
            { const f32x4 ww = w0 * f2[u];
              acc[0] += ww[0] * bflo(cc[u][0][0]) * bflo(ch[u][0][0]); acc[1] += ww[1] * bfhi(cc[u][0][0]) * bfhi(ch[u][0][0]); acc[2] += ww[2] * bflo(cc[u][0][1]) * bflo(ch[u][0][1]); acc[3] += ww[3] * bfhi(cc[u][0][1]) * bfhi(ch[u][0][1]); }
            v2u oc; oc.x = pk2(bflo(cb[u][0]) * acc[0], bfhi(cb[u][0]) * acc[1]); oc.y = pk2(bflo(cb[u][1]) * acc[2], bfhi(cb[u][1]) * acc[3]);
            *(v2u*)(MIX + (size_t)m * 1024 + 768 + c0) = oc;
        }
    }
}

__device__ __forceinline__ void p_final(Frame& F, float* dst) {
    { int t_ = threadIdx.x; asm volatile("" : "+v"(t_)); F.tid = t_; F.lane = t_ & 63; }
    const int gw = F.vcu * NWAVES + F.wave, NGW = F.G * NWAVES;
    const bf16* XBp = (const bf16*)(F.ws + WS_XB);
    const f32x4* gp = (const f32x4*)karg_in(15) + 2 * F.lane; f32x4 g[4];
#pragma unroll
    for (int j = 0; j < 2; ++j) { g[2 * j] = gp[128 * j]; g[2 * j + 1] = gp[128 * j + 1]; }
    for (int mb = gw; mb < M; mb += 2 * NGW) {
        v4u raw[2][2];
#pragma unroll
        for (int u = 0; u < 2; ++u)
#pragma unroll
            for (int j = 0; j < 2; ++j) raw[u][j] = *((const v4u*)(XBp + (size_t)(mb + u * NGW) * DMOD) + F.lane + 64 * j);
#pragma unroll
        for (int u = 0; u < 2; ++u) {
            f32x4 v[4]; float s = 0.f;
#pragma unroll
            for (int j = 0; j < 2; ++j) { const v4u r = raw[u][j];
                v[2 * j] = (f32x4){bflo(r.x), bfhi(r.x), bflo(r.y), bfhi(r.y)}; v[2 * j + 1] = (f32x4){bflo(r.z), bfhi(r.z), bflo(r.w), bfhi(r.w)}; }
#pragma unroll
            for (int j = 0; j < 4; ++j) s += (v[j].x * v[j].x + v[j].y * v[j].y) + (v[j].z * v[j].z + v[j].w * v[j].w);
            const float rs = 1.0f / sqrtf(wave_sum(s) * (1.0f / DMOD) + 1e-6f);
            f32x4* dr = (f32x4*)(dst + (size_t)(mb + u * NGW) * DMOD) + 2 * F.lane;
#pragma unroll
            for (int j = 0; j < 2; ++j) { dr[128 * j] = v[2 * j] * rs * g[2 * j]; dr[128 * j + 1] = v[2 * j + 1] * rs * g[2 * j + 1]; }
        }
    }
}

__device__ const unsigned short ATT_SCHED[256][8] = {
  {7,2,0,65535,65535,65535,65535,65535},{15,10,8,65535,65535,65535,65535,65535},{6,259,512,65535,65535,65535,65535,65535},{14,267,520,65535,65535,65535,65535,65535},
  {5,1,517,65535,65535,65535,65535,65535},{13,9,525,65535,65535,65535,65535,65535},{251,519,763,65535,65535,65535,65535,65535},{23,18,16,65535,65535,65535,65535,65535},
  {31,26,24,65535,65535,65535,65535,65535},{22,275,528,65535,65535,65535,65535,65535},{30,283,536,65535,65535,65535,65535,65535},{21,17,533,65535,65535,65535,65535,65535},
  {29,25,541,65535,65535,65535,65535,65535},{139,527,651,65535,65535,65535,65535,65535},{39,34,32,65535,65535,65535,65535,65535},{47,42,40,65535,65535,65535,65535,65535},
  {38,291,544,65535,65535,65535,65535,65535},{46,299,552,65535,65535,65535,65535,65535},{37,33,549,65535,65535,65535,65535,65535},{45,41,557,65535,65535,65535,65535,65535},
  {3,535,515,65535,65535,65535,65535,65535},{55,50,48,65535,65535,65535,65535,65535},{63,58,56,65535,65535,65535,65535,65535},{54,307,560,65535,65535,65535,65535,65535},
  {62,315,568,65535,65535,65535,65535,65535},{53,49,565,65535,65535,65535,65535,65535},{61,57,573,65535,65535,65535,65535,65535},{27,543,539,65535,65535,65535,65535,65535},
  {71,66,64,65535,65535,65535,65535,65535},{79,74,72,65535,65535,65535,65535,65535},{70,323,576,65535,65535,65535,65535,65535},{78,331,584,65535,65535,65535,65535,65535},
  {69,65,581,65535,65535,65535,65535,65535},{77,73,589,65535,65535,65535,65535,65535},{83,551,595,65535,65535,65535,65535,65535},{87,82,80,65535,65535,65535,65535,65535},
  {95,90,88,65535,65535,65535,65535,65535},{86,339,592,65535,65535,65535,65535,65535},{94,347,600,65535,65535,65535,65535,65535},{85,81,597,65535,65535,65535,65535,65535},
  {93,89,605,65535,65535,65535,65535,65535},{107,559,619,65535,65535,65535,65535,65535},{103,98,96,65535,65535,65535,65535,65535},{111,106,104,65535,65535,65535,65535,65535},
  {102,355,608,65535,65535,65535,65535,65535},{110,363,616,65535,65535,65535,65535,65535},{101,97,613,65535,65535,65535,65535,65535},{109,105,621,65535,65535,65535,65535,65535},
  {227,567,739,65535,65535,65535,65535,65535},{119,114,112,65535,65535,65535,65535,65535},{127,122,120,65535,65535,65535,65535,65535},{118,371,624,65535,65535,65535,65535,65535},
  {126,379,632,65535,65535,65535,65535,65535},{117,113,629,65535,65535,65535,65535,65535},{125,121,637,65535,65535,65535,65535,65535},{11,575,523,65535,65535,65535,65535,65535},
  {135,130,128,65535,65535,65535,65535,65535},{143,138,136,65535,65535,65535,65535,65535},{134,387,640,65535,65535,65535,65535,65535},{142,395,648,65535,65535,65535,65535,65535},
  {133,129,645,65535,65535,65535,65535,65535},{141,137,653,65535,65535,65535,65535,65535},{179,583,691,65535,65535,65535,65535,65535},{151,146,144,65535,65535,65535,65535,65535},
  {159,154,152,65535,65535,65535,65535,65535},{150,403,656,65535,65535,65535,65535,65535},{158,411,664,65535,65535,65535,65535,65535},{149,145,661,65535,65535,65535,65535,65535},
  {157,153,669,65535,65535,65535,65535,65535},{51,591,563,65535,65535,65535,65535,65535},{167,162,160,65535,65535,65535,65535,65535},{175,170,168,65535,65535,65535,65535,65535},
  {166,419,672,65535,65535,65535,65535,65535},{174,427,680,65535,65535,65535,65535,65535},{165,161,677,65535,65535,65535,65535,65535},{173,169,685,65535,65535,65535,65535,65535},
  {131,599,643,65535,65535,65535,65535,65535},{183,178,176,65535,65535,65535,65535,65535},{191,186,184,65535,65535,65535,65535,65535},{182,435,688,65535,65535,65535,65535,65535},
  {190,443,696,65535,65535,65535,65535,65535},{181,177,693,65535,65535,65535,65535,65535},{189,185,701,65535,65535,65535,65535,65535},{123,607,635,65535,65535,65535,65535,65535},
  {199,194,192,65535,65535,65535,65535,65535},{207,202,200,65535,65535,65535,65535,65535},{198,451,704,65535,65535,65535,65535,65535},{206,459,712,65535,65535,65535,65535,65535},
  {197,193,709,65535,65535,65535,65535,65535},{205,201,717,65535,65535,65535,65535,65535},{187,615,699,65535,65535,65535,65535,65535},{215,210,208,65535,65535,65535,65535,65535},
  {223,218,216,65535,65535,65535,65535,65535},{214,467,720,65535,65535,65535,65535,65535},{222,475,728,65535,65535,65535,65535,65535},{213,209,725,65535,65535,65535,65535,65535},
  {221,217,733,65535,65535,65535,65535,65535},{147,623,659,65535,65535,65535,65535,65535},{231,226,224,65535,65535,65535,65535,65535},{239,234,232,65535,65535,65535,65535,65535},
  {230,483,736,65535,65535,65535,65535,65535},{238,491,744,65535,65535,65535,65535,65535},{229,225,741,65535,65535,65535,65535,65535},{237,233,749,65535,65535,65535,65535,65535},
  {59,631,571,65535,65535,65535,65535,65535},{247,242,240,65535,65535,65535,65535,65535},{255,250,248,65535,65535,65535,65535,65535},{246,499,752,65535,65535,65535,65535,65535},
  {254,507,760,65535,65535,65535,65535,65535},{245,241,757,65535,65535,65535,65535,65535},{253,249,765,65535,65535,65535,65535,65535},{75,639,587,65535,65535,65535,65535,65535},
  {263,258,256,65535,65535,65535,65535,65535},{271,266,264,65535,65535,65535,65535,65535},{262,257,516,65535,65535,65535,65535,65535},{270,265,524,65535,65535,65535,65535,65535},
  {261,534,529,65535,65535,65535,65535,65535},{269,574,569,65535,65535,65535,65535,65535},{163,647,675,65535,65535,65535,65535,65535},{4,260,514,65535,65535,65535,65535,65535},
  {12,268,522,65535,65535,65535,65535,65535},{279,274,272,65535,65535,65535,65535,65535},{287,282,280,65535,65535,65535,65535,65535},{278,273,532,65535,65535,65535,65535,65535},
  {286,281,540,65535,65535,65535,65535,65535},{285,542,537,65535,65535,65535,65535,65535},{277,750,745,65535,65535,65535,65535,65535},{203,655,715,65535,65535,65535,65535,65535},
  {20,276,530,65535,65535,65535,65535,65535},{28,284,538,65535,65535,65535,65535,65535},{295,290,288,65535,65535,65535,65535,65535},{303,298,296,65535,65535,65535,65535,65535},
  {294,289,548,65535,65535,65535,65535,65535},{302,297,556,65535,65535,65535,65535,65535},{301,686,681,65535,65535,65535,65535,65535},{293,710,705,65535,65535,65535,65535,65535},
  {219,663,731,65535,65535,65535,65535,65535},{36,292,546,65535,65535,65535,65535,65535},{44,300,554,65535,65535,65535,65535,65535},{311,306,304,65535,65535,65535,65535,65535},
  {319,314,312,65535,65535,65535,65535,65535},{310,305,564,65535,65535,65535,65535,65535},{318,313,572,65535,65535,65535,65535,65535},{309,590,585,65535,65535,65535,65535,65535},
  {317,630,625,65535,65535,65535,65535,65535},{99,671,611,65535,65535,65535,65535,65535},{52,308,562,65535,65535,65535,65535,65535},{60,316,570,65535,65535,65535,65535,65535},
  {327,322,320,65535,65535,65535,65535,65535},{335,330,328,65535,65535,65535,65535,65535},{326,321,580,65535,65535,65535,65535,65535},{334,329,588,65535,65535,65535,65535,65535},
  {333,638,633,65535,65535,65535,65535,65535},{325,678,673,65535,65535,65535,65535,65535},{67,679,579,65535,65535,65535,65535,65535},{68,324,578,65535,65535,65535,65535,65535},
  {76,332,586,65535,65535,65535,65535,65535},{343,338,336,65535,65535,65535,65535,65535},{351,346,344,65535,65535,65535,65535,65535},{342,337,596,65535,65535,65535,65535,65535},
  {350,345,604,65535,65535,65535,65535,65535},{341,550,545,65535,65535,65535,65535,65535},{349,726,721,65535,65535,65535,65535,65535},{43,687,555,65535,65535,65535,65535,65535},
  {84,340,594,65535,65535,65535,65535,65535},{92,348,602,65535,65535,65535,65535,65535},{359,354,352,65535,65535,65535,65535,65535},{367,362,360,65535,65535,65535,65535,65535},
  {358,353,612,65535,65535,65535,65535,65535},{366,361,620,65535,65535,65535,65535,65535},{365,558,553,65535,65535,65535,65535,65535},{357,670,665,65535,65535,65535,65535,65535},
  {243,695,755,65535,65535,65535,65535,65535},{100,356,610,65535,65535,65535,65535,65535},{108,364,618,65535,65535,65535,65535,65535},{375,370,368,65535,65535,65535,65535,65535},
  {383,378,376,65535,65535,65535,65535,65535},{374,369,628,65535,65535,65535,65535,65535},{382,377,636,65535,65535,65535,65535,65535},{381,606,601,65535,65535,65535,65535,65535},
  {373,702,697,65535,65535,65535,65535,65535},{115,703,627,65535,65535,65535,65535,65535},{116,372,626,65535,65535,65535,65535,65535},{124,380,634,65535,65535,65535,65535,65535},
  {391,386,384,65535,65535,65535,65535,65535},{399,394,392,65535,65535,65535,65535,65535},{390,385,644,65535,65535,65535,65535,65535},{398,393,652,65535,65535,65535,65535,65535},
  {397,526,521,65535,65535,65535,65535,65535},{389,598,593,65535,65535,65535,65535,65535},{35,711,547,65535,65535,65535,65535,65535},{132,388,642,65535,65535,65535,65535,65535},
  {140,396,650,65535,65535,65535,65535,65535},{407,402,400,65535,65535,65535,65535,65535},{415,410,408,65535,65535,65535,65535,65535},{406,401,660,65535,65535,65535,65535,65535},
  {414,409,668,65535,65535,65535,65535,65535},{405,622,617,65535,65535,65535,65535,65535},{413,734,729,65535,65535,65535,65535,65535},{235,719,747,65535,65535,65535,65535,65535},
  {148,404,658,65535,65535,65535,65535,65535},{156,412,666,65535,65535,65535,65535,65535},{423,418,416,65535,65535,65535,65535,65535},{431,426,424,65535,65535,65535,65535,65535},
  {422,417,676,65535,65535,65535,65535,65535},{430,425,684,65535,65535,65535,65535,65535},{421,646,641,65535,65535,65535,65535,65535},{429,758,753,65535,65535,65535,65535,65535},
  {91,727,603,65535,65535,65535,65535,65535},{164,420,674,65535,65535,65535,65535,65535},{172,428,682,65535,65535,65535,65535,65535},{439,434,432,65535,65535,65535,65535,65535},
  {447,442,440,65535,65535,65535,65535,65535},{438,433,692,65535,65535,65535,65535,65535},{446,441,700,65535,65535,65535,65535,65535},{437,582,577,65535,65535,65535,65535,65535},
  {445,614,609,65535,65535,65535,65535,65535},{155,735,667,65535,65535,65535,65535,65535},{180,436,690,65535,65535,65535,65535,65535},{188,444,698,65535,65535,65535,65535,65535},
  {455,450,448,65535,65535,65535,65535,65535},{463,458,456,65535,65535,65535,65535,65535},{454,449,708,65535,65535,65535,65535,65535},{462,457,716,65535,65535,65535,65535,65535},
  {461,654,649,65535,65535,65535,65535,65535},{453,742,737,65535,65535,65535,65535,65535},{195,743,707,65535,65535,65535,65535,65535},{196,452,706,65535,65535,65535,65535,65535},
  {204,460,714,65535,65535,65535,65535,65535},{471,466,464,65535,65535,65535,65535,65535},{479,474,472,65535,65535,65535,65535,65535},{470,465,724,65535,65535,65535,65535,65535},
  {478,473,732,65535,65535,65535,65535,65535},{477,662,657,65535,65535,65535,65535,65535},{469,766,761,65535,65535,65535,65535,65535},{19,751,531,65535,65535,65535,65535,65535},
  {212,468,722,65535,65535,65535,65535,65535},{220,476,730,65535,65535,65535,65535,65535},{487,482,480,65535,65535,65535,65535,65535},{495,490,488,65535,65535,65535,65535,65535},
  {486,481,740,65535,65535,65535,65535,65535},{494,489,748,65535,65535,65535,65535,65535},{485,566,561,65535,65535,65535,65535,65535},{493,718,713,65535,65535,65535,65535,65535},
  {171,759,683,65535,65535,65535,65535,65535},{228,484,738,65535,65535,65535,65535,65535},{236,492,746,65535,65535,65535,65535,65535},{503,498,496,65535,65535,65535,65535,65535},
  {511,506,504,65535,65535,65535,65535,65535},{502,497,756,65535,65535,65535,65535,65535},{510,505,764,65535,65535,65535,65535,65535},{509,518,513,65535,65535,65535,65535,65535},
  {501,694,689,65535,65535,65535,65535,65535},{211,767,723,65535,65535,65535,65535,65535},{244,500,754,65535,65535,65535,65535,65535},{252,508,762,65535,65535,65535,65535,65535},
};

__device__ __forceinline__ attn_b::BlockRef bref(const attn_b::bf16* PROJ, attn_b::bf16* OB, int id) {
    const int qb = id & 7, pr = (id >> 3) & 1, h = (id >> 4) & 3, b = id >> 6;
    attn_b::BlockRef r; const size_t row0 = (size_t)b * SEQL;
    r.Q = PROJ + (row0 + qb * 256) * INC + 768 + h * 128 + pr * 64;
    r.K = PROJ + row0 * INC + 1280 + h * 128 + pr * 64;
    r.V = PROJ + row0 * INC + 1792 + h * 128;
    r.O = OB + (row0 + qb * 256) * 1024 + h * 256 + pr * 128;
    r.P0 = qb * 256;
    return r;
}
__device__ __forceinline__ void p_attention(Frame& F, unsigned char* ldsg, int kind = 0) {
    using abf = attn_body::bf16;
    const abf* PROJ = (const abf*)(F.ws + WS_PROJ); abf* OB = (abf*)(F.ws + WS_OB); abf* MIX = (abf*)(F.ws + WS_MIX);
    { int t_ = threadIdx.x; asm volatile("" : "+v"(t_)); LAS float* tb = (LAS float*)(F.lds + DMASK_TBL_OFF);
      for (int x = t_; x < attn_body::DMASK_TBL_N; x += NWAVES * 64) tb[x] = attn_body::dwl(2047 - x);
      __syncthreads(); }
    const unsigned tbl = (unsigned)(uintptr_t)(ldsg + DMASK_TBL_OFF);
    constexpr int NSL = 8;
    const bool tab = (F.G == 256);
    auto unit_id = [&](int i) -> int { if (tab) return i < NSL ? (int)ATT_SCHED[F.vcu][i] : 0xFFFF; const int id = F.vcu + i * F.G; return id < 768 ? id : 0xFFFF; };
    if (kind != 1) {
        int i = 0, id = unit_id(0);
        while (id != 0xFFFF && id >= 512) id = unit_id(++i);
        if (id != 0xFFFF) {
            attn_b::Seam S; attn_b::BlockRef cur = bref(PROJ, OB, id);
            attn_b::causal_prime(cur, (char*)ldsg, S);
            for (;;) {
                int idn = unit_id(++i);
                while (idn != 0xFFFF && idn >= 512) idn = unit_id(++i);
                const bool last = (idn == 0xFFFF);
                const attn_b::BlockRef nxt = last ? cur : bref(PROJ, OB, idn);
#if defined(PRB_ABL) && PRB_ABL > 0
                if (kind == 2) attn_b::causal_block<PRB_ABL>(cur, nxt, (char*)ldsg, S); else
#endif
                attn_b::causal_block<0>(cur, nxt, (char*)ldsg, S);
                if (last) break;
                cur = nxt;
            }
        }
    }
    if (kind != 2) {
        for (int i = 0;; ++i) {
            const int id = unit_id(i);
            if (id == 0xFFFF) break;
            if (id < 512) continue;
            const int k = id - 512, qb = k & 7, h = (k >> 3) & 3, b = k >> 5;
            attn_body::attn_unit<8, 1>(b, qb, PROJ + h * 64, PROJ + 256 + h * 64, PROJ + 512 + h * 64, MIX + h * 64, 1024, (char*)ldsg, tbl);
        }
    }
}

__global__ void __launch_bounds__(NWAVES * 64, 2) hybrid_fwd(Args args) {
    extern __shared__ __attribute__((aligned(16))) unsigned char lds[];
    Frame F;
    F.lds = (LAS unsigned char*)lds;
    F.tid = threadIdx.x; F.lane = F.tid & 63; F.wave = __builtin_amdgcn_readfirstlane(F.tid >> 6);
    F.G = gridDim.x; { const int bx = blockIdx.x; F.vcu = (F.G % 8 == 0) ? (bx % 8) * (F.G / 8) + bx / 8 : bx; }
    F.out = args.out; F.ws = args.ws;
    const int lo = args.ph_lo, hi = args.ph_hi;
#if MK_N_LAUNCHES == 1
    if (hi > NPHASE) cg::this_grid().sync();
#endif
#if MK_N_LAUNCHES == 1
    for (int u = F.tid; u < 64; u += NWAVES * 64) ((LAS unsigned*)(F.lds + MISC_OFF))[u] = 0u;
    __syncthreads();
    const XcdBarrier bar = xcd_barrier_post((unsigned*)(F.ws + WS_CTL) + CW_BAR, (volatile LAS unsigned*)(F.lds + MISC_OFF) + 8);
#endif
#ifndef DBG_MASK
#define DBG_MASK 0xffffffu
#endif
#define IN(k) (((DBG_MASK >> ((k) > 6 && (k) < 13 ? (k) - 6 : (k))) & 1u) && lo <= (k) && (k) < hi)
#if MK_N_LAUNCHES == 1
#define SEAM(k) do { if (IN(k) && IN((k) + 1)) { xcd_barrier(bar); } } while (0)
#else
#define SEAM(k) do { } while (0)
#endif
    bf16* XB = (bf16*)(F.ws + WS_XB); float* SS = (float*)(F.ws + WS_SS);

#ifndef PRB_P0
#define PRB_P0 0
#endif
#ifndef PRB_IN
#define PRB_IN 0
#endif
#ifndef PRB_ATT
#define PRB_ATT 0
#endif
#ifndef PRB_ATT_KIND
#define PRB_ATT_KIND 0
#endif
#ifndef PRB_CMB
#define PRB_CMB 0
#endif
#ifndef PRB_OUT
#define PRB_OUT 0
#endif
#ifndef PRB_UP
#define PRB_UP 0
#endif
#ifndef PRB_DN
#define PRB_DN 0
#endif
#ifndef PRB_FIN
#define PRB_FIN 0
#endif
#if MK_N_LAUNCHES == 1
#define XSEAM() xcd_barrier(bar)
#else
#define XSEAM() do { } while (0)
#endif
    const bool fuse_final = (MK_N_LAUNCHES == 1) && (F.G == 256) && (PRB_FIN == 0);
    for (int r_ = 0; r_ < PRB_P0; ++r_) { p0_prologue(F); XSEAM(); }
#ifndef TSM
#define TSM 0
#endif
    long long ts_acc = 0;
#define TSA(ty) do { if ((TSM >> (ty)) & 1) ts_acc -= (long long)__builtin_amdgcn_s_memrealtime(); } while (0)
#define TSB(ty) do { if ((TSM >> (ty)) & 1) ts_acc += (long long)__builtin_amdgcn_s_memrealtime(); } while (0)
    TSA(0); if (IN(0)) { p0_prologue(F); } SEAM(0); TSB(0);

#pragma unroll 1
    for (int L = 0; L < 2; ++L) {
        const int pb = 1 + 6 * L;
        TSA(1);
        unsigned char* wl = F.ws + WS_W + (size_t)L * W_LAYER;
        for (int r_ = 0; r_ < ((L == 0) ? 1 + PRB_IN : 1); ++r_) {
        if (r_) XSEAM();
        if (IN(pb)) {
            pg8::Gemm g{XB, (const bf16*)(wl + W_IN_OFF), DMOD, 256}; pg8::StaticOrder S; S.init(M / 256, INC / 256, F.G, (int)blockIdx.x);
            pg8::EpiInProj E{(bf16*)(F.ws + WS_PROJ), SS, (const float*)(F.ws + WS_ROPE), (LAS float*)(F.lds + LRSTD_OFF), (LAS float*)(F.lds + LROPE_OFF)};
            pg8::gemm_phase<pg8::EpiInProj, pg8::StaticOrder, true, true>(F.lds + RING_OFF, g, S, E);
        }
        }
        SEAM(pb);
        TSB(1); TSA(2);
#ifdef TSW_BLK
        if (L == TSW_LAYER) ts_acc -= (long long)__builtin_amdgcn_s_memrealtime();
#endif
        for (int r_ = 0; r_ < ((L == 0) ? 1 + PRB_ATT : 1); ++r_) { if (r_) XSEAM(); if (IN(pb + 1)) { p_attention(F, lds + RING_OFF, (r_ + 1 < ((L == 0) ? 1 + PRB_ATT : 1)) ? PRB_ATT_KIND : 0); } }
#ifdef TSW_BLK
        if (L == TSW_LAYER) ts_acc += (long long)__builtin_amdgcn_s_memrealtime();
#endif
        if (IN(pb + 1) && L == 0) { __syncthreads(); p0_convert_layer(F, 0, F.vcu * NWAVES + F.wave, F.G * NWAVES, 2); }
        SEAM(pb + 1);
        TSB(2); TSA(3);
        for (int r_ = 0; r_ < ((L == 0) ? 1 + PRB_CMB : 1); ++r_) { if (r_) XSEAM(); if (IN(pb + 2)) { p_combine(F, L); } }
        SEAM(pb + 2);
        TSB(3); TSA(4);
        for (int r_ = 0, nr_ = ((L == 0) ? 1 + PRB_OUT : 1); r_ < nr_; ++r_) {
        if (r_) XSEAM();
        if (IN(pb + 3)) {
            pg8::Gemm g{(const bf16*)(F.ws + WS_MIX), (const bf16*)(wl + W_OUT_OFF), DMOD, 256}; pg8::StaticOrder S; S.init(M / 256, DMOD / 256, F.G, (int)blockIdx.x);
            pg8::EpiResid E{XB, (r_ + 1 < nr_) ? (bf16*)(F.ws + WS_PROJ) : XB, SS};
            pg8::gemm_phase<pg8::EpiResid, pg8::StaticOrder, true, true>(F.lds + RING_OFF, g, S, E);
        }
        }
        SEAM(pb + 3);
        TSB(4); TSA(5);
        for (int r_ = 0; r_ < ((L == 0) ? 1 + PRB_UP : 1); ++r_) {
        if (r_) XSEAM();
        if (IN(pb + 4)) {
            pg8::Gemm g{XB - 2 * DMOD, (const bf16*)(wl + W_UP_OFF), DMOD, 254}; pg8::StaticOrder S; S.init(NMT_UP, 2 * DFF / 256, F.G, (int)blockIdx.x);
            pg8::EpiGlu E{(bf16*)(F.ws + WS_ACT), SS, karg_in(13) + (size_t)L * 3 * DFF, (LAS float*)(F.lds + HALO_OFF), (LAS float*)(F.lds + LRSTD_OFF), (LAS float*)(F.lds + LCW_OFF)};
            pg8::gemm_phase<pg8::EpiGlu, pg8::StaticOrder, true, true>(F.lds + RING_OFF, g, S, E);
            if (L == 0 && r_ == 0) { const int nfull = NMT_UP * (2 * DFF / 256) - (NMT_UP * (2 * DFF / 256) / F.G) * F.G;
                if (nfull > 0 && nfull < F.G) { if ((int)blockIdx.x >= nfull) p0_convert_layer(F, 1, ((int)blockIdx.x - nfull) * NWAVES + F.wave, (F.G - nfull) * NWAVES); }
                else p0_convert_layer(F, 1, F.vcu * NWAVES + F.wave, F.G * NWAVES); }
        }
        }
        SEAM(pb + 4);
        TSB(5); TSA(6);
        for (int r_ = 0, nr_ = ((L == 0) ? 1 + PRB_DN : 1); r_ < nr_; ++r_) {
        if (r_) XSEAM();
        if (IN(pb + 5)) {
            pg8::Gemm g{(const bf16*)(F.ws + WS_ACT), (const bf16*)(wl + W_DOWN_OFF), DFF, 256}; pg8::StaticOrder S; S.init(M / 256, DMOD / 256, F.G, (int)blockIdx.x);
            if (L == 1 && r_ + 1 == nr_ && fuse_final) {
                pg8::EpiResidFinal E{XB, F.out, SS, karg_in(15), (unsigned*)(F.ws + WS_CTL) + CW_PANEL, (LAS unsigned*)(F.lds + MISC_OFF) + 20};
                pg8::gemm_phase<pg8::EpiResidFinal, pg8::StaticOrder, true, true>(F.lds + RING_OFF, g, S, E);
            } else {
            pg8::EpiResid E{XB, (r_ + 1 < nr_) ? (bf16*)(F.ws + WS_OB) : XB, SS};
            pg8::gemm_phase<pg8::EpiResid, pg8::StaticOrder, true, true>(F.lds + RING_OFF, g, S, E);
            }
        }
        }
        if (!(L == 1 && fuse_final)) SEAM(pb + 5);
        TSB(6);
    }
    for (int r_ = 0; r_ < PRB_FIN; ++r_) { p_final(F, (float*)(F.ws + WS_OB)); XSEAM(); }
    if (IN(13) && !fuse_final) { p_final(F, F.out); }
#ifndef TSW_BLK
#define TSW_BLK 0
#else
#define TSM_ON 1
#endif
#if TSM != 0 || defined(TSM_ON)
    if (F.vcu == TSW_BLK && F.tid == 0) { const unsigned long long t0 = __builtin_amdgcn_s_memrealtime(); const unsigned long long w = (unsigned long long)(ts_acc > 0 ? ts_acc : 0) * 4ull;
        while (__builtin_amdgcn_s_memrealtime() - t0 < w) __builtin_amdgcn_s_sleep(8); }
#endif
#undef IN
#undef SEAM
}

extern "C" void kernel_launch(void* const* d_in, const int* in_sizes, int n_in, void* d_out, int out_size, void* d_ws, size_t ws_size, hipStream_t stream) {
    static int grid = 0;
    if (grid == 0) {
        if (n_in != 16 || in_sizes[0] != M * DMOD || out_size != M * DMOD || ws_size < WS_END) { fprintf(stderr, "kernel_launch: unexpected shapes (n_in %d, in0 %d, out %d, ws %zu)\n", n_in, n_in > 0 ? in_sizes[0] : -1, out_size, ws_size); grid = -1; return; }
        int dev = 0, cus = 0, per_cu = 0;
        if (hipGetDevice(&dev) != hipSuccess || hipDeviceGetAttribute(&cus, hipDeviceAttributeMultiprocessorCount, dev) != hipSuccess) { grid = -1; return; }
        if (hipFuncSetAttribute((const void*)hybrid_fwd, hipFuncAttributeMaxDynamicSharedMemorySize, LDS_BYTES) != hipSuccess) { fprintf(stderr, "kernel_launch: hipFuncSetAttribute failed\n"); grid = -1; return; }
        if (hipOccupancyMaxActiveBlocksPerMultiprocessor(&per_cu, (const void*)hybrid_fwd, NWAVES * 64, LDS_BYTES) != hipSuccess || per_cu < 1) { fprintf(stderr, "kernel_launch: occupancy query says %d blocks per CU\n", per_cu); per_cu = 1; }
        (void)hipGetLastError();
        grid = cus;
    }
    if (grid < 0) return;
    Args a{};
    for (int i = 0; i < 16; ++i) a.in[i] = (const float*)d_in[i];
    a.out = (float*)d_out; a.ws = (unsigned char*)d_ws;
#if MK_N_LAUNCHES == 1
#ifdef PRB_MEMSET2
    (void)hipMemsetAsync((char*)d_ws + WS_CTL + 512 * 1024, 0, CTL_ZERO_BYTES, stream);
#endif
    if (hipMemsetAsync((char*)d_ws + WS_CTL, 0, CTL_ZERO_BYTES, stream) != hipSuccess) { fprintf(stderr, "kernel_launch: memset of the control words failed\n"); return; }
    a.ph_lo = 0; a.ph_hi = NPHASE;
    void* kargs[] = {&a};
    hipError_t e = hipLaunchCooperativeKernel((const void*)hybrid_fwd, dim3(grid), dim3(NWAVES * 64), kargs, LDS_BYTES, stream);
    if (e != hipSuccess) fprintf(stderr, "kernel_launch: cooperative launch failed: %s (grid %d)\n", hipGetErrorString(e), grid);
#else
    for (int p = 0; p < NPHASE; ++p) {
        a.ph_lo = p; a.ph_hi = p + 1;
        hipLaunchKernelGGL(hybrid_fwd, dim3(grid), dim3(NWAVES * 64), LDS_BYTES, stream, a);
    }
#endif
}
```

```cpp
#include <hip/hip_runtime.h>
#include <hip/hip_cooperative_groups.h>
#include <hip/hip_bf16.h>
#include <cstdio>
#include <cstdint>
#include <cmath>
namespace pg8 {
#define PG8_LAS __attribute__((address_space(3)))
typedef unsigned short bf16_t;
typedef short bf16x8 __attribute__((ext_vector_type(8)));
typedef float f32x4 __attribute__((ext_vector_type(4)));
typedef unsigned u32x4 __attribute__((ext_vector_type(4)));
constexpr int BM = 256, BK = 64, HALF = 128, HTB = HALF * BK * 2  , STAGE_BYTES = 8 * HTB, NXCD = 8, WGM = 8;

__host__ __device__ __forceinline__ int lds_byte(int r, int c) { const int st = (r >> 4) * 2 + (c >> 5), rr = r & 15, cc = c & 31, ob = rr * 64 + cc * 2; return st * 1024 + (ob ^ (((ob >> 9) & 1) << 5)); }
__host__ __device__ __forceinline__ void stage_rc(int b, int& R, int& C) { const int st = b / 1024, sb = b % 1024, swz = sb ^ (((sb >> 9) & 1) << 5); R = (st >> 1) * 16 + swz / 64; C = (st & 1) * 32 + (swz % 64) / 2; }
__host__ __device__ __forceinline__ int perm32(int rho) { const int n = rho >> 4, i = rho & 15; return 8 * (i >> 2) + 4 * n + (i & 3); }

struct Unit { int pm, pn; };
struct Gemm { const bf16_t* A; const bf16_t* Bt; int K; int a_rows; };

struct StaticOrder {
    int nM, nN, nwg, G, c;
    __host__ __device__ void init(int nM_, int nN_, int G_, int c_) { nM = nM_; nN = nN_; nwg = nM * nN; G = G_; c = c_; }
    __host__ __device__ bool next(int i, Unit& u) const {
        const long L = (long)i * G + c; if (L >= nwg) return false;
        int wgid = (int)L; { const int q = nwg / NXCD, r = nwg % NXCD, xcd = wgid % NXCD, off = wgid / NXCD; wgid = (xcd < r ? xcd * (q + 1) : r * (q + 1) + (xcd - r) * q) + off; }
        const int nig = WGM * nN, gid = wgid / nig, fm = gid * WGM, gsz = (nM - fm) < WGM ? (nM - fm) : WGM;
        u.pm = fm + ((wgid % nig) % gsz); u.pn = (wgid % nig) / gsz; return true;
    }
    __device__ __forceinline__ void a_ready(const Unit&) const {}
    __device__ __forceinline__ void done(const Unit&) const {}
};


__device__ __forceinline__ unsigned cvt_pk_bf16(float lo, float hi) { unsigned r; asm volatile("v_cvt_pk_bf16_f32 %0, %1, %2" : "=v"(r) : "v"(lo), "v"(hi)); return r; }
constexpr int MROWS = 16384, DMODEL = 1024;
constexpr float QK_C2 = 0.125f * 1.4426950408889634f;

__device__ __forceinline__ f32x4 rstd_load(const float* SS, int row, int fq) { return *(const f32x4*)(SS + (size_t)row * 16 + 4 * fq); }
__device__ __forceinline__ float rstd_finish(f32x4 a) {
    float s = (a[0] + a[1]) + (a[2] + a[3]);
    s += __shfl_xor(s, 16); s += __shfl_xor(s, 32);
    return __builtin_amdgcn_rsqf(s * (1.0f / 1024.0f) + 1e-6f);
}

struct NoPrep { };
struct EpiInProj {
    static constexpr bool PERM = true, AFTER_DRAIN = false, HAS_INIT = false, HAS_PREP = true;
    bf16_t* O; const float* SS; const float* rope;
    PG8_LAS float* lrstd; PG8_LAS float* lrope;
    struct Prep { f32x4 s0, s1, r0, r1; };
    static __device__ __forceinline__ bool tile_rope(int pn) { return (pn <= 1) || (pn >= 3 && pn <= 6); }
    __device__ __forceinline__ void prep_load(Prep& P, const Unit& u, int tid) const {
        asm volatile("" : "+v"(tid));
        const int row = u.pm * BM + (tid >> 1), h = tid & 1;
        const f32x4* sp = (const f32x4*)(SS + (size_t)row * 16 + 8 * h); P.s0 = sp[0]; P.s1 = sp[1];
        const f32x4* rp = (const f32x4*)(rope + (size_t)row * 16 + 8 * h); P.r0 = rp[0]; P.r1 = rp[1];
    }
    __device__ __forceinline__ void prep_store(const Prep& P, const Unit& u, int tid) const {
        asm volatile("" : "+v"(tid));
        float s = ((P.s0[0] + P.s0[1]) + (P.s0[2] + P.s0[3])) + ((P.s1[0] + P.s1[1]) + (P.s1[2] + P.s1[3]));
        s += __shfl_xor(s, 1);
        if ((tid & 1) == 0) lrstd[tid >> 1] = __builtin_amdgcn_rsqf(s * (1.0f / 1024.0f) + 1e-6f);
        PG8_LAS f32x4* d = (PG8_LAS f32x4*)(lrope + (tid >> 1) * 16 + 8 * (tid & 1)); d[0] = P.r0; d[1] = P.r1;
    }
    __device__ __forceinline__ void operator()(f32x4 (&acc)[2][2][4][2], const Unit& u, const Unit& nxt, bool has_next, int wr, int wc, int fr, int fq, int tid) const {
        Prep P;
        asm volatile("" : "+v"(fr), "+v"(fq));
        const int pn = u.pn;
        const bool is_q = (pn == 0) || (pn == 3) || (pn == 4);
        const float qs = is_q ? QK_C2 : 1.0f;
        const bool wrot = tile_rope(pn) && ((wc & 1) == 0);
        const bool lrot = wrot && fq < 2;
        const float sgn = (fq == 0) ? -1.0f : 1.0f;
        const int rl0 = wr * 64 + fr, row0 = u.pm * BM + rl0, col0 = pn * BM + wc * 32 + 8 * fq;
#pragma unroll
        for (int ai = 0; ai < 2; ++ai) {
            if (ai == 1 && has_next) prep_load(P, nxt, tid);
#pragma unroll
            for (int m = 0; m < 4; ++m) {
                const int rl = rl0 + ai * HALF + m * 16;
                const float rs = lrstd[rl] * qs;
                const PG8_LAS f32x4* rp = (const PG8_LAS f32x4*)(lrope + rl * 16);
                const f32x4 one = {1.f, 1.f, 1.f, 1.f}, zero = {0.f, 0.f, 0.f, 0.f};
                const f32x4 cs0 = lrot ? rp[0] : one, cs1 = lrot ? rp[1] : one, sn0 = lrot ? rp[2] * sgn : zero, sn1 = lrot ? rp[3] * sgn : zero;
#pragma unroll
                for (int bj = 0; bj < 2; ++bj) {
                    f32x4 v0 = acc[ai][bj][m][0] * rs, v1 = acc[ai][bj][m][1] * rs;
                    if (wrot) {
                        f32x4 p0, p1;
#pragma unroll
                        for (int j = 0; j < 4; ++j) { p0[j] = __shfl_xor(v0[j], 16); p1[j] = __shfl_xor(v1[j], 16); }
                        v0 = v0 * cs0 + p0 * sn0; v1 = v1 * cs1 + p1 * sn1;
                    }
                    u32x4 w; w.x = cvt_pk_bf16(v0[0], v0[1]); w.y = cvt_pk_bf16(v0[2], v0[3]); w.z = cvt_pk_bf16(v1[0], v1[1]); w.w = cvt_pk_bf16(v1[2], v1[3]);
                    *(u32x4*)(O + (size_t)(row0 + ai * HALF + m * 16) * 3072 + col0 + bj * HALF) = w;
                }
                if (m & 1) asm volatile("" ::: "memory");
            }
        }
        asm volatile("s_waitcnt lgkmcnt(0)" ::: "memory"); __builtin_amdgcn_s_barrier(); asm volatile("" ::: "memory");
        if (has_next) prep_store(P, nxt, tid);
    }
};

__device__ __forceinline__ void resid_init_load(u32x4 (&raw)[16], const bf16_t* xin, const Unit& u, int wr, int wc, int fr, int fq) {
    const int row0 = u.pm * BM + wr * 64 + fr, col0 = u.pn * BM + wc * 32 + 8 * fq;
#pragma unroll
    for (int ai = 0; ai < 2; ++ai)
#pragma unroll
        for (int m = 0; m < 4; ++m)
#pragma unroll
            for (int bj = 0; bj < 2; ++bj) raw[(ai * 4 + m) * 2 + bj] = *(const u32x4*)(xin + (size_t)(row0 + ai * HALF + m * 16) * DMODEL + col0 + bj * HALF);
}
__device__ __forceinline__ void resid_init_acc(f32x4 (&acc)[2][2][4][2], const u32x4 (&raw)[16]) {
#pragma unroll
    for (int ai = 0; ai < 2; ++ai)
#pragma unroll
        for (int m = 0; m < 4; ++m)
#pragma unroll
            for (int bj = 0; bj < 2; ++bj) { const u32x4 x = raw[(ai * 4 + m) * 2 + bj];
                acc[ai][bj][m][0] = (f32x4){__builtin_bit_cast(float, x.x << 16), __builtin_bit_cast(float, x.x & 0xffff0000u), __builtin_bit_cast(float, x.y << 16), __builtin_bit_cast(float, x.y & 0xffff0000u)};
                acc[ai][bj][m][1] = (f32x4){__builtin_bit_cast(float, x.z << 16), __builtin_bit_cast(float, x.z & 0xffff0000u), __builtin_bit_cast(float, x.w << 16), __builtin_bit_cast(float, x.w & 0xffff0000u)}; }
}

struct EpiResid {
    static constexpr bool PERM = true, AFTER_DRAIN = false, HAS_INIT = true, HAS_PREP = false;
    typedef NoPrep Prep;
    const bf16_t* xin; bf16_t* xo; float* SS;
    __device__ __forceinline__ void init_load(u32x4 (&raw)[16], const Unit& u, int wr, int wc, int fr, int fq) const { resid_init_load(raw, xin, u, wr, wc, fr, fq); }
    __device__ __forceinline__ void init_acc(f32x4 (&acc)[2][2][4][2], const u32x4 (&raw)[16]) const { resid_init_acc(acc, raw); }
    __device__ __forceinline__ void operator()(f32x4 (&acc)[2][2][4][2], const Unit& u, const Unit& nxt, bool has_next, int wr, int wc, int fr, int fq, int tid) const {
        const int row0 = u.pm * BM + wr * 64 + fr, col0 = u.pn * BM + wc * 32 + 8 * fq;
#pragma unroll
        for (int ai = 0; ai < 2; ++ai)
#pragma unroll
            for (int m = 0; m < 4; ++m) {
                const int row = row0 + ai * HALF + m * 16; float ssq = 0.f;
#pragma unroll
                for (int bj = 0; bj < 2; ++bj) {
                    const size_t off = (size_t)row * DMODEL + col0 + bj * HALF;
                    const f32x4 h0 = acc[ai][bj][m][0], h1 = acc[ai][bj][m][1];
                    u32x4 w; w.x = cvt_pk_bf16(h0[0], h0[1]); w.y = cvt_pk_bf16(h0[2], h0[3]); w.z = cvt_pk_bf16(h1[0], h1[1]); w.w = cvt_pk_bf16(h1[2], h1[3]);
                    *(u32x4*)(xo + off) = w;
                    ssq += ((h0[0] * h0[0] + h0[1] * h0[1]) + (h0[2] * h0[2] + h0[3] * h0[3])) + ((h1[0] * h1[0] + h1[1] * h1[1]) + (h1[2] * h1[2] + h1[3] * h1[3]));
                }
                ssq += __shfl_xor(ssq, 16); ssq += __shfl_xor(ssq, 32);
                if (fq == 0) SS[(size_t)row * 16 + u.pn * 4 + wc] = ssq;
            }
    }
};

struct EpiResidFinal {
    static constexpr bool PERM = true, AFTER_DRAIN = false, HAS_INIT = true, HAS_PREP = false;
    typedef NoPrep Prep;
    const bf16_t* xin; float* out; float* SS; const float* g; unsigned* cnt; PG8_LAS unsigned* flag;
    __device__ __forceinline__ void init_load(u32x4 (&raw)[16], const Unit& u, int wr, int wc, int fr, int fq) const { resid_init_load(raw, xin, u, wr, wc, fr, fq); }
    __device__ __forceinline__ void init_acc(f32x4 (&acc)[2][2][4][2], const u32x4 (&raw)[16]) const { resid_init_acc(acc, raw); }
    __device__ __forceinline__ void operator()(f32x4 (&acc)[2][2][4][2], const Unit& u, const Unit& nxt, bool has_next, int wr, int wc, int fr, int fq, int tid) const {
        const int row0 = u.pm * BM + wr * 64 + fr, col0 = u.pn * BM + wc * 32 + 8 * fq;
#pragma unroll
        for (int ai = 0; ai < 2; ++ai) {
#pragma unroll
            for (int m = 0; m < 4; ++m) {
                const int row = row0 + ai * HALF + m * 16; float ssq = 0.f;
#pragma unroll
                for (int bj = 0; bj < 2; ++bj) {
                    const f32x4 h0 = acc[ai][bj][m][0], h1 = acc[ai][bj][m][1];
                    ssq += ((h0[0] * h0[0] + h0[1] * h0[1]) + (h0[2] * h0[2] + h0[3] * h0[3])) + ((h1[0] * h1[0] + h1[1] * h1[1]) + (h1[2] * h1[2] + h1[3] * h1[3]));
                }
                ssq += __shfl_xor(ssq, 16); ssq += __shfl_xor(ssq, 32);
                if (fq == 0) __hip_atomic_store(SS + (size_t)row * 16 + u.pn * 4 + wc, ssq, __ATOMIC_RELAXED, __HIP_MEMORY_SCOPE_AGENT);
            }
        }
        asm volatile("s_waitcnt vmcnt(0)" ::: "memory");
        __builtin_amdgcn_s_barrier(); asm volatile("" ::: "memory");
        if (wr == 0 && wc == 0 && fr == 0 && fq == 0) {
            __hip_atomic_fetch_add(cnt + 64 * u.pm, 1u, __ATOMIC_RELAXED, __HIP_MEMORY_SCOPE_AGENT);
            unsigned spins = 0;
            while (__hip_atomic_load(cnt + 64 * u.pm, __ATOMIC_RELAXED, __HIP_MEMORY_SCOPE_AGENT) < 4u) { __builtin_amdgcn_s_sleep(2); if (++spins > (1u << 22)) break; }
            __builtin_amdgcn_fence(__ATOMIC_ACQUIRE, "agent");
            asm volatile("s_waitcnt vmcnt(0)" ::: "memory");
            flag[0] = 1u;
        }
        asm volatile("s_waitcnt lgkmcnt(0)" ::: "memory"); __builtin_amdgcn_s_barrier(); asm volatile("" ::: "memory");
        f32x4 part[2][4];
#pragma unroll
        for (int ai = 0; ai < 2; ++ai)
#pragma unroll
            for (int m = 0; m < 4; ++m) { float* sp = SS + (size_t)(row0 + ai * HALF + m * 16) * 16 + 4 * fq;
#pragma unroll
                for (int j = 0; j < 4; ++j) part[ai][m][j] = __hip_atomic_load(sp + j, __ATOMIC_RELAXED, __HIP_MEMORY_SCOPE_AGENT); }
        f32x4 gv[2][2];
#pragma unroll
        for (int bj = 0; bj < 2; ++bj) { gv[bj][0] = *(const f32x4*)(g + col0 + bj * HALF); gv[bj][1] = *(const f32x4*)(g + col0 + bj * HALF + 4); }
#pragma unroll
        for (int ai = 0; ai < 2; ++ai)
#pragma unroll
            for (int m = 0; m < 4; ++m) {
                const float rs = rstd_finish(part[ai][m]);
                float* rowp = out + (size_t)(row0 + ai * HALF + m * 16) * DMODEL + col0;
#pragma unroll
                for (int bj = 0; bj < 2; ++bj) { __builtin_nontemporal_store(acc[ai][bj][m][0] * rs * gv[bj][0], (f32x4*)(rowp + bj * HALF)); __builtin_nontemporal_store(acc[ai][bj][m][1] * rs * gv[bj][1], (f32x4*)(rowp + bj * HALF + 4)); }
            }
    }
};

template <int N> __device__ __forceinline__ float dpp_ror(float v) { return __builtin_bit_cast(float, __builtin_amdgcn_update_dpp(0, __builtin_bit_cast(int, v), 0x120 + N, 0xf, 0xf, false)); }

struct EpiGlu {
    static constexpr bool PERM = true, AFTER_DRAIN = false, HAS_INIT = false, HAS_PREP = true;
    bf16_t* ACT; const float* SS; const float* cw;
    PG8_LAS float* halo;
    PG8_LAS float* lrstd;
    PG8_LAS float* lcw;
    struct Prep { f32x4 s0, s1, w; };
    __device__ __forceinline__ void prep_load(Prep& P, const Unit& u, int tid) const {
        asm volatile("" : "+v"(tid));
        int row = u.pm * 254 - 2 + (tid >> 1); row = row < 0 ? 0 : (row >= MROWS ? MROWS - 1 : row);
        const f32x4* sp = (const f32x4*)(SS + (size_t)row * 16 + 8 * (tid & 1)); P.s0 = sp[0]; P.s1 = sp[1];
        if (tid < 96) P.w = *(const f32x4*)(cw + (tid >> 5) * 2816 + u.pn * 128 + 4 * (tid & 31));
    }
    __device__ __forceinline__ void prep_store(const Prep& P, const Unit& u, int tid) const {
        asm volatile("" : "+v"(tid));
        float s = ((P.s0[0] + P.s0[1]) + (P.s0[2] + P.s0[3])) + ((P.s1[0] + P.s1[1]) + (P.s1[2] + P.s1[3]));
        s += __shfl_xor(s, 1);
        if ((tid & 1) == 0) lrstd[tid >> 1] = __builtin_amdgcn_rsqf(s * (1.0f / 1024.0f) + 1e-6f);
        if (tid < 96) *(PG8_LAS f32x4*)(lcw + 4 * tid) = P.w;
    }
    __device__ __forceinline__ void operator()(f32x4 (&acc)[2][2][4][2], const Unit& u, const Unit& nxt, bool has_next, int wr, int wc, int fr, int fq, int tid) const {
        const int lane = fr + 16 * fq;
        const int grow0 = u.pm * 254 - 2;
        const int cl = wc * 32 + 8 * fq;
        const int hcol = u.pn * 128 + cl;
#pragma unroll
        for (int ai = 0; ai < 2; ++ai)
#pragma unroll
            for (int m = 0; m < 4; ++m) {
                const float rs = lrstd[ai * HALF + wr * 64 + m * 16 + fr];
#pragma unroll
                for (int bj = 0; bj < 2; ++bj) { acc[ai][bj][m][0] = acc[ai][bj][m][0] * rs; acc[ai][bj][m][1] = acc[ai][bj][m][1] * rs; }
            }
        const f32x4 w0a = *(const PG8_LAS f32x4*)(lcw + cl), w0b = *(const PG8_LAS f32x4*)(lcw + cl + 4);
        const f32x4 w1a = *(const PG8_LAS f32x4*)(lcw + 128 + cl), w1b = *(const PG8_LAS f32x4*)(lcw + 128 + cl + 4);
        const f32x4 w2a = *(const PG8_LAS f32x4*)(lcw + 256 + cl), w2b = *(const PG8_LAS f32x4*)(lcw + 256 + cl + 4);
        if (fr >= 14) {
#pragma unroll
            for (int ai = 0; ai < 2; ++ai) { PG8_LAS float* hp = halo + ((2 * ai + wr) * 2 + (fr - 14)) * 128 + cl;
                *(PG8_LAS f32x4*)hp = acc[ai][0][3][0]; *(PG8_LAS f32x4*)(hp + 4) = acc[ai][0][3][1]; }
        }
        asm volatile("s_waitcnt lgkmcnt(0)" ::: "memory"); __builtin_amdgcn_s_barrier(); asm volatile("" ::: "memory");
        Prep P;
#pragma unroll
        for (int ai = 0; ai < 2; ++ai) {
            if (ai == 1 && has_next) prep_load(P, nxt, tid);
            const int q = 2 * ai + wr;
            f32x4 pv0 = {0.f, 0.f, 0.f, 0.f}, pv1 = pv0;
            if (fr >= 14 && q > 0) { const PG8_LAS float* hp = halo + ((q - 1) * 2 + (fr - 14)) * 128 + cl; pv0 = *(const PG8_LAS f32x4*)hp; pv1 = *(const PG8_LAS f32x4*)(hp + 4); }
#pragma unroll
            for (int m = 0; m < 4; ++m) {
                const int rl = ai * HALF + wr * 64 + m * 16 + fr, grow = grow0 + rl;
                const int tpos = grow & 2047;
                const f32x4 gp0 = (m == 0) ? pv0 : acc[ai][0][m - 1][0], gp1 = (m == 0) ? pv1 : acc[ai][0][m - 1][1];
                f32x4 r0, r1;
#pragma unroll
                for (int j = 0; j < 4; ++j) {
                    { const float cur = acc[ai][0][m][0][j];
                      float p1 = dpp_ror<1>((fr == 15) ? gp0[j] : cur), p2 = dpp_ror<2>((fr >= 14) ? gp0[j] : cur);
                      if (tpos < 1) p1 = 0.f; if (tpos < 2) p2 = 0.f;
                      const float cv = w0a[j] * p2 + w1a[j] * p1 + w2a[j] * cur;
                      r0[j] = cv * __builtin_amdgcn_rcpf(1.0f + __builtin_amdgcn_exp2f(-1.4426950408889634f * cv)) * acc[ai][1][m][0][j]; }
                    { const float cur = acc[ai][0][m][1][j];
                      float p1 = dpp_ror<1>((fr == 15) ? gp1[j] : cur), p2 = dpp_ror<2>((fr >= 14) ? gp1[j] : cur);
                      if (tpos < 1) p1 = 0.f; if (tpos < 2) p2 = 0.f;
                      const float cv = w0b[j] * p2 + w1b[j] * p1 + w2b[j] * cur;
                      r1[j] = cv * __builtin_amdgcn_rcpf(1.0f + __builtin_amdgcn_exp2f(-1.4426950408889634f * cv)) * acc[ai][1][m][1][j]; }
                }
                if (rl >= 2 && grow < MROWS) {
                    u32x4 w; w.x = cvt_pk_bf16(r0[0], r0[1]); w.y = cvt_pk_bf16(r0[2], r0[3]); w.z = cvt_pk_bf16(r1[0], r1[1]); w.w = cvt_pk_bf16(r1[2], r1[3]);
                    *(u32x4*)(ACT + (size_t)grow * 2816 + hcol) = w;
                }
            }
        }
        if (has_next) prep_store(P, nxt, tid);
    }
};
template <class Epi, class Sched, bool ALIGN_EPI = false, bool SP2 = false>
__device__ __forceinline__ void gemm_phase(PG8_LAS unsigned char* lds, const Gemm g, const Sched& S, const Epi& E) {
    int tid_ = threadIdx.x; asm volatile("" : "+v"(tid_));
    const int tid = tid_, wid = __builtin_amdgcn_readfirstlane(tid >> 6), lane = tid & 63, wr = wid >> 2, wc = wid & 3, fr = lane & 15, fq = lane >> 4;
    const int K = g.K, nt = K / BK;
    unsigned voffA[2], voffB[2];
#pragma unroll
    for (int i = 0; i < 2; ++i) { int R, C; stage_rc(tid * 16 + i * 8192, R, C); const int Rb = Epi::PERM ? ((R & ~31) + perm32(R & 31)) : R;
        voffA[i] = (unsigned)(R * K + C) * 2u; voffB[i] = (unsigned)(Rb * K + C) * 2u; }
    const size_t kstep = (size_t)(BK * 2);
    const size_t hstep = (size_t)HALF * K * 2;
    const size_t tstep = 2 * hstep;
    const size_t tstepA = (size_t)g.a_rows * K * 2;
    const unsigned ldsw = (unsigned)wid * 1024u;
    const int aoff = lds_byte(wr * 64 + fr, fq * 8), boff = lds_byte(wc * 32 + fr, fq * 8);
#define PG8_SA(b, h) (((b) * 2 + (h)) * HTB)
#define PG8_SB(b, h) ((4 + (b) * 2 + (h)) * HTB)
#define PG8_STAGE(bufoff, gbase, voff) do { _Pragma("unroll") for (int _i = 0; _i < 2; ++_i) \
        __builtin_amdgcn_global_load_lds((const unsigned*)((const char*)(gbase) + (voff)[_i]), (PG8_LAS unsigned*)(lds + (bufoff) + ldsw + _i * 8192), 16, 0, 0); } while (0)
#define PG8_LDA(dst, b, h) do { _Pragma("unroll") for (int m = 0; m < 4; ++m) _Pragma("unroll") for (int k = 0; k < 2; ++k) dst[m][k] = *(const PG8_LAS bf16x8*)(lds + PG8_SA(b, h) + aoff + m * 2048 + k * 1024); } while (0)
#define PG8_LDB(dst, b, h) do { _Pragma("unroll") for (int n = 0; n < 2; ++n) _Pragma("unroll") for (int k = 0; k < 2; ++k) dst[n][k] = *(const PG8_LAS bf16x8*)(lds + PG8_SB(b, h) + boff + n * 2048 + k * 1024); } while (0)
#define PG8_MMA(ai, bj, At, Bt) do { __builtin_amdgcn_s_setprio(1); _Pragma("unroll") for (int m = 0; m < 4; ++m) _Pragma("unroll") for (int n = 0; n < 2; ++n) _Pragma("unroll") for (int k = 0; k < 2; ++k) \
        acc[ai][bj][m][n] = __builtin_amdgcn_mfma_f32_16x16x32_bf16(Bt[n][k], At[m][k], acc[ai][bj][m][n], 0, 0, 0); __builtin_amdgcn_s_setprio(0); } while (0)
#define PG8_WAIT_V(n) asm volatile("s_waitcnt vmcnt(" #n ")" ::: "memory")
#define PG8_WAIT_L(n) asm volatile("s_waitcnt lgkmcnt(" #n ")" ::: "memory")
#define PG8_BAR __builtin_amdgcn_s_barrier()
#define PG8_SCHED __builtin_amdgcn_sched_barrier(0)
    Unit cur, nxt; int ui = 0;
    if (!S.next(0, cur)) return;
    f32x4 acc[2][2][4][2];
    u32x4 iraw[Epi::HAS_INIT ? 16 : 1];
    if constexpr (Epi::HAS_INIT) E.init_load(iraw, cur, wr, wc, fr, fq);
    typename Epi::Prep prep;
    if constexpr (Epi::HAS_PREP) E.prep_load(prep, cur, tid);
    bf16x8 At[4][2], B0[2][2], B1[2][2];
    const char* cA = (const char*)g.A + (size_t)cur.pm * tstepA; const char* cB = (const char*)g.Bt + (size_t)cur.pn * tstep;
    S.a_ready(cur);
    if constexpr (SP2) {
        PG8_STAGE(PG8_SB(0, 0), cB, voffB); PG8_STAGE(PG8_SB(0, 1), cB + hstep, voffB); PG8_STAGE(PG8_SA(0, 0), cA, voffA); PG8_STAGE(PG8_SA(0, 1), cA + hstep, voffA);
        if (wr == 1) PG8_BAR;
        PG8_WAIT_V(2); PG8_BAR;
        PG8_STAGE(PG8_SB(1, 0), cB + kstep, voffB); PG8_STAGE(PG8_SA(1, 0), cA + kstep, voffA); PG8_STAGE(PG8_SB(1, 1), cB + hstep + kstep, voffB);
        PG8_WAIT_V(6); PG8_BAR;
    } else {
        PG8_STAGE(PG8_SB(0, 0), cB, voffB); PG8_STAGE(PG8_SA(0, 0), cA, voffA); PG8_STAGE(PG8_SB(0, 1), cB + hstep, voffB); PG8_STAGE(PG8_SA(0, 1), cA + hstep, voffA);
        if (wr == 1) PG8_BAR;
        PG8_WAIT_V(4); PG8_BAR;
        PG8_STAGE(PG8_SB(1, 0), cB + kstep, voffB); PG8_STAGE(PG8_SA(1, 0), cA + kstep, voffA); PG8_STAGE(PG8_SB(1, 1), cB + hstep + kstep, voffB);
        PG8_WAIT_V(6); PG8_BAR;
    }
    if constexpr (Epi::HAS_PREP) E.prep_store(prep, cur, tid);
    if constexpr (Epi::HAS_INIT) { E.init_acc(acc, iraw); }
    else {
#pragma unroll
        for (int a = 0; a < 2; ++a)
#pragma unroll
            for (int b = 0; b < 2; ++b)
#pragma unroll
                for (int m = 0; m < 4; ++m)
#pragma unroll
                    for (int n = 0; n < 2; ++n) acc[a][b][m][n] = (f32x4){0.f, 0.f, 0.f, 0.f};
    }
    for (;;) {
        const bool has_next = S.next(ui + 1, nxt);
        const char* nA = has_next ? (const char*)g.A + (size_t)nxt.pm * tstepA : cA; const char* nB = has_next ? (const char*)g.Bt + (size_t)nxt.pn * tstep : cB;
        for (int t = 0; t < nt; t += 2) {
            const bool last = (t == nt - 2);
            const char* a1 = cA + (size_t)(t + 1) * kstep;
            const char* a2 = last ? nA : cA + (size_t)(t + 2) * kstep; const char* b2 = last ? nB : cB + (size_t)(t + 2) * kstep;
            const char* a3 = a2 + kstep; const char* b3 = b2 + kstep;
            if (last && has_next) S.a_ready(nxt);
            if constexpr (SP2) {
            PG8_LDB(B0, 0, 0); PG8_LDB(B1, 0, 1); PG8_SCHED; PG8_LDA(At, 0, 0); PG8_STAGE(PG8_SA(1, 1), a1 + hstep, voffA);
            PG8_WAIT_V(8); PG8_WAIT_L(0); PG8_BAR; PG8_MMA(0, 0, At, B0); PG8_MMA(0, 1, At, B1); PG8_BAR; PG8_SCHED;
            PG8_LDA(At, 0, 1); PG8_STAGE(PG8_SB(0, 0), b2, voffB); PG8_STAGE(PG8_SB(0, 1), b2 + hstep, voffB); PG8_STAGE(PG8_SA(0, 0), a2, voffA);
            PG8_WAIT_V(8); PG8_WAIT_L(0); PG8_BAR; PG8_MMA(1, 0, At, B0); PG8_MMA(1, 1, At, B1); PG8_BAR; PG8_SCHED;
            PG8_LDB(B0, 1, 0); PG8_LDB(B1, 1, 1); PG8_SCHED; PG8_LDA(At, 1, 0); PG8_STAGE(PG8_SA(0, 1), a2 + hstep, voffA);
            PG8_WAIT_V(8); PG8_WAIT_L(0); PG8_BAR; PG8_MMA(0, 0, At, B0); PG8_MMA(0, 1, At, B1); PG8_BAR; PG8_SCHED;
            PG8_LDA(At, 1, 1); PG8_STAGE(PG8_SB(1, 0), b3, voffB); PG8_STAGE(PG8_SB(1, 1), b3 + hstep, voffB); PG8_STAGE(PG8_SA(1, 0), a3, voffA);
            PG8_WAIT_V(8); PG8_WAIT_L(0); PG8_BAR; PG8_MMA(1, 0, At, B0); PG8_MMA(1, 1, At, B1); PG8_BAR; PG8_SCHED;
            } else {
            PG8_LDB(B0, 0, 0); PG8_SCHED; PG8_LDA(At, 0, 0); PG8_STAGE(PG8_SA(1, 1), a1 + hstep, voffA);
            PG8_WAIT_L(8); PG8_BAR; PG8_WAIT_L(0); PG8_MMA(0, 0, At, B0); PG8_BAR; PG8_SCHED;
            PG8_LDB(B1, 0, 1); PG8_STAGE(PG8_SB(0, 0), b2, voffB);
            PG8_BAR; PG8_WAIT_L(0); PG8_MMA(0, 1, At, B1); PG8_BAR;
            PG8_LDA(At, 0, 1); PG8_STAGE(PG8_SA(0, 0), a2, voffA);
            PG8_BAR; PG8_WAIT_L(0); PG8_MMA(1, 0, At, B0); PG8_BAR; PG8_SCHED;
            PG8_STAGE(PG8_SB(0, 1), b2 + hstep, voffB);
            PG8_WAIT_V(6); PG8_BAR; PG8_MMA(1, 1, At, B1); PG8_BAR;
            PG8_LDB(B0, 1, 0); PG8_SCHED; PG8_LDA(At, 1, 0); PG8_STAGE(PG8_SA(0, 1), a2 + hstep, voffA);
            PG8_WAIT_L(8); PG8_BAR; PG8_WAIT_L(0); PG8_MMA(0, 0, At, B0); PG8_BAR; PG8_SCHED;
            PG8_LDB(B1, 1, 1); PG8_STAGE(PG8_SB(1, 0), b3, voffB);
            PG8_BAR; PG8_WAIT_L(0); PG8_MMA(0, 1, At, B1); PG8_BAR;
            PG8_LDA(At, 1, 1); PG8_STAGE(PG8_SA(1, 0), a3, voffA);
            PG8_BAR; PG8_WAIT_L(0); PG8_MMA(1, 0, At, B0); PG8_BAR; PG8_SCHED;
            PG8_STAGE(PG8_SB(1, 1), b3 + hstep, voffB);
            PG8_WAIT_V(6); PG8_BAR; PG8_MMA(1, 1, At, B1); PG8_BAR;
            }
        }
        if constexpr (ALIGN_EPI) { if (wr == 0) PG8_BAR; }
        if constexpr (!Epi::AFTER_DRAIN) { E(acc, cur, nxt, has_next, wr, wc, fr, fq, tid); S.done(cur); }
        if (!has_next) break;
        if constexpr (Epi::HAS_INIT) { E.init_load(iraw, nxt, wr, wc, fr, fq); E.init_acc(acc, iraw); }
        else {
#pragma unroll
        for (int a = 0; a < 2; ++a)
#pragma unroll
            for (int b = 0; b < 2; ++b)
#pragma unroll
                for (int m = 0; m < 4; ++m)
#pragma unroll
                    for (int n = 0; n < 2; ++n) acc[a][b][m][n] = (f32x4){0.f, 0.f, 0.f, 0.f};
        }
        cur = nxt; cA = nA; cB = nB; ++ui;
        if constexpr (ALIGN_EPI) { if (wr == 1) PG8_BAR; }
    }
    PG8_WAIT_V(0);
    if constexpr (!ALIGN_EPI) { if (wr == 0) PG8_BAR; }
    PG8_BAR;
    if constexpr (Epi::AFTER_DRAIN) { E.fused(acc, cur, wr, wc, fr, fq, lds, wid, lane); S.done(cur); }
#undef PG8_SA
#undef PG8_SB
#undef PG8_STAGE
#undef PG8_LDA
#undef PG8_LDB
#undef PG8_MMA
#undef PG8_WAIT_V
#undef PG8_WAIT_L
#undef PG8_BAR
#undef PG8_SCHED
}
}
namespace attn_body {
using bf16=__hip_bfloat16;
using bf16x8=__attribute__((ext_vector_type(8)))short;
using s16x4=__attribute__((ext_vector_type(4)))short;
using f32x16=__attribute__((ext_vector_type(16)))float;
using u32x4=__attribute__((ext_vector_type(4)))unsigned;
constexpr int BATCH=8,SEQ=2048,D=64,DM=3072;
constexpr int NW=8,QBLK=32,QB=QBLK*NW,KVBLK=64,NQB=SEQ/QB;
constexpr int ATTN_UNIT_ROWS=QB;
__device__ __forceinline__ int crow(int r,int hi){return (r&3)+8*(r>>2)+4*hi;}
#define SBAR() __builtin_amdgcn_sched_barrier(0)
__device__ __forceinline__ void cmask(f32x16&p0,f32x16&p1,int jb,int qrel,int hi){
  const float NEG=-INFINITY; int kb=64*jb+4*hi;
  #pragma unroll
  for(int r=0;r<16;++r){int kv=kb+(r&3)+8*(r>>2); if(kv>qrel)p0[r]=NEG; if(kv+32>qrel)p1[r]=NEG;}
}

__device__ __forceinline__ float dwl(int d){
  const int w=(int)(d<=128)+(int)(((d&3)==0)&&(d<=512))+(int)((d&15)==0);
  const float a=(w==0)?-INFINITY:(w==1)?0.f:(w==2)?1.f:1.5849625007f;
  return d<0?-INFINITY:a;
}
typedef __attribute__((address_space(3))) const float* ldsf_cptr;
typedef float f32x2m __attribute__((ext_vector_type(2)));
constexpr int DMASK_TBL_N=2368;
#define DMASK_BATCH(o_) asm volatile("ds_read2_b32 %0, %8 offset0:" #o_ "+0 offset1:" #o_ "+1\n\tds_read2_b32 %1, %8 offset0:" #o_ "+2 offset1:" #o_ "+3\n\t" \
      "ds_read2_b32 %2, %8 offset0:" #o_ "+8 offset1:" #o_ "+9\n\tds_read2_b32 %3, %8 offset0:" #o_ "+10 offset1:" #o_ "+11\n\t" \
      "ds_read2_b32 %4, %8 offset0:" #o_ "+16 offset1:" #o_ "+17\n\tds_read2_b32 %5, %8 offset0:" #o_ "+18 offset1:" #o_ "+19\n\t" \
      "ds_read2_b32 %6, %8 offset0:" #o_ "+24 offset1:" #o_ "+25\n\tds_read2_b32 %7, %8 offset0:" #o_ "+26 offset1:" #o_ "+27\n\ts_waitcnt lgkmcnt(0)" \
      :"=&v"(t0),"=&v"(t1),"=&v"(t2),"=&v"(t3),"=&v"(t4),"=&v"(t5),"=&v"(t6),"=&v"(t7):"v"(a):"memory")
__device__ __forceinline__ void dmask(f32x16&p0,f32x16&p1,int base,unsigned tbl_addr){
  const unsigned a=tbl_addr+(unsigned)(2047-base)*4u;
  f32x2m t0,t1,t2,t3,t4,t5,t6,t7;
  DMASK_BATCH(0);
  p0[0]+=t0.x;p0[1]+=t0.y;p0[2]+=t1.x;p0[3]+=t1.y;p0[4]+=t2.x;p0[5]+=t2.y;p0[6]+=t3.x;p0[7]+=t3.y;
  p0[8]+=t4.x;p0[9]+=t4.y;p0[10]+=t5.x;p0[11]+=t5.y;p0[12]+=t6.x;p0[13]+=t6.y;p0[14]+=t7.x;p0[15]+=t7.y;
  DMASK_BATCH(32);
  p1[0]+=t0.x;p1[1]+=t0.y;p1[2]+=t1.x;p1[3]+=t1.y;p1[4]+=t2.x;p1[5]+=t2.y;p1[6]+=t3.x;p1[7]+=t3.y;
  p1[8]+=t4.x;p1[9]+=t4.y;p1[10]+=t5.x;p1[11]+=t5.y;p1[12]+=t6.x;p1[13]+=t6.y;p1[14]+=t7.x;p1[15]+=t7.y;
}

constexpr int NSLOT=3, SLOTB=8192;
constexpr int LDS_K=0, LDS_V=NSLOT*SLOTB, LDS_WS=2*NSLOT*SLOTB, LDS_OST=LDS_WS+NW*64*4, LDS_BYTES=LDS_OST+NW*4096;
constexpr float C2=0.125f*1.4426950408889634f;
__device__ __forceinline__ void glds16(const void*gsrc,unsigned lds_dst){unsigned keep;
  asm volatile("s_mov_b32 %0, m0\n\ts_mov_b32 m0, %2\n\ts_nop 0\n\tglobal_load_lds_dwordx4 %1, off\n\ts_mov_b32 m0, %0":"=&s"(keep):"v"(gsrc),"s"(lds_dst):"memory");}
__device__ __forceinline__ float max3f(float a,float b,float c){float r;asm("v_max3_f32 %0, %1, %2, %3":"=v"(r):"v"(a),"v"(b),"v"(c));return r;}
__device__ __forceinline__ float max2f(float a,float b){float r;asm("v_max_f32_e32 %0, %1, %2":"=v"(r):"v"(a),"v"(b));return r;}
__device__ __forceinline__ float fadd_s(float a,float b){float r;asm("v_add_f32_e32 %0, %1, %2":"=v"(r):"v"(a),"v"(b));return r;}
__device__ __forceinline__ float fsub_s(float a,float b){float r;asm("v_sub_f32_e32 %0, %1, %2":"=v"(r):"v"(a),"v"(b));return r;}
typedef float f32x2_t __attribute__((ext_vector_type(2))); typedef __bf16 bf16x2_t __attribute__((ext_vector_type(2)));
__device__ __forceinline__ unsigned cvtpk_s(float lo,float hi){f32x2_t v={lo,hi};bf16x2_t b=__builtin_convertvector(v,bf16x2_t);return __builtin_bit_cast(unsigned,b);}
#define WAIT_BAR(N) asm volatile("s_waitcnt vmcnt(" #N ") lgkmcnt(0)\n\ts_barrier":::"memory")

__device__ __forceinline__ void qkt(f32x16&p0,f32x16&p1,const char*Kslot,const bf16x8*qr,const f32x16&negm,int r32,int hi){
  const char*kb=Kslot+hi*1024+r32*16;
  #pragma unroll
  for(int d0=0;d0<4;++d0){
    const bf16x8 b0=*reinterpret_cast<const bf16x8*>(kb+d0*2048);
    const bf16x8 b1=*reinterpret_cast<const bf16x8*>(kb+d0*2048+512);
    if(d0==0){p0=__builtin_amdgcn_mfma_f32_32x32x16_bf16(b0,qr[0],negm,0,0,0);p1=__builtin_amdgcn_mfma_f32_32x32x16_bf16(b1,qr[0],negm,0,0,0);}
    else{p0=__builtin_amdgcn_mfma_f32_32x32x16_bf16(b0,qr[d0],p0,0,0,0);p1=__builtin_amdgcn_mfma_f32_32x32x16_bf16(b1,qr[d0],p1,0,0,0);}}
}
typedef __attribute__((address_space(3))) const char* lds_cptr;
typedef short v4i16_t __attribute__((ext_vector_type(4)));
__device__ __forceinline__ void kload8(bf16x8*kf,lds_cptr kp){
  kf[0]=*(const __attribute__((address_space(3))) bf16x8*)(kp);      kf[1]=*(const __attribute__((address_space(3))) bf16x8*)(kp+512);
  kf[2]=*(const __attribute__((address_space(3))) bf16x8*)(kp+2048); kf[3]=*(const __attribute__((address_space(3))) bf16x8*)(kp+2560);
  kf[4]=*(const __attribute__((address_space(3))) bf16x8*)(kp+4096); kf[5]=*(const __attribute__((address_space(3))) bf16x8*)(kp+4608);
  kf[6]=*(const __attribute__((address_space(3))) bf16x8*)(kp+6144); kf[7]=*(const __attribute__((address_space(3))) bf16x8*)(kp+6656);
}
__device__ __forceinline__ void kload2(bf16x8*kf,lds_cptr kp,int j){ kf[2*j]=*(const __attribute__((address_space(3))) bf16x8*)(kp+j*2048); kf[2*j+1]=*(const __attribute__((address_space(3))) bf16x8*)(kp+j*2048+512); }
__device__ __forceinline__ s16x4 vtr(lds_cptr p){ return __builtin_bit_cast(s16x4,__builtin_amdgcn_ds_read_tr16_b64_v4i16((__attribute__((address_space(3))) v4i16_t*)p)); }
__device__ __forceinline__ float rowmax(const f32x16&p0,const f32x16&p1){
  float a=max3f(p0[0],p0[1],p1[0]),b=max3f(p0[2],p0[3],p1[1]);a=max3f(a,p1[2],p1[3]);
  #pragma unroll
  for(int r=4;r<16;r+=4){a=max3f(a,p0[r],p0[r+1]);b=max3f(b,p0[r+2],p0[r+3]);a=max3f(a,p1[r],p1[r+1]);b=max3f(b,p1[r+2],p1[r+3]);}
  const float m=max2f(a,b);
  auto rr=__builtin_amdgcn_permlane32_swap(__float_as_uint(m),__float_as_uint(m),false,false);
  return max2f(__uint_as_float(rr[0]),__uint_as_float(rr[1]));
}
__device__ __forceinline__ void pv(f32x16*o,int vb,bf16x8 pa0,bf16x8 pa1,bf16x8 pa2,bf16x8 pa3){
  #pragma unroll
  for(int d0=0;d0<2;++d0){s16x4 lo[4],hi[4];
    #pragma unroll
    for(int ks=0;ks<4;++ks){
      asm volatile("ds_read_b64_tr_b16 %0,%1 offset:%c2":"=&v"(lo[ks]):"v"(vb),"i"(d0*4096+ks*1024):"memory");
      asm volatile("ds_read_b64_tr_b16 %0,%1 offset:%c2":"=&v"(hi[ks]):"v"(vb),"i"(d0*4096+ks*1024+512):"memory");}
    asm volatile("s_waitcnt lgkmcnt(0)":::"memory");SBAR();
    #define PK(k) (bf16x8){lo[k][0],lo[k][1],lo[k][2],lo[k][3],hi[k][0],hi[k][1],hi[k][2],hi[k][3]}
    o[d0]=__builtin_amdgcn_mfma_f32_32x32x16_bf16(pa0,PK(0),o[d0],0,0,0);
    o[d0]=__builtin_amdgcn_mfma_f32_32x32x16_bf16(pa1,PK(1),o[d0],0,0,0);
    o[d0]=__builtin_amdgcn_mfma_f32_32x32x16_bf16(pa2,PK(2),o[d0],0,0,0);
    o[d0]=__builtin_amdgcn_mfma_f32_32x32x16_bf16(pa3,PK(3),o[d0],0,0,0);
    #undef PK
  }
}

#ifndef ATTN_STORE16
#define ATTN_STORE16(p,v) (*(u32x4*)(p)=(v))
#endif
template<int THRL,int MODE> __device__ __forceinline__ void attn_unit(int b,int qb,const bf16*Q,const bf16*__restrict__ K,const bf16*__restrict__ V,bf16*O,int opitch,char*shm,unsigned tbl){
  int tid_=threadIdx.x; asm volatile("":"+v"(tid_));
  const int tid=tid_,lane=tid&63,r32=lane&31,hi=lane>>5; const int wid=__builtin_amdgcn_readfirstlane(tid>>6);
  const long rowbase=(long)b*SEQ; const int q0=qb*QB;
  const bf16*Qw=Q+(rowbase+q0+wid*QBLK)*DM;
  const bf16*Kh=K+rowbase*DM,*Vh=V+rowbase*DM;
  const unsigned lds0=(unsigned)(uintptr_t)shm;
  float*wsf=(float*)(shm+LDS_WS)+wid*64;
  const bf16*ksrc=Kh+(long)lane*DM+wid*8;
  const bf16*vsrc=Vh+(long)(16*(wid&3)+(lane>>2))*DM+(wid>>2)*32+(lane&3)*8;
  const unsigned kdst=lds0+LDS_K+wid*1024, vdst=lds0+LDS_V+wid*1024;
  #define DMA_K(t,slot) glds16(ksrc+(long)(t)*KVBLK*DM,(unsigned)__builtin_amdgcn_readfirstlane(kdst+(slot)))
  #define DMA_V(t,slot) glds16(vsrc+(long)(t)*KVBLK*DM,(unsigned)__builtin_amdgcn_readfirstlane(vdst+(slot)))
  const int vb0=(int)(lds0+LDS_V)+((lane>>4)&1)*32+(lane&3)*8+(4*hi+((lane&15)>>2))*64;
  const char*Kbase=shm+LDS_K; bf16x8 kf[8];
  const lds_cptr shm3=(lds_cptr)shm; const lds_cptr kp0=shm3+LDS_K+hi*1024+r32*16; const lds_cptr vp0=shm3+LDS_V+((lane>>4)&1)*32+(lane&3)*8+(4*hi+((lane&15)>>2))*64;
  const int NT=(q0+QB)/KVBLK;
  DMA_K(0,0);DMA_V(0,0);DMA_K(1,SLOTB);
  bf16x8 qr[4];
  #pragma unroll
  for(int d0=0;d0<4;++d0)qr[d0]=*reinterpret_cast<const bf16x8*>(&Qw[(long)r32*DM+d0*16+hi*8]);
  float mhat=0.f,l_reg=0.f;f32x16 o[2];o[0]=f32x16{};o[1]=f32x16{};f32x16 negm=f32x16{};asm volatile("":"+v"(negm));
  const int qrel=wid*QBLK+r32;
  #define CMASK(P0,P1,t) do{ if constexpr(MODE==0){int jb_=(t)-(NT-4); if(jb_>=0)cmask(P0,P1,jb_,qrel,hi);} else if constexpr(MODE==1) { dmask(P0,P1,q0+qrel-64*(t)-4*hi,tbl); } }while(0)
  bool resc=false;
  #define START(P0,P1) do{ const float rm=rowmax(P0,P1); resc=false; \
    { const float dl=rm; mhat=fadd_s(mhat,dl); \
      _Pragma("unroll") for(int r=0;r<16;++r){P0[r]=fsub_s(P0[r],dl);P1[r]=fsub_s(P1[r],dl);} \
      _Pragma("unroll") for(int r=0;r<16;++r)negm[r]=-mhat; asm volatile("":"+v"(negm)); } \
    _Pragma("unroll") for(int r=0;r<16;++r)P0[r]=__builtin_amdgcn_exp2f(P0[r]); }while(0)
  #define RESC() do{ if(resc){ asm volatile("s_waitcnt lgkmcnt(0)":::"memory"); \
      _Pragma("unroll") for(int d_=0;d_<2;++d_) _Pragma("unroll") for(int r=0;r<16;++r)o[d_][r]*=wsf[crow(r,hi)]; } }while(0)
  f32x16 pA0,pA1,pB0,pB1;
  int sl_prev=0,sl_cur=0,sl_next=SLOTB;
  #define ROT() do{sl_prev=sl_cur;sl_cur=sl_next;sl_next=(sl_next==(NSLOT-1)*SLOTB)?0:sl_next+SLOTB;}while(0)
  DMA_K(2,2*SLOTB);
  WAIT_BAR(3);
  qkt(pA0,pA1,Kbase,qr,negm,r32,hi);asm volatile("s_nop 15\n\ts_nop 7":"+v"(pA0),"+v"(pA1));CMASK(pA0,pA1,0);
  START(pA0,pA1);
  _Pragma("unroll") for(int r=0;r<16;++r)pA1[r]=__builtin_amdgcn_exp2f(pA1[r]);
  WAIT_BAR(0);
  DMA_K(3,0);DMA_V(1,SLOTB);
  ROT();
  kload8(kf,kp0+sl_cur);
  WAIT_BAR(2);
  s16x4 vlo[8],vhi[8]; u32x4 pw0,pw1,pw2,pw3;
  #define PKW(P,B) cvtpk_s(P[B],P[B+1])
  #define PAF(k) __builtin_bit_cast(bf16x8,pw##k)
  #define VFR(i) (bf16x8){vlo[i][0],vlo[i][1],vlo[i][2],vlo[i][3],vhi[i][0],vhi[i][1],vhi[i][2],vhi[i][3]}
  #define PIN(x) asm volatile("":"+v"(x))
  #define MX3(a,b,c) __builtin_fmaxf(__builtin_fmaxf((a),(b)),(c))
  #define GAPA(MF,A0,A1,A2,A3,W0,W1,PW) do{ MF; sacc+=A0; sacc+=A1; sacc+=A2; sacc+=A3; PIN(sacc); W0; W1; PIN(PW); SBAR(); }while(0)
  #define EX(v) __builtin_amdgcn_exp2f(v)
  #define GAPB(MF,X,B) do{ MF; X[B]=EX(X[B]); X[B+1]=EX(X[B+1]); X[B+2]=EX(X[B+2]); X[B+3]=EX(X[B+3]); PIN(X); SBAR(); }while(0)
  #define VRD(i) do{ vlo[i]=vtr(vp_+(((i)>>2)*4096+((i)&3)*1024)); vhi[i]=vtr(vp_+(((i)>>2)*4096+((i)&3)*1024+512)); }while(0)
  #define KRD(G,j) do{ if(G){ kload2(kf,kp0+sl_next,j); SBAR(); } }while(0)
  #define STEP(C0,C1,P0,P1,t,GK,GV,GL) do{ SBAR(); \
    const lds_cptr vp_=vp0+sl_prev; \
    VRD(0); SBAR(); float sacc=(P0[0]+P0[1]); \
    GAPA(C0=__builtin_amdgcn_mfma_f32_32x32x16_bf16(kf[0],qr[0],negm,0,0,0), P0[2],P0[3],P0[4],P0[5],     pw0[0]=PKW(P0,0), pw0[1]=PKW(P0,2), pw0); \
    VRD(4); SBAR(); GAPA(C1=__builtin_amdgcn_mfma_f32_32x32x16_bf16(kf[1],qr[0],negm,0,0,0), P0[6],P0[7],P0[8],P0[9],     pw0[2]=PKW(P0,4), pw0[3]=PKW(P0,6), pw0); \
    VRD(1); SBAR(); GAPA(C0=__builtin_amdgcn_mfma_f32_32x32x16_bf16(kf[2],qr[1],C0,0,0,0),   P0[10],P0[11],P0[12],P0[13], pw1[0]=PKW(P0,8), pw1[1]=PKW(P0,10), pw1); \
    VRD(5); SBAR(); GAPA(C1=__builtin_amdgcn_mfma_f32_32x32x16_bf16(kf[3],qr[1],C1,0,0,0),   P0[14],P0[15],P1[0],P1[1],   pw1[2]=PKW(P0,12),pw1[3]=PKW(P0,14), pw1); \
    VRD(2); SBAR(); GAPA(C0=__builtin_amdgcn_mfma_f32_32x32x16_bf16(kf[4],qr[2],C0,0,0,0),   P1[2],P1[3],P1[4],P1[5],     pw2[0]=PKW(P1,0), pw2[1]=PKW(P1,2), pw2); \
    VRD(6); SBAR(); GAPA(C1=__builtin_amdgcn_mfma_f32_32x32x16_bf16(kf[5],qr[2],C1,0,0,0),   P1[6],P1[7],P1[8],P1[9],     pw2[2]=PKW(P1,4), pw2[3]=PKW(P1,6), pw2); \
    VRD(3); SBAR(); GAPA(C0=__builtin_amdgcn_mfma_f32_32x32x16_bf16(kf[6],qr[3],C0,0,0,0),   P1[10],P1[11],P1[12],P1[13], pw3[0]=PKW(P1,8), pw3[1]=PKW(P1,10), pw3); \
    VRD(7); SBAR(); GAPA(C1=__builtin_amdgcn_mfma_f32_32x32x16_bf16(kf[7],qr[3],C1,0,0,0),   P1[14],P1[15],0.f,0.f,       pw3[2]=PKW(P1,12),pw3[3]=PKW(P1,14), pw3); \
    l_reg+=sacc; \
    if(GK){DMA_K((t)+3,sl_cur);} if(GV){DMA_V((t)+1,sl_next);} \
    CMASK(C0,C1,t); \
    { float a=MX3(C0[0],C0[1],C1[0]),b=MX3(C0[2],C0[3],C1[1]); a=MX3(a,C1[2],C1[3]); \
      _Pragma("unroll") for(int r=4;r<16;r+=4){a=MX3(a,C0[r],C0[r+1]);b=MX3(b,C0[r+2],C0[r+3]);a=MX3(a,C1[r],C1[r+1]);b=MX3(b,C1[r+2],C1[r+3]);} \
      float rm=__builtin_fmaxf(a,b); { auto rr=__builtin_amdgcn_permlane32_swap(__float_as_uint(rm),__float_as_uint(rm),false,false); rm=__builtin_fmaxf(__uint_as_float(rr[0]),__uint_as_float(rr[1])); } \
      resc=false; \
      if(__builtin_expect(__any(rm>(float)THRL),0)){ const float dl=__builtin_fmaxf(rm,0.f); mhat+=dl; \
        _Pragma("unroll") for(int r=0;r<16;++r){C0[r]-=dl;C1[r]-=dl;} \
        _Pragma("unroll") for(int r=0;r<16;++r)negm[r]=-mhat; asm volatile("":"+v"(negm)); \
        const float f=__builtin_amdgcn_exp2f(-dl); l_reg*=f; if(hi==0)wsf[r32]=f; resc=true; } } \
    SBAR(); \
    GAPB(o[0]=__builtin_amdgcn_mfma_f32_32x32x16_bf16(PAF(0),VFR(0),o[0],0,0,0), C0,0); \
    GAPB(o[1]=__builtin_amdgcn_mfma_f32_32x32x16_bf16(PAF(0),VFR(4),o[1],0,0,0), C0,4); \
    KRD(GL,0); GAPB(o[0]=__builtin_amdgcn_mfma_f32_32x32x16_bf16(PAF(1),VFR(1),o[0],0,0,0), C0,8); \
    KRD(GL,1); GAPB(o[1]=__builtin_amdgcn_mfma_f32_32x32x16_bf16(PAF(1),VFR(5),o[1],0,0,0), C0,12); \
    KRD(GL,2); GAPB(o[0]=__builtin_amdgcn_mfma_f32_32x32x16_bf16(PAF(2),VFR(2),o[0],0,0,0), C1,0); \
    KRD(GL,3); GAPB(o[1]=__builtin_amdgcn_mfma_f32_32x32x16_bf16(PAF(2),VFR(6),o[1],0,0,0), C1,4); \
    GAPB(o[0]=__builtin_amdgcn_mfma_f32_32x32x16_bf16(PAF(3),VFR(3),o[0],0,0,0), C1,8); \
    GAPB(o[1]=__builtin_amdgcn_mfma_f32_32x32x16_bf16(PAF(3),VFR(7),o[1],0,0,0), C1,12); \
    }while(0)
  int t=1;
  #undef CMASK
  #define CMASK(P0,P1,t) do{ if constexpr(MODE==1){ dmask(P0,P1,q0+qrel-64*(t)-4*hi,tbl); } }while(0)
  for(;t+5<NT;t+=2){
    STEP(pB0,pB1,pA0,pA1,t,true,true,true);     WAIT_BAR(2); RESC(); ROT();
    STEP(pA0,pA1,pB0,pB1,t+1,true,true,true);   WAIT_BAR(2); RESC(); ROT();
  }
  #undef CMASK
  #define CMASK(P0,P1,t) do{ if constexpr(MODE==0){int jb_=(t)-(NT-4); if(jb_>=0)cmask(P0,P1,jb_,qrel,hi);} else if constexpr(MODE==1) { dmask(P0,P1,q0+qrel-64*(t)-4*hi,tbl); } }while(0)
  #define ENDW(tt) do{ if((tt)+3<NT){WAIT_BAR(2);} else if((tt)+2<NT){WAIT_BAR(1);} else {WAIT_BAR(0);} }while(0)
  for(;t+1<NT;t+=2){
    STEP(pB0,pB1,pA0,pA1,t,(t+3<NT),(t+1<NT),(t+1<NT));       ENDW(t);   RESC(); ROT();
    STEP(pA0,pA1,pB0,pB1,t+1,(t+4<NT),(t+2<NT),(t+2<NT));     ENDW(t+1); RESC(); ROT();
  }
  STEP(pB0,pB1,pA0,pA1,NT-1,false,false,false); RESC();
  { float sacc=pB0[0]+pB0[1]; _Pragma("unroll") for(int r=2;r<16;++r)sacc+=pB0[r]; _Pragma("unroll") for(int r=0;r<16;++r)sacc+=pB1[r]; l_reg+=sacc;
    pw0=(u32x4){PKW(pB0,0),PKW(pB0,2),PKW(pB0,4),PKW(pB0,6)};pw1=(u32x4){PKW(pB0,8),PKW(pB0,10),PKW(pB0,12),PKW(pB0,14)};pw2=(u32x4){PKW(pB1,0),PKW(pB1,2),PKW(pB1,4),PKW(pB1,6)};pw3=(u32x4){PKW(pB1,8),PKW(pB1,10),PKW(pB1,12),PKW(pB1,14)};
    SBAR(); pv(o,vb0+sl_cur,PAF(0),PAF(1),PAF(2),PAF(3)); }
  #undef PKW
  #undef PAF
  #undef VFR
  #undef PIN
  #undef MX3
  #undef GAPA
  #undef GAPB
  #undef EX
  #undef VRD
  #undef KRD
  #undef STEP
  #undef ENDW
  {auto rr=__builtin_amdgcn_permlane32_swap(__float_as_uint(l_reg),__float_as_uint(l_reg),false,false);l_reg=__uint_as_float(rr[0])+__uint_as_float(rr[1]);}
  if(hi==0)wsf[32+r32]=l_reg;asm volatile("s_waitcnt lgkmcnt(0)":::"memory");
  float rli[16];
  #pragma unroll
  for(int r=0;r<16;++r)rli[r]=__builtin_amdgcn_rcpf(wsf[32+crow(r,hi)]);
  bf16*Ow=O+(rowbase+q0+wid*QBLK)*(long)opitch;
  { bf16*stg=(bf16*)(shm+LDS_OST)+wid*2048;
    #pragma unroll
    for(int r=0;r<16;++r){const int orow=crow(r,hi);
      #pragma unroll
      for(int d0=0;d0<2;++d0)stg[orow*64+d0*32+r32]=__float2bfloat16(o[d0][r]*rli[r]);}
    asm volatile("s_waitcnt lgkmcnt(0)":::"memory");
    #pragma unroll
    for(int i=0;i<4;++i){const int row=i*8+(lane>>3),ch=lane&7; const u32x4 v=*(const u32x4*)(stg+row*64+ch*8); ATTN_STORE16(Ow+(long)row*opitch+ch*8,v);} }
  asm volatile("s_waitcnt lgkmcnt(0)\n\ts_barrier":::"memory");
  #undef DMA_K
  #undef DMA_V
  #undef CMASK
  #undef START
  #undef RESC
  #undef ROT
}
constexpr int ATTN_LDS_BYTES=LDS_BYTES;
#undef SBAR
#undef WAIT_BAR
}

namespace attn_b {
using bf16 = __hip_bfloat16;
typedef short bf16x8 __attribute__((ext_vector_type(8)));
typedef short s16x4 __attribute__((ext_vector_type(4)));
typedef float f32x16 __attribute__((ext_vector_type(16)));
typedef float f32x4 __attribute__((ext_vector_type(4)));
typedef unsigned u32x4 __attribute__((ext_vector_type(4)));
constexpr int DQ = 64, DV = 128, PIN = 3072, POUT = 1024;
constexpr int NW = 8, QBLK = 32, KVBLK = 64, QB = NW * QBLK;
constexpr int SHM_V = KVBLK * DV * 2, SHM_K = KVBLK * DQ * 2;
constexpr int NBUF = 3;
constexpr int LDS_BYTES = NBUF * SHM_V + NBUF * SHM_K + NW * 64 * 4;
constexpr int OSTAGE_OFF = 98304;
constexpr float THR = 8.f;
#define KSWZ(row, colB) ((row) * 128 + ((colB) ^ ((((row) >> 1) & 7) << 4)))
#define SBAR() __builtin_amdgcn_sched_barrier(0)
__device__ __forceinline__ int v_st(int k, int c) { const int kk = (k & ~0xC) | ((k & 4) << 1) | ((k & 8) >> 1); return ((kk >> 3) * 4 + (c >> 5)) * 512 + ((kk & 7) * 32 + (c & 31)) * 2; }
__device__ __forceinline__ int v_rd_base(int lane) { return ((lane & 3) << 3) | (((lane >> 2) & 3) << 6) | (((lane >> 4) & 1) << 5) | (((lane >> 5) & 1) << 8); }
constexpr int v_rd_off(int d0, int ks, int half) { return d0 * 512 + ks * 4096 + half * 2048; }
__device__ __forceinline__ int crow(int r, int hi) { return (r & 3) + 8 * (r >> 2) + 4 * hi; }
__device__ __forceinline__ unsigned cvtpk(float lo, float hi) { unsigned r; asm volatile("v_cvt_pk_bf16_f32 %0, %1, %2" : "=v"(r) : "v"(lo), "v"(hi)); return r; }
__device__ __forceinline__ bf16x8 load8(const bf16* p) { return *reinterpret_cast<const bf16x8*>(p); }
__device__ __forceinline__ void mask_tile(f32x16& p0, f32x16& p1, int dq) {
    const float NEG = -__builtin_inff();
#pragma unroll
    for (int r = 0; r < 16; ++r) { const int c = (r & 3) + 8 * (r >> 2); if (dq - c < 0) p0[r] = NEG; if (dq - c - 32 < 0) p1[r] = NEG; }
}
#define MX3(a, b, c) __builtin_fmaxf(__builtin_fmaxf((a), (b)), (c))
__device__ __forceinline__ void partialSM(f32x16& p0, f32x16& p1, float& m_reg, float& mn, float& alpha) {
    float ma = MX3(p0[0], p0[1], p0[2]), mb = MX3(p0[3], p0[4], p0[5]), mc = MX3(p1[0], p1[1], p1[2]), md = MX3(p1[3], p1[4], p1[5]);
    ma = MX3(ma, p0[6], p0[7]); mb = MX3(mb, p0[8], p0[9]); mc = MX3(mc, p1[6], p1[7]); md = MX3(md, p1[8], p1[9]);
    ma = MX3(ma, p0[10], p0[11]); mb = MX3(mb, p0[12], p0[13]); mc = MX3(mc, p1[10], p1[11]); md = MX3(md, p1[12], p1[13]);
    ma = MX3(ma, p0[14], p0[15]); mc = MX3(mc, p1[14], p1[15]);
    float pmax = __builtin_fmaxf(MX3(ma, mb, mc), md);
    { auto rr = __builtin_amdgcn_permlane32_swap(__float_as_uint(pmax), __float_as_uint(pmax), false, false); pmax = fmaxf(__uint_as_float(rr[0]), __uint_as_float(rr[1])); }
    if (__builtin_expect(__all((pmax - m_reg) <= THR), 1)) { mn = m_reg; alpha = 1.f; }
    else { mn = fmaxf(m_reg, pmax); alpha = __builtin_amdgcn_exp2f(m_reg - mn); m_reg = mn; }
#pragma unroll
    for (int r = 0; r < 16; ++r) p0[r] = p0[r] - mn;
#pragma unroll
    for (int r = 0; r < 16; ++r) p1[r] = p1[r] - mn;
#pragma unroll
    for (int r = 0; r < 16; ++r) p0[r] = __builtin_amdgcn_exp2f(p0[r]);
}
__device__ __forceinline__ void finishSM(f32x16& p0, f32x16& p1, float alpha, float& l_reg, bf16x8& pa0, bf16x8& pa1, bf16x8& pa2, bf16x8& pa3) {
#pragma unroll
    for (int r = 0; r < 16; ++r) p1[r] = __builtin_amdgcn_exp2f(p1[r]);
    float sa = p0[0] + p0[1], sb = p0[2] + p0[3], sc = p1[0] + p1[1], sd = p1[2] + p1[3];
#pragma unroll
    for (int r = 4; r < 16; r += 4) { sa += p0[r]; sb += p0[r + 2]; sc += p1[r]; sd += p1[r + 2]; sa += p0[r + 1]; sb += p0[r + 3]; sc += p1[r + 1]; sd += p1[r + 3]; }
    float ps = (sa + sb) + (sc + sd);
    { auto rr = __builtin_amdgcn_permlane32_swap(__float_as_uint(ps), __float_as_uint(ps), false, false); ps = __uint_as_float(rr[0]) + __uint_as_float(rr[1]); }
    l_reg = l_reg * alpha + ps;
#define PK4(P, B_, OUT) do { unsigned a0 = cvtpk(P[B_+0], P[B_+1]), a1 = cvtpk(P[B_+2], P[B_+3]);                          \
        unsigned b0 = cvtpk(P[B_+4], P[B_+5]), b1 = cvtpk(P[B_+6], P[B_+7]);                                             \
        auto r0 = __builtin_amdgcn_permlane32_swap(a0, b0, false, false); auto r1 = __builtin_amdgcn_permlane32_swap(a1, b1, false, false); \
        u32x4 w = {r0[0], r1[0], r0[1], r1[1]}; OUT = *reinterpret_cast<bf16x8*>(&w); } while (0)
    PK4(p0, 0, pa0); PK4(p0, 8, pa1); PK4(p1, 0, pa2); PK4(p1, 8, pa3);
#undef PK4
}
__device__ __forceinline__ void qkt(f32x16& p0, f32x16& p1, const char* K_buf, int r32, int hi, const bf16x8* qr) {
    p0 = f32x16{}; p1 = f32x16{};
#pragma unroll
    for (int d0 = 0; d0 < 4; ++d0) { const char* a = K_buf + KSWZ(r32, (d0 * 16 + hi * 8) * 2);
        bf16x8 b0 = *reinterpret_cast<const bf16x8*>(a);
        bf16x8 b1 = *reinterpret_cast<const bf16x8*>(a + 32 * 128);
        p0 = __builtin_amdgcn_mfma_f32_32x32x16_bf16(b0, qr[d0], p0, 0, 0, 0);
        p1 = __builtin_amdgcn_mfma_f32_32x32x16_bf16(b1, qr[d0], p1, 0, 0, 0); }
}
__device__ __forceinline__ void qkt_shift(f32x16& p0, f32x16& p1, const char* K_buf, int r32, int hi, const bf16x8* qr, const f32x16& negm) {
#pragma unroll
    for (int d0 = 0; d0 < 4; ++d0) { const char* a = K_buf + KSWZ(r32, (d0 * 16 + hi * 8) * 2);
        bf16x8 b0 = *reinterpret_cast<const bf16x8*>(a);
        bf16x8 b1 = *reinterpret_cast<const bf16x8*>(a + 32 * 128);
        if (d0 == 0) { p0 = __builtin_amdgcn_mfma_f32_32x32x16_bf16(b0, qr[0], negm, 0, 0, 0); p1 = __builtin_amdgcn_mfma_f32_32x32x16_bf16(b1, qr[0], negm, 0, 0, 0); }
        else { p0 = __builtin_amdgcn_mfma_f32_32x32x16_bf16(b0, qr[d0], p0, 0, 0, 0); p1 = __builtin_amdgcn_mfma_f32_32x32x16_bf16(b1, qr[d0], p1, 0, 0, 0); } }
}
__device__ __forceinline__ void partialSM_shift(f32x16& p0, f32x16& p1, float& m_reg, f32x16& negm, float& alpha) {
    float ma = MX3(p0[0], p0[1], p0[2]), mb = MX3(p0[3], p0[4], p0[5]), mc = MX3(p1[0], p1[1], p1[2]), md = MX3(p1[3], p1[4], p1[5]);
    ma = MX3(ma, p0[6], p0[7]); mb = MX3(mb, p0[8], p0[9]); mc = MX3(mc, p1[6], p1[7]); md = MX3(md, p1[8], p1[9]);
    ma = MX3(ma, p0[10], p0[11]); mb = MX3(mb, p0[12], p0[13]); mc = MX3(mc, p1[10], p1[11]); md = MX3(md, p1[12], p1[13]);
    ma = MX3(ma, p0[14], p0[15]); mc = MX3(mc, p1[14], p1[15]);
    float pmax = __builtin_fmaxf(MX3(ma, mb, mc), md);
    { auto rr = __builtin_amdgcn_permlane32_swap(__float_as_uint(pmax), __float_as_uint(pmax), false, false); pmax = fmaxf(__uint_as_float(rr[0]), __uint_as_float(rr[1])); }
    if (__builtin_expect(__all(pmax <= THR), 1)) { alpha = 1.f; }
    else { const float dl = fmaxf(pmax, 0.f); alpha = __builtin_amdgcn_exp2f(-dl); m_reg += dl;
#pragma unroll
        for (int r = 0; r < 16; ++r) { p0[r] = p0[r] - dl; p1[r] = p1[r] - dl; }
#pragma unroll
        for (int r = 0; r < 16; ++r) negm[r] = -m_reg;
        asm volatile("" : "+v"(negm)); }
#pragma unroll
    for (int r = 0; r < 16; ++r) p0[r] = __builtin_amdgcn_exp2f(p0[r]);
}
__device__ __forceinline__ void pv_tile(f32x16* o, int vb0, bf16x8 pa0, bf16x8 pa1, bf16x8 pa2, bf16x8 pa3) {
#define TRRD(dst, off) asm volatile("ds_read_b64_tr_b16 %0, %1 offset:%2" : "=&v"(dst) : "v"(vb0), "i"(off) : "memory")
#define PV_D0(d0) do { s16x4 l0, l1, l2, l3, h0, h1, h2, h3; constexpr int b_ = v_rd_off(d0, 0, 0);   \
        TRRD(l0, b_); TRRD(h0, b_ + 2048); TRRD(l1, b_ + 4096); TRRD(h1, b_ + 6144); TRRD(l2, b_ + 8192); TRRD(h2, b_ + 10240); TRRD(l3, b_ + 12288); TRRD(h3, b_ + 14336); \
        asm volatile("s_waitcnt lgkmcnt(0)" ::: "memory"); SBAR();   \
        o[d0] = __builtin_amdgcn_mfma_f32_32x32x16_bf16(pa0, (bf16x8){l0[0], l0[1], l0[2], l0[3], h0[0], h0[1], h0[2], h0[3]}, o[d0], 0, 0, 0);   \
        o[d0] = __builtin_amdgcn_mfma_f32_32x32x16_bf16(pa1, (bf16x8){l1[0], l1[1], l1[2], l1[3], h1[0], h1[1], h1[2], h1[3]}, o[d0], 0, 0, 0);   \
        o[d0] = __builtin_amdgcn_mfma_f32_32x32x16_bf16(pa2, (bf16x8){l2[0], l2[1], l2[2], l2[3], h2[0], h2[1], h2[2], h2[3]}, o[d0], 0, 0, 0);   \
        o[d0] = __builtin_amdgcn_mfma_f32_32x32x16_bf16(pa3, (bf16x8){l3[0], l3[1], l3[2], l3[3], h3[0], h3[1], h3[2], h3[3]}, o[d0], 0, 0, 0); } while (0)
    PV_D0(0); PV_D0(1); PV_D0(2); PV_D0(3);
#undef PV_D0
#undef TRRD
}
__device__ __forceinline__ void partialSM_noexp(f32x16& p0, f32x16& p1, float& m_reg, float& mn, float& alpha) {
    float pmax = p0[0];
#pragma unroll
    for (int r = 1; r < 16; ++r) pmax = fmaxf(pmax, p0[r]);
#pragma unroll
    for (int r = 0; r < 16; ++r) pmax = fmaxf(pmax, p1[r]);
    { auto rr = __builtin_amdgcn_permlane32_swap(__float_as_uint(pmax), __float_as_uint(pmax), false, false); pmax = fmaxf(__uint_as_float(rr[0]), __uint_as_float(rr[1])); }
    if (__builtin_expect(__all((pmax - m_reg) <= THR), 1)) { mn = m_reg; alpha = 1.f; }
    else { mn = fmaxf(m_reg, pmax); alpha = 1.f; m_reg = mn; }
#pragma unroll
    for (int r = 0; r < 16; ++r) p0[r] = p0[r] - mn;
#pragma unroll
    for (int r = 0; r < 16; ++r) p1[r] = p1[r] - mn;
}
__device__ __forceinline__ void finishSM_noexp(f32x16& p0, f32x16& p1, float alpha, float& l_reg, bf16x8& pa0, bf16x8& pa1, bf16x8& pa2, bf16x8& pa3) {
    float ps = 0;
#pragma unroll
    for (int r = 0; r < 16; ++r) ps += p0[r];
#pragma unroll
    for (int r = 0; r < 16; ++r) ps += p1[r];
    { auto rr = __builtin_amdgcn_permlane32_swap(__float_as_uint(ps), __float_as_uint(ps), false, false); ps = __uint_as_float(rr[0]) + __uint_as_float(rr[1]); }
    l_reg = l_reg * alpha + ps;
#define PK4(P, B_, OUT) do { unsigned a0 = cvtpk(P[B_+0], P[B_+1]), a1 = cvtpk(P[B_+2], P[B_+3]);                          \
        unsigned b0 = cvtpk(P[B_+4], P[B_+5]), b1 = cvtpk(P[B_+6], P[B_+7]);                                             \
        auto r0 = __builtin_amdgcn_permlane32_swap(a0, b0, false, false); auto r1 = __builtin_amdgcn_permlane32_swap(a1, b1, false, false); \
        u32x4 w = {r0[0], r1[0], r0[1], r1[1]}; OUT = *reinterpret_cast<bf16x8*>(&w); } while (0)
    PK4(p0, 0, pa0); PK4(p0, 8, pa1); PK4(p1, 0, pa2); PK4(p1, 8, pa3);
#undef PK4
}
__device__ __forceinline__ void qkt_nomma(f32x16& p0, f32x16& p1, const char* K_buf, int r32, int hi, const bf16x8* qr) {
    p0 = f32x16{}; p1 = f32x16{};
#pragma unroll
    for (int d0 = 0; d0 < 4; ++d0) { const char* a = K_buf + KSWZ(r32, (d0 * 16 + hi * 8) * 2);
        bf16x8 b0 = *reinterpret_cast<const bf16x8*>(a);
        bf16x8 b1 = *reinterpret_cast<const bf16x8*>(a + 32 * 128);
        p0[d0] += (float)b0[0] + (float)qr[d0][0]; p1[d0] += (float)b1[0]; }
}
__device__ __forceinline__ void pv_nomma(f32x16* o, int vb0, bf16x8 pa0, bf16x8 pa1, bf16x8 pa2, bf16x8 pa3) {
#define TRRD(dst, off) asm volatile("ds_read_b64_tr_b16 %0, %1 offset:%2" : "=&v"(dst) : "v"(vb0), "i"(off) : "memory")
#define PV_D0(d0) do { s16x4 l0, l1, l2, l3, h0, h1, h2, h3; constexpr int b_ = v_rd_off(d0, 0, 0);   \
        TRRD(l0, b_); TRRD(h0, b_ + 2048); TRRD(l1, b_ + 4096); TRRD(h1, b_ + 6144); TRRD(l2, b_ + 8192); TRRD(h2, b_ + 10240); TRRD(l3, b_ + 12288); TRRD(h3, b_ + 14336); \
        asm volatile("s_waitcnt lgkmcnt(0)" ::: "memory"); SBAR();   \
        o[d0][0] += (float)(l0[0] + h0[0] + l1[0] + h1[0] + l2[0] + h2[0] + l3[0] + h3[0]) + (float)pa0[0] + (float)pa1[0] + (float)pa2[0] + (float)pa3[0]; } while (0)
    PV_D0(0); PV_D0(1); PV_D0(2); PV_D0(3);
#undef PV_D0
#undef TRRD
}
struct BlockRef { const bf16* Q; const bf16* K; const bf16* V; bf16* O; int P0; };
struct Seam { bf16x8 qr[4]; bf16x8 st_v0, st_v1, st_k0; };
#define VMW() asm volatile("s_waitcnt vmcnt(0)" ::: "memory")
#define VMWN(n) asm volatile("s_waitcnt vmcnt(%0)" :: "i"(n) : "memory")
#define SLOAD_H(Kp, Vp, k0) do { S.st_v0 = load8((Vp) + (size_t)((k0) + sr) * PIN + sc); S.st_v1 = load8((Vp) + (size_t)((k0) + 32 + sr) * PIN + sc);   \
                                 S.st_k0 = load8((Kp) + (size_t)((k0) + ksr) * PIN + ksc); } while (0)
#define SWRITE_HK(bf) do { *(bf16x8*)(K_lds + (bf) * SHM_K + kws) = S.st_k0; } while (0)
#define SWRITE_HV(bf) do { *(bf16x8*)(V_lds + (bf) * SHM_V + vst0) = S.st_v0; *(bf16x8*)(V_lds + (bf) * SHM_V + vst1) = S.st_v1; } while (0)
#define SWRITE_H(bf) do { SWRITE_HV(bf); SWRITE_HK(bf); } while (0)
__device__ __forceinline__ void causal_prime(const BlockRef& cur, char* lds, Seam& S) {
    int tid_ = threadIdx.x; asm volatile("" : "+v"(tid_));
    const int tid = tid_, wid = __builtin_amdgcn_readfirstlane(tid >> 6), lane = tid & 63, r32 = lane & 31, hi = lane >> 5;
    const int sr = tid >> 4, sc = (tid & 15) * 8, ksr = tid >> 3, ksc = (tid & 7) * 8, kws = KSWZ(ksr, ksc * 2); char* K_lds = lds + NBUF * SHM_V;
#pragma unroll
    for (int d0 = 0; d0 < 4; ++d0) S.qr[d0] = load8(cur.Q + (size_t)(wid * QBLK + r32) * PIN + d0 * 16 + hi * 8);
    SLOAD_H(cur.K, cur.V, 0); VMW(); SWRITE_HK(0);
    __syncthreads();
}
template <int ABL = 0>
__device__ __forceinline__ void causal_block(const BlockRef& cur, const BlockRef& nxt, char* lds, Seam& S) {
    int tid_ = threadIdx.x; asm volatile("" : "+v"(tid_));
    const int tid = tid_, wid = __builtin_amdgcn_readfirstlane(tid >> 6), lane = tid & 63, r32 = lane & 31, hi = lane >> 5;
    const int NT = (cur.P0 + QB) / KVBLK;
    const int qlo = cur.P0 + wid * QBLK, qm = qlo + r32 - 4 * hi;
    char* V_lds = lds; char* K_lds = lds + NBUF * SHM_V;
    float* ws = (float*)(lds + NBUF * SHM_V + NBUF * SHM_K) + wid * 64; float* li_l = ws, * al_l = ws + 32;
    float m_reg = -1e30f, l_reg = 0; f32x16 o[4] = {};
    const int sr = tid >> 4, sc = (tid & 15) * 8, vst0 = v_st(sr, sc), vst1 = v_st(32 + sr, sc), ksr = tid >> 3, ksc = (tid & 7) * 8, kws = KSWZ(ksr, ksc * 2);
    const int vb0 = (int)(uintptr_t)V_lds + v_rd_base(lane);
    const bf16* Kh = cur.K; const bf16* Vh = cur.V;
#define RESC(a) do { if (__any((a) < 1.f)) { if (hi == 0) al_l[r32] = (a); asm volatile("s_waitcnt lgkmcnt(0)" ::: "memory");              \
                     _Pragma("unroll") for (int d_ = 0; d_ < 4; ++d_) _Pragma("unroll") for (int r = 0; r < 16; ++r) o[d_][r] *= al_l[crow(r, hi)]; } } while (0)
#define KBASE(t) ((t) * KVBLK)
#define MASKT(P0_, P1_, t) do { const int kb_ = KBASE(t); if (kb_ + KVBLK - 1 > qlo) { asm volatile("" ::: "memory"); mask_tile(P0_, P1_, qm - kb_); } } while (0)
    constexpr int NQL = 4;
#define SEAM_K0() do { VMWN(NQL); SWRITE_HK(0); SBAR(); } while (0)
    f32x16 pA0, pA1, pB0, pB1; float mnA, mnB, alA, alB; bf16x8 pa0, pa1, pa2, pa3;
    SWRITE_HV(0); SBAR();
    if (NT > 1) { SLOAD_H(Kh, Vh, KBASE(1)); }
    SBAR(); qkt(pA0, pA1, K_lds, r32, hi, S.qr);
    MASKT(pA0, pA1, 0); partialSM(pA0, pA1, m_reg, mnA, alA);
    f32x16 negm;
#pragma unroll
    for (int r = 0; r < 16; ++r) negm[r] = -m_reg;
    asm volatile("" : "+v"(negm));
    if (NT > 1) { VMW(); SWRITE_H(1); }
    __syncthreads();
    int bt = 1, bp = 0, bn = 2;
#define ROTB() do { const int o_ = bp; bp = bt; bt = bn; bn = o_; } while (0)
#define HALF_STEP(PX0, PX1, mnX, alX, PY0, PY1, alY, t) do {                                                                 \
        SBAR(); if constexpr (ABL != 6 && ABL < 9) { if constexpr (ABL == 2) qkt_nomma(PX0, PX1, K_lds + bt * SHM_K, r32, hi, S.qr); else qkt_shift(PX0, PX1, K_lds + bt * SHM_K, r32, hi, S.qr, negm); } \
        if constexpr (ABL != 7 && ABL < 9) { if constexpr (ABL == 1) finishSM_noexp(PY0, PY1, alY, l_reg, pa0, pa1, pa2, pa3); else finishSM(PY0, PY1, alY, l_reg, pa0, pa1, pa2, pa3); } SBAR(); \
        if constexpr (ABL != 4 && ABL < 9) { if ((t) + 1 < NT) { SLOAD_H(Kh, Vh, KBASE((t) + 1)); SBAR(); } }                              \
        if constexpr (ABL != 5 && ABL < 9) { if constexpr (ABL == 2) pv_nomma(o, vb0 + bp * SHM_V, pa0, pa1, pa2, pa3); else pv_tile(o, vb0 + bp * SHM_V, pa0, pa1, pa2, pa3); } \
        MASKT(PX0, PX1, (t)); if constexpr (ABL != 7 && ABL < 9) { if constexpr (ABL == 1) partialSM_noexp(PX0, PX1, m_reg, mnX, alX); else partialSM_shift(PX0, PX1, m_reg, negm, alX); } else { alX = 1.f; } \
        if constexpr (ABL != 4 && ABL < 9) { if ((t) + 1 < NT) { VMW(); SWRITE_H(bn); } }                                                  \
        RESC(alX); if constexpr (ABL != 3 && ABL != 10) __syncthreads(); ROTB(); } while (0)
    for (int t = 1; t + 1 < NT && ABL != 8; t += 2) {
        HALF_STEP(pB0, pB1, mnB, alB, pA0, pA1, alA, t);
        HALF_STEP(pA0, pA1, mnA, alA, pB0, pB1, alB, t + 1);
    }
    const bool even = (NT & 1) == 0;
    if (even) { SBAR(); qkt_shift(pB0, pB1, K_lds + bt * SHM_K, r32, hi, S.qr, negm); SBAR(); }
    SLOAD_H(nxt.K, nxt.V, 0); SBAR();
#pragma unroll
    for (int d0 = 0; d0 < 4; ++d0) S.qr[d0] = load8(nxt.Q + (size_t)(wid * QBLK + r32) * PIN + d0 * 16 + hi * 8);
    SBAR();
    finishSM(pA0, pA1, alA, l_reg, pa0, pa1, pa2, pa3); SBAR();
    pv_tile(o, vb0 + (even ? bp : bt) * SHM_V, pa0, pa1, pa2, pa3);
    if (even) { MASKT(pB0, pB1, NT - 1); partialSM_shift(pB0, pB1, m_reg, negm, alB); __syncthreads(); RESC(alB);
        finishSM(pB0, pB1, alB, l_reg, pa0, pa1, pa2, pa3); SBAR(); pv_tile(o, vb0 + bt * SHM_V, pa0, pa1, pa2, pa3); }
    SBAR(); SEAM_K0();
    if (hi == 0) li_l[r32] = l_reg; asm volatile("s_waitcnt lgkmcnt(0)" ::: "memory");
    float rli[16];
#pragma unroll
    for (int r = 0; r < 16; ++r) rli[r] = __builtin_amdgcn_rcpf(li_l[crow(r, hi)]);
    bf16* Ow = cur.O + (size_t)(wid * QBLK) * POUT;
    bf16* stg = (bf16*)(lds + OSTAGE_OFF) + wid * 2048;
#pragma unroll
    for (int h2 = 0; h2 < 2; ++h2) {
#pragma unroll
        for (int r = 0; r < 16; ++r) { const int orow = crow(r, hi);
#pragma unroll
            for (int dd = 0; dd < 2; ++dd) stg[orow * 64 + dd * 32 + r32] = __float2bfloat16(o[2 * h2 + dd][r] * rli[r]); }
        asm volatile("s_waitcnt lgkmcnt(0)" ::: "memory");
#pragma unroll
        for (int i = 0; i < 4; ++i) { const int row = i * 8 + (lane >> 3), ch = lane & 7; const u32x4 v = *(const u32x4*)(stg + row * 64 + ch * 8);
            *(u32x4*)(Ow + (size_t)row * POUT + h2 * 64 + ch * 8) = v; }
        asm volatile("s_waitcnt lgkmcnt(0)" ::: "memory");
    }
    __syncthreads();
#undef RESC
#undef KBASE
#undef MASKT
#undef SEAM_K0
#undef HALF_STEP
#undef ROTB
}
#undef VMW
#undef VMWN
#undef SLOAD_H
#undef SWRITE_HK
#undef SWRITE_HV
#undef SWRITE_H
#undef KSWZ
#undef SBAR
}

namespace cg = cooperative_groups;
constexpr int NWAVES = 8;
#ifndef MK_N_LAUNCHES
#define MK_N_LAUNCHES 1
#endif
constexpr int NPHASE = 14;

constexpr int M = 16384, DMOD = 1024, SEQL = 2048, NBATCH = 8, DFF = 2816, INC = 3072;
constexpr int NMT_UP = 65;

constexpr size_t MiB = 1u << 20;
constexpr size_t WS_CTL = 0, CTL_ZERO_BYTES = 64 * 1024;
constexpr int CW_PANEL = 8192;
constexpr int CW_BAR = 1024;
constexpr size_t WS_IDENT = 128 * 1024;
constexpr size_t WS_SS = 1 * MiB;
constexpr size_t WS_ROPE = 2 * MiB;
constexpr size_t WS_W = 3 * MiB;
constexpr size_t W_IN_OFF = 0, W_OUT_OFF = 6 * MiB, W_UP_OFF = 8 * MiB, W_DOWN_OFF = 19 * MiB, W_LAYER = 24 * MiB + MiB / 2;
constexpr size_t WS_XB = 52 * MiB + MiB / 2;
constexpr size_t WS_PROJ = 85 * MiB;
constexpr size_t WS_ACT = 85 * MiB;
constexpr size_t WS_OB = 181 * MiB;
constexpr size_t WS_MIX = 213 * MiB;
constexpr size_t WS_END = 245 * MiB;
static_assert(WS_W + 2 * W_LAYER <= WS_XB - MiB / 2 && WS_XB + (size_t)M * DMOD * 2 + MiB / 2 <= WS_PROJ && WS_PROJ + (size_t)M * INC * 2 <= WS_OB && WS_ACT + (size_t)M * DFF * 2 <= WS_OB && WS_MIX + (size_t)M * DMOD * 2 <= WS_END, "d_ws map");

constexpr int RING_OFF = 0, RING_BYTES = 131072;
constexpr int DMASK_TBL_OFF = 86016;
constexpr int HALO_OFF = RING_BYTES;
constexpr int MISC_OFF = HALO_OFF + 4096;
constexpr int P0_SCR_BYTES = 64 * 65 * 4;
constexpr int LRSTD_OFF = MISC_OFF + 256;
constexpr int LROPE_OFF = LRSTD_OFF + 1024;
constexpr int LCW_OFF = LROPE_OFF + 16384;
constexpr int LDS_BYTES = 155648;
static_assert(attn_b::LDS_BYTES <= DMASK_TBL_OFF && NWAVES * P0_SCR_BYTES <= MISC_OFF && LCW_OFF + 1536 <= LDS_BYTES && LDS_BYTES <= 163840 && attn_body::ATTN_LDS_BYTES <= DMASK_TBL_OFF && DMASK_TBL_OFF + attn_body::DMASK_TBL_N * 4 <= attn_b::OSTAGE_OFF && attn_b::OSTAGE_OFF + 32768 <= RING_BYTES, "LDS map");

#define GAS __attribute__((address_space(1)))
#define LAS __attribute__((address_space(3)))
typedef unsigned short bf16;
typedef unsigned v4u __attribute__((ext_vector_type(4)));
typedef unsigned v2u __attribute__((ext_vector_type(2)));
typedef float f32x4 __attribute__((ext_vector_type(4)));
#define LDS_WAIT() asm volatile("s_waitcnt lgkmcnt(0)" ::: "memory")
__device__ __forceinline__ unsigned f2bf(float f) { unsigned u = __builtin_bit_cast(unsigned, f); return (u + 0x7fffu + ((u >> 16) & 1u)) >> 16; }
__device__ __forceinline__ unsigned pk2(float lo, float hi) { return f2bf(lo) | (f2bf(hi) << 16); }
__device__ __forceinline__ float bflo(unsigned w) { return __builtin_bit_cast(float, w << 16); }
__device__ __forceinline__ float bfhi(unsigned w) { return __builtin_bit_cast(float, w & 0xffff0000u); }
__device__ __forceinline__ float wave_sum(float v) {
#pragma unroll
    for (int o = 1; o < 64; o <<= 1) v += __shfl_xor(v, o);
    return v;
}

#define XB_TMO      128
#define XB_XCNT(j)  (256  + 64 * (j))
#define XB_XSUB(j)  (1280 + 64 * (j))
#define XB_XGEN(j)  (2304 + 64 * (j))
#define XB_TOP      3328
#define XB_TOPGEN   3392
#define XCD_BAR_WORDS 3456
#define XB_SPIN_CAP (1u << 18)

__device__ __forceinline__ unsigned xb_ld(unsigned* p)              { return __hip_atomic_load(p, __ATOMIC_RELAXED, __HIP_MEMORY_SCOPE_AGENT); }
__device__ __forceinline__ unsigned xb_add(unsigned* p, unsigned v) { return __hip_atomic_fetch_add(p, v, __ATOMIC_RELAXED, __HIP_MEMORY_SCOPE_AGENT); }
__device__ __forceinline__ unsigned xb_xcc_id() { return (unsigned)__builtin_amdgcn_s_getreg((3 << 11) | 20) & 0xFu; }
#define XB_SPIN(cond, bar) do { unsigned _sp = 0; while (cond) { __builtin_amdgcn_s_sleep(1); \
    if ((++_sp & 255u) == 0u) { if (xb_ld(&(bar)[XB_TMO])) break; if (_sp > XB_SPIN_CAP) { atomicAdd(&(bar)[XB_TMO], 1u); break; } } } } while (0)

struct XcdBarrier {
    unsigned* bar; unsigned x;
    volatile LAS unsigned* st;
};

__device__ __forceinline__ XcdBarrier xcd_barrier_post(unsigned* bar, volatile LAS unsigned* st) {
    XcdBarrier b; b.bar = bar; b.x = xb_xcc_id(); b.st = st;
    if (threadIdx.x == 0) (void)xb_add(&bar[XB_XCNT(b.x)], 1u);
    return b;
}
__device__ __forceinline__ void xcd_barrier_complete(unsigned* bar, unsigned x, unsigned& nloc, unsigned& nx) {
    const unsigned G = gridDim.x * gridDim.y * gridDim.z;
    unsigned sum, cnt, mine, sp = 0u;
    for (;;) {
        sum = 0u; cnt = 0u; mine = 0u;
#pragma unroll
        for (unsigned j = 0; j < 16; ++j) { const unsigned c = xb_ld(&bar[XB_XCNT(j)]); sum += c; cnt += (c > 0u) ? 1u : 0u; mine = (j == x) ? c : mine; }
        if (sum == G) break;
        __builtin_amdgcn_s_sleep(1);
        if ((++sp & 255u) == 0u) { if (xb_ld(&bar[XB_TMO])) break; if (sp > XB_SPIN_CAP) { atomicAdd(&bar[XB_TMO], 1u); break; } }
    }
    nloc = mine > 0u ? mine : 1u; nx = cnt > 0u ? cnt : 1u;
}

__device__ __forceinline__ void xcd_barrier(const XcdBarrier& b) {
    asm volatile("s_waitcnt vmcnt(0)" ::: "memory");
    __syncthreads();
    if (threadIdx.x == 0) {
        unsigned* bar = b.bar;
        __builtin_amdgcn_s_waitcnt(0);
        unsigned nloc = b.st[0], nx = b.st[1];
        if (nloc == 0u) { xcd_barrier_complete(bar, b.x, nloc, nx); b.st[0] = nloc; b.st[1] = nx; }
        const unsigned old = xb_add(&bar[XB_XSUB(b.x)], 1u);
        const unsigned gen = old / nloc;
        if (old + 1u == (gen + 1u) * nloc) {
            __builtin_amdgcn_fence(__ATOMIC_RELEASE, "agent");
            asm volatile("s_waitcnt vmcnt(0)" ::: "memory");
            const unsigned og = xb_add(&bar[XB_TOP], 1u);
            const unsigned tg = og / nx;
            if (og + 1u == (tg + 1u) * nx) xb_add(&bar[XB_TOPGEN], 1u);
            else XB_SPIN(xb_ld(&bar[XB_TOPGEN]) == tg, bar);
            __builtin_amdgcn_fence(__ATOMIC_ACQUIRE, "agent");
            xb_add(&bar[XB_XGEN(b.x)], 1u);
            asm volatile("s_waitcnt vmcnt(0)" ::: "memory");
        } else {
            XB_SPIN(xb_ld(&bar[XB_XGEN(b.x)]) == gen, bar);
            __builtin_amdgcn_fence(__ATOMIC_ACQUIRE, "agent");
            asm volatile("s_waitcnt vmcnt(0)" ::: "memory");
        }
    }
    __syncthreads();
}

struct Args { const float* in[16]; float* out; unsigned char* ws; int ph_lo, ph_hi; };
static_assert(sizeof(Args) == 16 * 8 + 8 + 8 + 8, "Args has no padding");

struct Frame {
    LAS unsigned char* lds;
    int tid, lane, wave, vcu, G;
    float* out; unsigned char* ws;
};
__device__ __forceinline__ const float* karg_in(int i) {
    const __attribute__((address_space(4))) char* kp = (const __attribute__((address_space(4))) char*)__builtin_amdgcn_kernarg_segment_ptr();
    asm volatile("" : "+s"(kp));
    return ((const float* const __attribute__((address_space(4)))*)kp)[i];
}

__device__ __forceinline__ void p0_transpose_item(const float* W, int K, int N, bf16* WT, int k0, int n0, int drow0, const float* gain, LAS float* scr, int lane) {
    const int lr = lane >> 4, lc = (lane & 15) * 4;
    f32x4 v[16];
#pragma unroll
    for (int i = 0; i < 16; ++i) v[i] = __builtin_nontemporal_load((const f32x4*)(W + (size_t)(k0 + lr + 4 * i) * N + n0 + lc));
    if (gain) {
#pragma unroll
        for (int i = 0; i < 16; ++i) v[i] = v[i] * gain[k0 + lr + 4 * i];
    }
#pragma unroll
    for (int i = 0; i < 16; ++i) { LAS float* p = scr + (lr + 4 * i) * 65 + lc; p[0] = v[i].x; p[1] = v[i].y; p[2] = v[i].z; p[3] = v[i].w; }
    LDS_WAIT(); asm volatile("" ::: "memory");
    const int c = lane >> 3, nn = lane & 7;
#pragma unroll
    for (int j = 0; j < 8; ++j) { const int n = nn + 8 * j; const LAS float* q = scr + (8 * c) * 65 + n;
        v4u o; o.x = pk2(q[0 * 65], q[1 * 65]); o.y = pk2(q[2 * 65], q[3 * 65]); o.z = pk2(q[4 * 65], q[5 * 65]); o.w = pk2(q[6 * 65], q[7 * 65]);
        *(v4u*)(WT + (size_t)(drow0 + n) * K + k0 + 8 * c) = o; }
    LDS_WAIT(); asm volatile("" ::: "memory");
}
__device__ __forceinline__ int up_dest_row(int n0) { const int half = n0 >= DFF ? 1 : 0, n = n0 - half * DFF; return (n >> 7) * 256 + half * 128 + (n & 127); }

__device__ __forceinline__ void p0_convert_layer(Frame& F, int L, int widx, int nw, int part = 0) {
    { int t_ = threadIdx.x; asm volatile("" : "+v"(t_)); F.tid = t_; F.lane = t_ & 63; }
    LAS float* scr = (LAS float*)(F.lds + RING_OFF + F.wave * P0_SCR_BYTES);
    constexpr int I_IN = (DMOD / 64) * (INC / 64), I_OUT = (DMOD / 64) * (DMOD / 64), I_UP = (DMOD / 64) * (2 * DFF / 64), I_DN = (DFF / 64) * (DMOD / 64);
    constexpr int I_LAYER = I_IN + I_OUT + I_UP + I_DN;
    unsigned char* wl = F.ws + WS_W + (size_t)L * W_LAYER;
    const int it_lo = (part == 2) ? I_IN : 0, it_hi = (part == 1) ? I_IN : I_LAYER;
    for (int it = it_lo + widx; it < it_hi; it += nw) {
        int r = it;
        if (r < I_IN) { const int nb = INC / 64, kb = r / nb, n0 = 64 * (r % nb);
            p0_transpose_item(karg_in(3) + (size_t)L * DMOD * INC, DMOD, INC, (bf16*)(wl + W_IN_OFF), 64 * kb, n0, n0, karg_in(2) + L * DMOD, scr, F.lane); continue; }
        r -= I_IN;
        if (r < I_OUT) { const int nb = DMOD / 64, kb = r / nb, n0 = 64 * (r % nb);
            p0_transpose_item(karg_in(10) + (size_t)L * DMOD * DMOD, DMOD, DMOD, (bf16*)(wl + W_OUT_OFF), 64 * kb, n0, n0, nullptr, scr, F.lane); continue; }
        r -= I_OUT;
        if (r < I_UP) { const int nb = 2 * DFF / 64, kb = r / nb, n0 = 64 * (r % nb);
            p0_transpose_item(karg_in(12) + (size_t)L * DMOD * 2 * DFF, DMOD, 2 * DFF, (bf16*)(wl + W_UP_OFF), 64 * kb, n0, up_dest_row(n0), karg_in(11) + L * DMOD, scr, F.lane); continue; }
        r -= I_UP;
        { const int nb = DMOD / 64, kb = r / nb, n0 = 64 * (r % nb);
            p0_transpose_item(karg_in(14) + (size_t)L * DFF * DMOD, DFF, DMOD, (bf16*)(wl + W_DOWN_OFF), 64 * kb, n0, n0, nullptr, scr, F.lane); }
    }
}

__device__ __forceinline__ void p0_prologue(Frame& F) {
    const int gw = F.vcu * NWAVES + F.wave, NGW = F.G * NWAVES;
    p0_convert_layer(F, 0, gw, NGW, 1);
    bf16* XB = (bf16*)(F.ws + WS_XB); float* SS = (float*)(F.ws + WS_SS);
    for (int m = gw; m < M; m += NGW) {
        const f32x4* xr = (const f32x4*)(karg_in(0) + (size_t)m * DMOD) + F.lane;
        f32x4 v[4]; float s = 0.f;
#pragma unroll
        for (int j = 0; j < 4; ++j) { v[j] = __builtin_nontemporal_load(xr + 64 * j); s += (v[j].x * v[j].x + v[j].y * v[j].y) + (v[j].z * v[j].z + v[j].w * v[j].w); }
        s = wave_sum(s);
        unsigned long long* o8 = (unsigned long long*)(XB + (size_t)m * DMOD) + F.lane;
#pragma unroll
        for (int j = 0; j < 4; ++j) o8[64 * j] = (unsigned long long)pk2(v[j].x, v[j].y) | ((unsigned long long)pk2(v[j].z, v[j].w) << 32);
        if (F.lane < 16) SS[(size_t)m * 16 + F.lane] = (F.lane == 0) ? s : 0.f;
    }
    if (gw == 0 && F.lane < 16) ((float*)(F.ws + WS_IDENT))[F.lane] = F.lane < 8 ? 1.0f : 0.0f;
    const int* pos = (const int*)karg_in(1); float* rope = (float*)(F.ws + WS_ROPE);
    const int gt = (F.vcu * NWAVES + F.wave) * 64 + F.lane, NGT = F.G * NWAVES * 64;
    for (int idx = gt; idx < M * 8; idx += NGT) {
        const int m = idx >> 3, i = idx & 7;
        const double invd = (i == 0) ? 1.0 : (i == 1) ? 0.19392274474868576 : (i == 2) ? 0.03760603093086393 : (i == 3) ? 0.007292664737217109 : (i == 4) ? 0.001414213562373095 :
                            (i == 5) ? 0.0002742481756762073 : (i == 6) ? 5.318295896944988e-05 : 1.031338537721246e-05;
        const double ang = (double)pos[m] * (double)(float)invd;
        const double k = __builtin_rint(ang * 0.15915494309189535);
        const float r = (float)(ang - k * 6.283185307179586);
        rope[(size_t)m * 16 + i] = cosf(r); rope[(size_t)m * 16 + 8 + i] = sinf(r);
    }
}

__device__ __forceinline__ void p_combine(Frame& F, int L) {
    { int t_ = threadIdx.x; asm volatile("" : "+v"(t_)); F.tid = t_; F.lane = t_ & 63; }
    const int gw = F.vcu * NWAVES + F.wave, NGW = F.G * NWAVES, lane = F.lane;
    const float lam_init = 0.8f - 0.6f * expf(-0.3f * (float)L);
    const float d1 = wave_sum(karg_in(4)[L * 64 + lane] * karg_in(5)[L * 64 + lane]), d2 = wave_sum(karg_in(6)[L * 64 + lane] * karg_in(7)[L * 64 + lane]);
    const float lam = expf(d1) - expf(d2) + lam_init, osc = 1.0f - lam_init;
    const bf16* OB = (const bf16*)(F.ws + WS_OB); const bf16* PROJ = (const bf16*)(F.ws + WS_PROJ); bf16* MIX = (bf16*)(F.ws + WS_MIX);
    const int h = lane >> 4, e0 = (lane & 15) * 8, c0 = lane * 4;
    const float* sg = karg_in(8) + L * 128 + e0; const f32x4 g0 = *(const f32x4*)sg, g1 = *(const f32x4*)(sg + 4);
    const float* cw = karg_in(9) + L * 3 * 256 + c0; const f32x4 w0 = *(const f32x4*)cw, w1 = *(const f32x4*)(cw + 256), w2 = *(const f32x4*)(cw + 512);
    constexpr int UR = 4;
    for (int mb = gw; mb < M; mb += UR * NGW) {
        v4u a[UR], b[UR]; v2u cb[UR], cc[UR][3], ch[UR][3]; float f1[UR], f2[UR];
#pragma unroll
        for (int u = 0; u < UR; ++u) {
            const int m = mb + u * NGW, t = m & (SEQL - 1);
            const bf16* ob = OB + (size_t)m * 1024 + h * 256 + e0;
            a[u] = *(const v4u*)ob; b[u] = *(const v4u*)(ob + 128);
            const bf16* pr = PROJ + (size_t)m * INC + c0;
            const int o1 = t >= 1 ? INC : 0, o2 = t >= 2 ? 2 * INC : 0;
            f1[u] = t >= 1 ? 1.f : 0.f; f2[u] = t >= 2 ? 1.f : 0.f;
            cb[u] = *(const v2u*)(pr + 2304);
            cc[u][2] = *(const v2u*)(pr + 2560); ch[u][2] = *(const v2u*)(pr + 2816);
            cc[u][1] = *(const v2u*)(pr - o1 + 2560); ch[u][1] = *(const v2u*)(pr - o1 + 2816);
            cc[u][0] = *(const v2u*)(pr - o2 + 2560); ch[u][0] = *(const v2u*)(pr - o2 + 2816);
        }
#pragma unroll
        for (int u = 0; u < UR; ++u) {
            const int m = mb + u * NGW;
            float o[8];
#pragma unroll
            for (int i = 0; i < 4; ++i) { o[2 * i] = bflo(a[u][i]) - lam * bflo(b[u][i]); o[2 * i + 1] = bfhi(a[u][i]) - lam * bfhi(b[u][i]); }
            float ss = 0.f;
#pragma unroll
            for (int i = 0; i < 8; ++i) ss += o[i] * o[i];
            ss += __shfl_xor(ss, 1); ss += __shfl_xor(ss, 2); ss += __shfl_xor(ss, 4); ss += __shfl_xor(ss, 8);
            const float rs = osc / sqrtf(ss * (1.0f / 128.0f) + 1e-5f);
            v4u w; w.x = pk2(o[0] * rs * g0[0], o[1] * rs * g0[1]); w.y = pk2(o[2] * rs * g0[2], o[3] * rs * g0[3]); w.z = pk2(o[4] * rs * g1[0], o[5] * rs * g1[1]); w.w = pk2(o[6] * rs * g1[2], o[7] * rs * g1[3]);
            *(v4u*)(MIX + (size_t)m * 1024 + 256 + h * 128 + e0) = w;
            f32x4 acc;
            acc[0] = w2[0] * bflo(cc[u][2][0]) * bflo(ch[u][2][0]); acc[1] = w2[1] * bfhi(cc[u][2][0]) * bfhi(ch[u][2][0]); acc[2] = w2[2] * bflo(cc[u][2][1]) * bflo(ch[u][2][1]); acc[3] = w2[3] * bfhi(cc[u][2][1]) * bfhi(ch[u][2][1]);
            { const f32x4 ww = w1 * f1[u];
              acc[0] += ww[0] * bflo(cc[u][1][0]) * bflo(ch[u][1][0]); acc[1] += ww[1] * bfhi(cc[u][1][0]) * bfhi(ch[u][1][0]); acc[2] += ww[2] * bflo(cc[u][1][1]) * bflo(ch[u][1][1]); acc[3] += ww[3] * bfhi(cc[u][1][1]) * bfhi(ch[u][1][1]); }
            { const f32x4 ww = w0 * f2[u];
              acc[0] += ww[0] * bflo(cc[u][0][0]) * bflo(ch[u][0][0]); acc[1] += ww[1] * bfhi(cc[u][0][0]) * bfhi(ch[u][0][0]); acc[2] += ww[2] * bflo(cc[u][0][1]) * bflo(ch[u][0][1]); acc[3] += ww[3] * bfhi(cc[u][0][1]) * bfhi(ch[u][0][1]); }
            v2u oc; oc.x = pk2(bflo(cb[u][0]) * acc[0], bfhi(cb[u][0]) * acc[1]); oc.y = pk2(bflo(cb[u][1]) * acc[2], bfhi(cb[u][1]) * acc[3]);
            *(v2u*)(MIX + (size_t)m * 1024 + 768 + c0) = oc;
        }
    }
}

__device__ __forceinline__ void p_final(Frame& F, float* dst) {
    { int t_ = threadIdx.x; asm volatile("" : "+v"(t_)); F.tid = t_; F.lane = t_ & 63; }
    const int gw = F.vcu * NWAVES + F.wave, NGW = F.G * NWAVES;
    const bf16* XBp = (const bf16*)(F.ws + WS_XB);
    const f32x4* gp = (const f32x4*)karg_in(15) + 2 * F.lane; f32x4 g[4];
#pragma unroll
    for (int j = 0; j < 2; ++j) { g[2 * j] = gp[128 * j]; g[2 * j + 1] = gp[128 * j + 1]; }
    for (int mb = gw; mb < M; mb += 2 * NGW) {
        v4u raw[2][2];
#pragma unroll
        for (int u = 0; u < 2; ++u)
#pragma unroll
            for (int j = 0; j < 2; ++j) raw[u][j] = *((const v4u*)(XBp + (size_t)(mb + u * NGW) * DMOD) + F.lane + 64 * j);
#pragma unroll
        for (int u = 0; u < 2; ++u) {
            f32x4 v[4]; float s = 0.f;
#pragma unroll
            for (int j = 0; j < 2; ++j) { const v4u r = raw[u][j];
                v[2 * j] = (f32x4){bflo(r.x), bfhi(r.x), bflo(r.y), bfhi(r.y)}; v[2 * j + 1] = (f32x4){bflo(r.z), bfhi(r.z), bflo(r.w), bfhi(r.w)}; }
#pragma unroll
            for (int j = 0; j < 4; ++j) s += (v[j].x * v[j].x + v[j].y * v[j].y) + (v[j].z * v[j].z + v[j].w * v[j].w);
            const float rs = 1.0f / sqrtf(wave_sum(s) * (1.0f / DMOD) + 1e-6f);
            f32x4* dr = (f32x4*)(dst + (size_t)(mb + u * NGW) * DMOD) + 2 * F.lane;
#pragma unroll
            for (int j = 0; j < 2; ++j) { dr[128 * j] = v[2 * j] * rs * g[2 * j]; dr[128 * j + 1] = v[2 * j + 1] * rs * g[2 * j + 1]; }
        }
    }
}

__device__ const unsigned short ATT_SCHED[256][8] = {
  {7,2,0,65535,65535,65535,65535,65535},{15,10,8,65535,65535,65535,65535,65535},{6,259,512,65535,65535,65535,65535,65535},{14,267,520,65535,65535,65535,65535,65535},
  {5,1,517,65535,65535,65535,65535,65535},{13,9,525,65535,65535,65535,65535,65535},{251,519,763,65535,65535,65535,65535,65535},{23,18,16,65535,65535,65535,65535,65535},
  {31,26,24,65535,65535,65535,65535,65535},{22,275,528,65535,65535,65535,65535,65535},{30,283,536,65535,65535,65535,65535,65535},{21,17,533,65535,65535,65535,65535,65535},
  {29,25,541,65535,65535,65535,65535,65535},{139,527,651,65535,65535,65535,65535,65535},{39,34,32,65535,65535,65535,65535,65535},{47,42,40,65535,65535,65535,65535,65535},
  {38,291,544,65535,65535,65535,65535,65535},{46,299,552,65535,65535,65535,65535,65535},{37,33,549,65535,65535,65535,65535,65535},{45,41,557,65535,65535,65535,65535,65535},
  {3,535,515,65535,65535,65535,65535,65535},{55,50,48,65535,65535,65535,65535,65535},{63,58,56,65535,65535,65535,65535,65535},{54,307,560,65535,65535,65535,65535,65535},
  {62,315,568,65535,65535,65535,65535,65535},{53,49,565,65535,65535,65535,65535,65535},{61,57,573,65535,65535,65535,65535,65535},{27,543,539,65535,65535,65535,65535,65535},
  {71,66,64,65535,65535,65535,65535,65535},{79,74,72,65535,65535,65535,65535,65535},{70,323,576,65535,65535,65535,65535,65535},{78,331,584,65535,65535,65535,65535,65535},
  {69,65,581,65535,65535,65535,65535,65535},{77,73,589,65535,65535,65535,65535,65535},{83,551,595,65535,65535,65535,65535,65535},{87,82,80,65535,65535,65535,65535,65535},
  {95,90,88,65535,65535,65535,65535,65535},{86,339,592,65535,65535,65535,65535,65535},{94,347,600,65535,65535,65535,65535,65535},{85,81,597,65535,65535,65535,65535,65535},
  {93,89,605,65535,65535,65535,65535,65535},{107,559,619,65535,65535,65535,65535,65535},{103,98,96,65535,65535,65535,65535,65535},{111,106,104,65535,65535,65535,65535,65535},
  {102,355,608,65535,65535,65535,65535,65535},{110,363,616,65535,65535,65535,65535,65535},{101,97,613,65535,65535,65535,65535,65535},{109,105,621,65535,65535,65535,65535,65535},
  {227,567,739,65535,65535,65535,65535,65535},{119,114,112,65535,65535,65535,65535,65535},{127,122,120,65535,65535,65535,65535,65535},{118,371,624,65535,65535,65535,65535,65535},
  {126,379,632,65535,65535,65535,65535,65535},{117,113,629,65535,65535,65535,65535,65535},{125,121,637,65535,65535,65535,65535,65535},{11,575,523,65535,65535,65535,65535,65535},
  {135,130,128,65535,65535,65535,65535,65535},{143,138,136,65535,65535,65535,65535,65535},{134,387,640,65535,65535,65535,65535,65535},{142,395,648,65535,65535,65535,65535,65535},
  {133,129,645,65535,65535,65535,65535,65535},{141,137,653,65535,65535,65535,65535,65535},{179,583,691,65535,65535,65535,65535,65535},{151,146,144,65535,65535,65535,65535,65535},
  {159,154,152,65535,65535,65535,65535,65535},{150,403,656,65535,65535,65535,65535,65535},{158,411,664,65535,65535,65535,65535,65535},{149,145,661,65535,65535,65535,65535,65535},
  {157,153,669,65535,65535,65535,65535,65535},{51,591,563,65535,65535,65535,65535,65535},{167,162,160,65535,65535,65535,65535,65535},{175,170,168,65535,65535,65535,65535,65535},
  {166,419,672,65535,65535,65535,65535,65535},{174,427,680,65535,65535,65535,65535,65535},{165,161,677,65535,65535,65535,65535,65535},{173,169,685,65535,65535,65535,65535,65535},
  {131,599,643,65535,65535,65535,65535,65535},{183,178,176,65535,65535,65535,65535,65535},{191,186,184,65535,65535,65535,65535,65535},{182,435,688,65535,65535,65535,65535,65535},
  {190,443,696,65535,65535,65535,65535,65535},{181,177,693,65535,65535,65535,65535,65535},{189,185,701,65535,65535,65535,65535,65535},{123,607,635,65535,65535,65535,65535,65535},
  {199,194,192,65535,65535,65535,65535,65535},{207,202,200,65535,65535,65535,65535,65535},{198,451,704,65535,65535,65535,65535,65535},{206,459,712,65535,65535,65535,65535,65535},
  {197,193,709,65535,65535,65535,65535,65535},{205,201,717,65535,65535,65535,65535,65535},{187,615,699,65535,65535,65535,65535,65535},{215,210,208,65535,65535,65535,65535,65535},
  {223,218,216,65535,65535,65535,65535,65535},{214,467,720,65535,65535,65535,65535,65535},{222,475,728,65535,65535,65535,65535,65535},{213,209,725,65535,65535,65535,65535,65535},
  {221,217,733,65535,65535,65535,65535,65535},{147,623,659,65535,65535,65535,65535,65535},{231,226,224,65535,65535,65535,65535,65535},{239,234,232,65535,65535,65535,65535,65535},
  {230,483,736,65535,65535,65535,65535,65535},{238,491,744,65535,65535,65535,65535,65535},{229,225,741,65535,65535,65535,65535,65535},{237,233,749,65535,65535,65535,65535,65535},
  {59,631,571,65535,65535,65535,65535,65535},{247,242,240,65535,65535,65535,65535,65535},{255,250,248,65535,65535,65535,65535,65535},{246,499,752,65535,65535,65535,65535,65535},
  {254,507,760,65535,65535,65535,65535,65535},{245,241,757,65535,65535,65535,65535,65535},{253,249,765,65535,65535,65535,65535,65535},{75,639,587,65535,65535,65535,65535,65535},
  {263,258,256,65535,65535,65535,65535,65535},{271,266,264,65535,65535,65535,65535,65535},{262,257,516,65535,65535,65535,65535,65535},{270,265,524,65535,65535,65535,65535,65535},
  {261,534,529,65535,65535,65535,65535,65535},{269,574,569,65535,65535,65535,65535,65535},{163,647,675,65535,65535,65535,65535,65535},{4,260,514,65535,65535,65535,65535,65535},
  {12,268,522,65535,65535,65535,65535,65535},{279,274,272,65535,65535,65535,65535,65535},{287,282,280,65535,65535,65535,65535,65535},{278,273,532,65535,65535,65535,65535,65535},
  {286,281,540,65535,65535,65535,65535,65535},{285,542,537,65535,65535,65535,65535,65535},{277,750,745,65535,65535,65535,65535,65535},{203,655,715,65535,65535,65535,65535,65535},
  {20,276,530,65535,65535,65535,65535,65535},{28,284,538,65535,65535,65535,65535,65535},{295,290,288,65535,65535,65535,65535,65535},{303,298,296,65535,65535,65535,65535,65535},
  {294,289,548,65535,65535,65535,65535,65535},{302,297,556,65535,65535,65535,65535,65535},{301,686,681,65535,65535,65535,65535,65535},{293,710,705,65535,65535,65535,65535,65535},
  {219,663,731,65535,65535,65535,65535,65535},{36,292,546,65535,65535,65535,65535,65535},{44,300,554,65535,65535,65535,65535,65535},{311,306,304,65535,65535,65535,65535,65535},
  {319,314,312,65535,65535,65535,65535,65535},{310,305,564,65535,65535,65535,65535,65535},{318,313,572,65535,65535,65535,65535,65535},{309,590,585,65535,65535,65535,65535,65535},
  {317,630,625,65535,65535,65535,65535,65535},{99,671,611,65535,65535,65535,65535,65535},{52,308,562,65535,65535,65535,65535,65535},{60,316,570,65535,65535,65535,65535,65535},
  {327,322,320,65535,65535,65535,65535,65535},{335,330,328,65535,65535,65535,65535,65535},{326,321,580,65535,65535,65535,65535,65535},{334,329,588,65535,65535,65535,65535,65535},
  {333,638,633,65535,65535,65535,65535,65535},{325,678,673,65535,65535,65535,65535,65535},{67,679,579,65535,65535,65535,65535,65535},{68,324,578,65535,65535,65535,65535,65535},
  {76,332,586,65535,65535,65535,65535,65535},{343,338,336,65535,65535,65535,65535,65535},{351,346,344,65535,65535,65535,65535,65535},{342,337,596,65535,65535,65535,65535,65535},
  {350,345,604,65535,65535,65535,65535,65535},{341,550,545,65535,65535,65535,65535,65535},{349,726,721,65535,65535,65535,65535,65535},{43,687,555,65535,65535,65535,65535,65535},
  {84,340,594,65535,65535,65535,65535,65535},{92,348,602,65535,65535,65535,65535,65535},{359,354,352,65535,65535,65535,65535,65535},{367,362,360,65535,65535,65535,65535,65535},
  {358,353,612,65535,65535,65535,65535,65535},{366,361,620,65535,65535,65535,65535,65535},{365,558,553,65535,65535,65535,65535,65535},{357,670,665,65535,65535,65535,65535,65535},
  {243,695,755,65535,65535,65535,65535,65535},{100,356,610,65535,65535,65535,65535,65535},{108,364,618,65535,65535,65535,65535,65535},{375,370,368,65535,65535,65535,65535,65535},
  {383,378,376,65535,65535,65535,65535,65535},{374,369,628,65535,65535,65535,65535,65535},{382,377,636,65535,65535,65535,65535,65535},{381,606,601,65535,65535,65535,65535,65535},
  {373,702,697,65535,65535,65535,65535,65535},{115,703,627,65535,65535,65535,65535,65535},{116,372,626,65535,65535,65535,65535,65535},{124,380,634,65535,65535,65535,65535,65535},
  {391,386,384,65535,65535,65535,65535,65535},{399,394,392,65535,65535,65535,65535,65535},{390,385,644,65535,65535,65535,65535,65535},{398,393,652,65535,65535,65535,65535,65535},
  {397,526,521,65535,65535,65535,65535,65535},{389,598,593,65535,65535,65535,65535,65535},{35,711,547,65535,65535,65535,65535,65535},{132,388,642,65535,65535,65535,65535,65535},
  {140,396,650,65535,65535,65535,65535,65535},{407,402,400,65535,65535,65535,65535,65535},{415,410,408,65535,65535,65535,65535,65535},{406,401,660,65535,65535,65535,65535,65535},
  {414,409,668,65535,65535,65535,65535,65535},{405,622,617,65535,65535,65535,65535,65535},{413,734,729,65535,65535,65535,65535,65535},{235,719,747,65535,65535,65535,65535,65535},
  {148,404,658,65535,65535,65535,65535,65535},{156,412,666,65535,65535,65535,65535,65535},{423,418,416,65535,65535,65535,65535,65535},{431,426,424,65535,65535,65535,65535,65535},
  {422,417,676,65535,65535,65535,65535,65535},{430,425,684,65535,65535,65535,65535,65535},{421,646,641,65535,65535,65535,65535,65535},{429,758,753,65535,65535,65535,65535,65535},
  {91,727,603,65535,65535,65535,65535,65535},{164,420,674,65535,65535,65535,65535,65535},{172,428,682,65535,65535,65535,65535,65535},{439,434,432,65535,65535,65535,65535,65535},
  {447,442,440,65535,65535,65535,65535,65535},{438,433,692,65535,65535,65535,65535,65535},{446,441,700,65535,65535,65535,65535,65535},{437,582,577,65535,65535,65535,65535,65535},
  {445,614,609,65535,65535,65535,65535,65535},{155,735,667,65535,65535,65535,65535,65535},{180,436,690,65535,65535,65535,65535,65535},{188,444,698,65535,65535,65535,65535,65535},
  {455,450,448,65535,65535,65535,65535,65535},{463,458,456,65535,65535,65535,65535,65535},{454,449,708,65535,65535,65535,65535,65535},{462,457,716,65535,65535,65535,65535,65535},
  {461,654,649,65535,65535,65535,65535,65535},{453,742,737,65535,65535,65535,65535,65535},{195,743,707,65535,65535,65535,65535,65535},{196,452,706,65535,65535,65535,65535,65535},
  {204,460,714,65535,65535,65535,65535,65535},{471,466,464,65535,65535,65535,65535,65535},{479,474,472,65535,65535,65535,65535,65535},{470,465,724,65535,65535,65535,65535,65535},
  {478,473,732,65535,65535,65535,65535,65535},{477,662,657,65535,65535,65535,65535,65535},{469,766,761,65535,65535,65535,65535,65535},{19,751,531,65535,65535,65535,65535,65535},
  {212,468,722,65535,65535,65535,65535,65535},{220,476,730,65535,65535,65535,65535,65535},{487,482,480,65535,65535,65535,65535,65535},{495,490,488,65535,65535,65535,65535,65535},
  {486,481,740,65535,65535,65535,65535,65535},{494,489,748,65535,65535,65535,65535,65535},{485,566,561,65535,65535,65535,65535,65535},{493,718,713,65535,65535,65535,65535,65535},
  {171,759,683,65535,65535,65535,65535,65535},{228,484,738,65535,65535,65535,65535,65535},{236,492,746,65535,65535,65535,65535,65535},{503,498,496,65535,65535,65535,65535,65535},
  {511,506,504,65535,65535,65535,65535,65535},{502,497,756,65535,65535,65535,65535,65535},{510,505,764,65535,65535,65535,65535,65535},{509,518,513,65535,65535,65535,65535,65535},
  {501,694,689,65535,65535,65535,65535,65535},{211,767,723,65535,65535,65535,65535,65535},{244,500,754,65535,65535,65535,65535,65535},{252,508,762,65535,65535,65535,65535,65535},
};

__device__ __forceinline__ attn_b::BlockRef bref(const attn_b::bf16* PROJ, attn_b::bf16* OB, int id) {
    const int qb = id & 7, pr = (id >> 3) & 1, h = (id >> 4) & 3, b = id >> 6;
    attn_b::BlockRef r; const size_t row0 = (size_t)b * SEQL;
    r.Q = PROJ + (row0 + qb * 256) * INC + 768 + h * 128 + pr * 64;
    r.K = PROJ + row0 * INC + 1280 + h * 128 + pr * 64;
    r.V = PROJ + row0 * INC + 1792 + h * 128;
    r.O = OB + (row0 + qb * 256) * 1024 + h * 256 + pr * 128;
    r.P0 = qb * 256;
    return r;
}
__device__ __forceinline__ void p_attention(Frame& F, unsigned char* ldsg, int kind = 0) {
    using abf = attn_body::bf16;
    const abf* PROJ = (const abf*)(F.ws + WS_PROJ); abf* OB = (abf*)(F.ws + WS_OB); abf* MIX = (abf*)(F.ws + WS_MIX);
    { int t_ = threadIdx.x; asm volatile("" : "+v"(t_)); LAS float* tb = (LAS float*)(F.lds + DMASK_TBL_OFF);
      for (int x = t_; x < attn_body::DMASK_TBL_N; x += NWAVES * 64) tb[x] = attn_body::dwl(2047 - x);
      __syncthreads(); }
    const unsigned tbl = (unsigned)(uintptr_t)(ldsg + DMASK_TBL_OFF);
    constexpr int NSL = 8;
    const bool tab = (F.G == 256);
    auto unit_id = [&](int i) -> int { if (tab) return i < NSL ? (int)ATT_SCHED[F.vcu][i] : 0xFFFF; const int id = F.vcu + i * F.G; return id < 768 ? id : 0xFFFF; };
    if (kind != 1) {
        int i = 0, id = unit_id(0);
        while (id != 0xFFFF && id >= 512) id = unit_id(++i);
        if (id != 0xFFFF) {
            attn_b::Seam S; attn_b::BlockRef cur = bref(PROJ, OB, id);
            attn_b::causal_prime(cur, (char*)ldsg, S);
            for (;;) {
                int idn = unit_id(++i);
                while (idn != 0xFFFF && idn >= 512) idn = unit_id(++i);
                const bool last = (idn == 0xFFFF);
                const attn_b::BlockRef nxt = last ? cur : bref(PROJ, OB, idn);
#if defined(PRB_ABL) && PRB_ABL > 0
                if (kind == 2) attn_b::causal_block<PRB_ABL>(cur, nxt, (char*)ldsg, S); else
#endif
                attn_b::causal_block<0>(cur, nxt, (char*)ldsg, S);
                if (last) break;
                cur = nxt;
            }
        }
    }
    if (kind != 2) {
        for (int i = 0;; ++i) {
            const int id = unit_id(i);
            if (id == 0xFFFF) break;
            if (id < 512) continue;
            const int k = id - 512, qb = k & 7, h = (k >> 3) & 3, b = k >> 5;
            attn_body::attn_unit<8, 1>(b, qb, PROJ + h * 64, PROJ + 256 + h * 64, PROJ + 512 + h * 64, MIX + h * 64, 1024, (char*)ldsg, tbl);
        }
    }
}

__global__ void __launch_bounds__(NWAVES * 64, 2) hybrid_fwd(Args args) {
    extern __shared__ __attribute__((aligned(16))) unsigned char lds[];
    Frame F;
    F.lds = (LAS unsigned char*)lds;
    F.tid = threadIdx.x; F.lane = F.tid & 63; F.wave = __builtin_amdgcn_readfirstlane(F.tid >> 6);
    F.G = gridDim.x; { const int bx = blockIdx.x; F.vcu = (F.G % 8 == 0) ? (bx % 8) * (F.G / 8) + bx / 8 : bx; }
    F.out = args.out; F.ws = args.ws;
    const int lo = args.ph_lo, hi = args.ph_hi;
#if MK_N_LAUNCHES == 1
    if (hi > NPHASE) cg::this_grid().sync();
#endif
#if MK_N_LAUNCHES == 1
    for (int u = F.tid; u < 64; u += NWAVES * 64) ((LAS unsigned*)(F.lds + MISC_OFF))[u] = 0u;
    __syncthreads();
    const XcdBarrier bar = xcd_barrier_post((unsigned*)(F.ws + WS_CTL) + CW_BAR, (volatile LAS unsigned*)(F.lds + MISC_OFF) + 8);
#endif
#ifndef DBG_MASK
#define DBG_MASK 0xffffffu
#endif
#define IN(k) (((DBG_MASK >> ((k) > 6 && (k) < 13 ? (k) - 6 : (k))) & 1u) && lo <= (k) && (k) < hi)
#if MK_N_LAUNCHES == 1
#define SEAM(k) do { if (IN(k) && IN((k) + 1)) { xcd_barrier(bar); } } while (0)
#else
#define SEAM(k) do { } while (0)
#endif
    bf16* XB = (bf16*)(F.ws + WS_XB); float* SS = (float*)(F.ws + WS_SS);

#ifndef PRB_P0
#define PRB_P0 0
#endif
#ifndef PRB_IN
#define PRB_IN 0
#endif
#ifndef PRB_ATT
#define PRB_ATT 0
#endif
#ifndef PRB_ATT_KIND
#define PRB_ATT_KIND 0
#endif
#ifndef PRB_CMB
#define PRB_CMB 0
#endif
#ifndef PRB_OUT
#define PRB_OUT 0
#endif
#ifndef PRB_UP
#define PRB_UP 0
#endif
#ifndef PRB_DN
#define PRB_DN 0
#endif
#ifndef PRB_FIN
#define PRB_FIN 0
#endif
#if MK_N_LAUNCHES == 1
#define XSEAM() xcd_barrier(bar)
#else
#define XSEAM() do { } while (0)
#endif
    const bool fuse_final = (MK_N_LAUNCHES == 1) && (F.G == 256) && (PRB_FIN == 0);
    for (int r_ = 0; r_ < PRB_P0; ++r_) { p0_prologue(F); XSEAM(); }
#ifndef TSM
#define TSM 0
#endif
    long long ts_acc = 0;
#define TSA(ty) do { if ((TSM >> (ty)) & 1) ts_acc -= (long long)__builtin_amdgcn_s_memrealtime(); } while (0)
#define TSB(ty) do { if ((TSM >> (ty)) & 1) ts_acc += (long long)__builtin_amdgcn_s_memrealtime(); } while (0)
    TSA(0); if (IN(0)) { p0_prologue(F); } SEAM(0); TSB(0);

#pragma unroll 1
    for (int L = 0; L < 2; ++L) {
        const int pb = 1 + 6 * L;
        TSA(1);
        unsigned char* wl = F.ws + WS_W + (size_t)L * W_LAYER;
        for (int r_ = 0; r_ < ((L == 0) ? 1 + PRB_IN : 1); ++r_) {
        if (r_) XSEAM();
        if (IN(pb)) {
            pg8::Gemm g{XB, (const bf16*)(wl + W_IN_OFF), DMOD, 256}; pg8::StaticOrder S; S.init(M / 256, INC / 256, F.G, (int)blockIdx.x);
            pg8::EpiInProj E{(bf16*)(F.ws + WS_PROJ), SS, (const float*)(F.ws + WS_ROPE), (LAS float*)(F.lds + LRSTD_OFF), (LAS float*)(F.lds + LROPE_OFF)};
            pg8::gemm_phase<pg8::EpiInProj, pg8::StaticOrder, true, true>(F.lds + RING_OFF, g, S, E);
        }
        }
        SEAM(pb);
        TSB(1); TSA(2);
#ifdef TSW_BLK
        if (L == TSW_LAYER) ts_acc -= (long long)__builtin_amdgcn_s_memrealtime();
#endif
        for (int r_ = 0; r_ < ((L == 0) ? 1 + PRB_ATT : 1); ++r_) { if (r_) XSEAM(); if (IN(pb + 1)) { p_attention(F, lds + RING_OFF, (r_ + 1 < ((L == 0) ? 1 + PRB_ATT : 1)) ? PRB_ATT_KIND : 0); } }
#ifdef TSW_BLK
        if (L == TSW_LAYER) ts_acc += (long long)__builtin_amdgcn_s_memrealtime();
#endif
        if (IN(pb + 1) && L == 0) { __syncthreads(); p0_convert_layer(F, 0, F.vcu * NWAVES + F.wave, F.G * NWAVES, 2); }
        SEAM(pb + 1);
        TSB(2); TSA(3);
        for (int r_ = 0; r_ < ((L == 0) ? 1 + PRB_CMB : 1); ++r_) { if (r_) XSEAM(); if (IN(pb + 2)) { p_combine(F, L); } }
        SEAM(pb + 2);
        TSB(3); TSA(4);
        for (int r_ = 0, nr_ = ((L == 0) ? 1 + PRB_OUT : 1); r_ < nr_; ++r_) {
        if (r_) XSEAM();
        if (IN(pb + 3)) {
            pg8::Gemm g{(const bf16*)(F.ws + WS_MIX), (const bf16*)(wl + W_OUT_OFF), DMOD, 256}; pg8::StaticOrder S; S.init(M / 256, DMOD / 256, F.G, (int)blockIdx.x);
            pg8::EpiResid E{XB, (r_ + 1 < nr_) ? (bf16*)(F.ws + WS_PROJ) : XB, SS};
            pg8::gemm_phase<pg8::EpiResid, pg8::StaticOrder, true, true>(F.lds + RING_OFF, g, S, E);
        }
        }
        SEAM(pb + 3);
        TSB(4); TSA(5);
        for (int r_ = 0; r_ < ((L == 0) ? 1 + PRB_UP : 1); ++r_) {
        if (r_) XSEAM();
        if (IN(pb + 4)) {
            pg8::Gemm g{XB - 2 * DMOD, (const bf16*)(wl + W_UP_OFF), DMOD, 254}; pg8::StaticOrder S; S.init(NMT_UP, 2 * DFF / 256, F.G, (int)blockIdx.x);
            pg8::EpiGlu E{(bf16*)(F.ws + WS_ACT), SS, karg_in(13) + (size_t)L * 3 * DFF, (LAS float*)(F.lds + HALO_OFF), (LAS float*)(F.lds + LRSTD_OFF), (LAS float*)(F.lds + LCW_OFF)};
            pg8::gemm_phase<pg8::EpiGlu, pg8::StaticOrder, true, true>(F.lds + RING_OFF, g, S, E);
            if (L == 0 && r_ == 0) { const int nfull = NMT_UP * (2 * DFF / 256) - (NMT_UP * (2 * DFF / 256) / F.G) * F.G;
                if (nfull > 0 && nfull < F.G) { if ((int)blockIdx.x >= nfull) p0_convert_layer(F, 1, ((int)blockIdx.x - nfull) * NWAVES + F.wave, (F.G - nfull) * NWAVES); }
                else p0_convert_layer(F, 1, F.vcu * NWAVES + F.wave, F.G * NWAVES); }
        }
        }
        SEAM(pb + 4);
        TSB(5); TSA(6);
        for (int r_ = 0, nr_ = ((L == 0) ? 1 + PRB_DN : 1); r_ < nr_; ++r_) {
        if (r_) XSEAM();
        if (IN(pb + 5)) {
            pg8::Gemm g{(const bf16*)(F.ws + WS_ACT), (const bf16*)(wl + W_DOWN_OFF), DFF, 256}; pg8::StaticOrder S; S.init(M / 256, DMOD / 256, F.G, (int)blockIdx.x);
            if (L == 1 && r_ + 1 == nr_ && fuse_final) {
                pg8::EpiResidFinal E{XB, F.out, SS, karg_in(15), (unsigned*)(F.ws + WS_CTL) + CW_PANEL, (LAS unsigned*)(F.lds + MISC_OFF) + 20};
                pg8::gemm_phase<pg8::EpiResidFinal, pg8::StaticOrder, true, true>(F.lds + RING_OFF, g, S, E);
            } else {
            pg8::EpiResid E{XB, (r_ + 1 < nr_) ? (bf16*)(F.ws + WS_OB) : XB, SS};
            pg8::gemm_phase<pg8::EpiResid, pg8::StaticOrder, true, true>(F.lds + RING_OFF, g, S, E);
            }
        }
        }
        if (!(L == 1 && fuse_final)) SEAM(pb + 5);
        TSB(6);
    }
    for (int r_ = 0; r_ < PRB_FIN; ++r_) { p_final(F, (float*)(F.ws + WS_OB)); XSEAM(); }
    if (IN(13) && !fuse_final) { p_final(F, F.out); }
#ifndef TSW_BLK
#define TSW_BLK 0
#else
#define TSM_ON 1
#endif
#if TSM != 0 || defined(TSM_ON)
    if (F.vcu == TSW_BLK && F.tid == 0) { const unsigned long long t0 = __builtin_amdgcn_s_memrealtime(); const unsigned long long w = (unsigned long long)(ts_acc > 0 ? ts_acc : 0) * 4ull;
        while (__builtin_amdgcn_s_memrealtime() - t0 < w) __builtin_amdgcn_s_sleep(8); }
#endif
#undef IN
#undef SEAM
}

extern "C" void kernel_launch(void* const* d_in, const int* in_sizes, int n_in, void* d_out, int out_size, void* d_ws, size_t ws_size, hipStream_t stream) {
    static int grid = 0;
    if (grid == 0) {
        if (n_in != 16 || in_sizes[0] != M * DMOD || out_size != M * DMOD || ws_size < WS_END) { fprintf(stderr, "kernel_launch: unexpected shapes (n_in %d, in0 %d, out %d, ws %zu)\n", n_in, n_in > 0 ? in_sizes[0] : -1, out_size, ws_size); grid = -1; return; }
        int dev = 0, cus = 0, per_cu = 0;
        if (hipGetDevice(&dev) != hipSuccess || hipDeviceGetAttribute(&cus, hipDeviceAttributeMultiprocessorCount, dev) != hipSuccess) { grid = -1; return; }
        if (hipFuncSetAttribute((const void*)hybrid_fwd, hipFuncAttributeMaxDynamicSharedMemorySize, LDS_BYTES) != hipSuccess) { fprintf(stderr, "kernel_launch: hipFuncSetAttribute failed\n"); grid = -1; return; }
        if (hipOccupancyMaxActiveBlocksPerMultiprocessor(&per_cu, (const void*)hybrid_fwd, NWAVES * 64, LDS_BYTES) != hipSuccess || per_cu < 1) { fprintf(stderr, "kernel_launch: occupancy query says %d blocks per CU\n", per_cu); per_cu = 1; }
        (void)hipGetLastError();
        grid = cus;
    }
    if (grid < 0) return;
    Args a{};
    for (int i = 0; i < 16; ++i) a.in[i] = (const float*)d_in[i];
    a.out = (float*)d_out; a.ws = (unsigned char*)d_ws;
#if MK_N_LAUNCHES == 1
#ifdef PRB_MEMSET2
    (void)hipMemsetAsync((char*)d_ws + WS_CTL + 512 * 1024, 0, CTL_ZERO_BYTES, stream);
#endif
    if (hipMemsetAsync((char*)d_ws + WS_CTL, 0, CTL_ZERO_BYTES, stream) != hipSuccess) { fprintf(stderr, "kernel_launch: memset of the control words failed\n"); return; }
    a.ph_lo = 0; a.ph_hi = NPHASE;
    void* kargs[] = {&a};
    hipError_t e = hipLaunchCooperativeKernel((const void*)hybrid_fwd, dim3(grid), dim3(NWAVES * 64), kargs, LDS_BYTES, stream);
    if (e != hipSuccess) fprintf(stderr, "kernel_launch: cooperative launch failed: %s (grid %d)\n", hipGetErrorString(e), grid);
#else
    for (int p = 0; p < NPHASE; ++p) {
        a.ph_lo = p; a.ph_hi = p + 1;
        hipLaunchKernelGGL(hybrid_fwd, dim3(grid), dim3(NWAVES * 64), LDS_BYTES, stream, a);
    }
#endif
}
```

```cpp
#include <hip/hip_runtime.h>
#include <hip/hip_cooperative_groups.h>
#include <hip/hip_bf16.h>
#include <cstdio>
#include <cstdint>
#include <cmath>
namespace pg8 {
#define PG8_LAS __attribute__((address_space(3)))
typedef unsigned short bf16_t;
typedef short bf16x8 __attribute__((ext_vector_type(8)));
typedef float f32x4 __attribute__((ext_vector_type(4)));
typedef unsigned u32x4 __attribute__((ext_vector_type(4)));
constexpr int BM = 256, BK = 64, HALF = 128, HTB = HALF * BK * 2  , STAGE_BYTES = 8 * HTB, NXCD = 8, WGM = 8;

__host__ __device__ __forceinline__ int lds_byte(int r, int c) { const int st = (r >> 4) * 2 + (c >> 5), rr = r & 15, cc = c & 31, ob = rr * 64 + cc * 2; return st * 1024 + (ob ^ (((ob >> 9) & 1) << 5)); }
__host__ __device__ __forceinline__ void stage_rc(int b, int& R, int& C) { const int st = b / 1024, sb = b % 1024, swz = sb ^ (((sb >> 9) & 1) << 5); R = (st >> 1) * 16 + swz / 64; C = (st & 1) * 32 + (swz % 64) / 2; }
__host__ __device__ __forceinline__ int perm32(int rho) { const int n = rho >> 4, i = rho & 15; return 8 * (i >> 2) + 4 * n + (i & 3); }

struct Unit { int pm, pn; };
struct Gemm { const bf16_t* A; const bf16_t* Bt; int K; int a_rows; };

struct StaticOrder {
    int nM, nN, nwg, G, c, rot;
    __host__ __device__ void init(int nM_, int nN_, int G_, int c_, int rot_ = 0) { nM = nM_; nN = nN_; nwg = nM * nN; G = G_; c = c_; rot = rot_; }
    __host__ __device__ bool next(int i, Unit& u) const {
        const long L = (long)i * G + (rot ? (c + 8 * i) % G : c); if (L >= nwg) return false;
        int wgid = (int)L; { const int q = nwg / NXCD, r = nwg % NXCD, xcd = wgid % NXCD, off = wgid / NXCD; wgid = (xcd < r ? xcd * (q + 1) : r * (q + 1) + (xcd - r) * q) + off; }
        const int nig = WGM * nN, gid = wgid / nig, fm = gid * WGM, gsz = (nM - fm) < WGM ? (nM - fm) : WGM;
        u.pm = fm + ((wgid % nig) % gsz); u.pn = (wgid % nig) / gsz; return true;
    }
    __device__ __forceinline__ void a_ready(const Unit&) const {}
    __device__ __forceinline__ void done(const Unit&) const {}
};


__device__ __forceinline__ unsigned cvt_pk_bf16(float lo, float hi) { unsigned r; asm volatile("v_cvt_pk_bf16_f32 %0, %1, %2" : "=v"(r) : "v"(lo), "v"(hi)); return r; }
constexpr int MROWS = 16384, DMODEL = 1024;
__device__ __forceinline__ void store16_wt(void* p, u32x4 w, bool wt) {
    if (wt) { asm volatile("global_store_dwordx4 %0, %1, off sc1\n\ts_nop 1" :: "v"(p), "v"(w) : "memory"); }
    else *(u32x4*)p = w;
}
constexpr float QK_C2 = 0.125f * 1.4426950408889634f;

__device__ __forceinline__ f32x4 rstd_load(const float* SS, int row, int fq) { return *(const f32x4*)(SS + (size_t)row * 16 + 4 * fq); }
__device__ __forceinline__ float rstd_finish(f32x4 a) {
    float s = (a[0] + a[1]) + (a[2] + a[3]);
    s += __shfl_xor(s, 16); s += __shfl_xor(s, 32);
    return __builtin_amdgcn_rsqf(s * (1.0f / 1024.0f) + 1e-6f);
}

struct NoPrep { };
struct EpiInProj {
    static constexpr bool PERM = true, AFTER_DRAIN = false, HAS_INIT = false, HAS_PREP = true;
    bf16_t* O; const float* SS; const float* rope;
    PG8_LAS float* lrstd; PG8_LAS float* lrope;
    struct Prep { f32x4 s0, s1, r0, r1; };
    static __device__ __forceinline__ bool tile_rope(int pn) { return (pn <= 1) || (pn >= 3 && pn <= 6); }
    __device__ __forceinline__ void prep_load(Prep& P, const Unit& u, int tid) const {
        asm volatile("" : "+v"(tid));
        const int row = u.pm * BM + (tid >> 1), h = tid & 1;
        const f32x4* sp = (const f32x4*)(SS + (size_t)row * 16 + 8 * h); P.s0 = sp[0]; P.s1 = sp[1];
        const f32x4* rp = (const f32x4*)(rope + (size_t)row * 16 + 8 * h); P.r0 = rp[0]; P.r1 = rp[1];
    }
    __device__ __forceinline__ void prep_store(const Prep& P, const Unit& u, int tid) const {
        asm volatile("" : "+v"(tid));
        float s = ((P.s0[0] + P.s0[1]) + (P.s0[2] + P.s0[3])) + ((P.s1[0] + P.s1[1]) + (P.s1[2] + P.s1[3]));
        s += __shfl_xor(s, 1);
        if ((tid & 1) == 0) lrstd[tid >> 1] = __builtin_amdgcn_rsqf(s * (1.0f / 1024.0f) + 1e-6f);
        PG8_LAS f32x4* d = (PG8_LAS f32x4*)(lrope + (tid >> 1) * 16 + 8 * (tid & 1)); d[0] = P.r0; d[1] = P.r1;
        if (tid < 16) lrope[256 * 16 + tid] = (tid < 8) ? 1.0f : 0.0f;
    }
    __device__ __forceinline__ void operator()(f32x4 (&acc)[2][2][4][2], const Unit& u, const Unit& nxt, bool has_next, int wr, int wc, int fr, int fq, int tid) const {
        Prep P;
        if (has_next) prep_load(P, nxt, tid);
        asm volatile("" : "+v"(fr), "+v"(fq));
        const int pn = u.pn;
        const bool is_q = (pn == 0) || (pn == 3) || (pn == 4);
        const float qs = is_q ? QK_C2 : 1.0f;
        const bool prod = (pn >= 10);
        const bool wrot = tile_rope(pn) && ((wc & 1) == 0);
        const bool lrot = wrot && fq < 2;
        const int rl0 = wr * 64 + fr, row0 = u.pm * BM + rl0, col0 = pn * BM + wc * 32 + 8 * fq, pcol = 2560 + (pn - 10) * 128 + wc * 32 + 8 * fq;
#pragma unroll
        for (int ai = 0; ai < 2; ++ai) {
#pragma unroll
            for (int m = 0; m < 4; ++m) {
                const int rl = rl0 + ai * HALF + m * 16;
                const float rs = lrstd[rl] * qs;
                f32x4 cs = {1.f, 1.f, 1.f, 1.f}, sn = {0.f, 0.f, 0.f, 0.f};
                if (wrot) { asm volatile("");
                    const PG8_LAS f32x4* rp = (const PG8_LAS f32x4*)(lrope + (lrot ? rl : 256) * 16); cs = rp[fq & 1]; sn = rp[2 + (fq & 1)]; }
#pragma unroll
                for (int bj = 0; bj < 2; ++bj) {
                    f32x4 v0 = acc[ai][bj][m][0] * rs, v1 = acc[ai][bj][m][1] * rs;
                    if (bj == 0 && prod) { asm volatile(""); v0 = v0 * (acc[ai][1][m][0] * rs); v1 = v1 * (acc[ai][1][m][1] * rs); }
                    if (wrot) {
                        asm volatile("");
                        const f32x4 y0 = v0 * cs - v1 * sn, y1 = v1 * cs + v0 * sn;
                        v0 = y0; v1 = y1;
                    }
                    u32x4 w; w.x = cvt_pk_bf16(v0[0], v0[1]); w.y = cvt_pk_bf16(v0[2], v0[3]); w.z = cvt_pk_bf16(v1[0], v1[1]); w.w = cvt_pk_bf16(v1[2], v1[3]);
                    if (bj == 0 || !prod) store16_wt(O + (size_t)(row0 + ai * HALF + m * 16) * 3072 + (prod ? pcol : col0 + bj * HALF), w, !has_next);
                }
                if (m & 1) asm volatile("" ::: "memory");
            }
        }
        asm volatile("s_waitcnt lgkmcnt(0)" ::: "memory"); __builtin_amdgcn_s_barrier(); asm volatile("" ::: "memory");
        if (has_next) prep_store(P, nxt, tid);
    }
};

__device__ __forceinline__ void resid_init_load(u32x4 (&raw)[16], const bf16_t* xin, const Unit& u, int wr, int wc, int fr, int fq) {
    const int row0 = u.pm * BM + wr * 64 + fr, col0 = u.pn * BM + wc * 32 + 8 * fq;
#pragma unroll
    for (int ai = 0; ai < 2; ++ai)
#pragma unroll
        for (int m = 0; m < 4; ++m)
#pragma unroll
            for (int bj = 0; bj < 2; ++bj) raw[(ai * 4 + m) * 2 + bj] = *(const u32x4*)(xin + (size_t)(row0 + ai * HALF + m * 16) * DMODEL + col0 + bj * HALF);
}
__device__ __forceinline__ void resid_init_acc(f32x4 (&acc)[2][2][4][2], const u32x4 (&raw)[16]) {
#pragma unroll
    for (int ai = 0; ai < 2; ++ai)
#pragma unroll
        for (int m = 0; m < 4; ++m)
#pragma unroll
            for (int bj = 0; bj < 2; ++bj) { const u32x4 x = raw[(ai * 4 + m) * 2 + bj];
                acc[ai][bj][m][0] = (f32x4){__builtin_bit_cast(float, x.x << 16), __builtin_bit_cast(float, x.x & 0xffff0000u), __builtin_bit_cast(float, x.y << 16), __builtin_bit_cast(float, x.y & 0xffff0000u)};
                acc[ai][bj][m][1] = (f32x4){__builtin_bit_cast(float, x.z << 16), __builtin_bit_cast(float, x.z & 0xffff0000u), __builtin_bit_cast(float, x.w << 16), __builtin_bit_cast(float, x.w & 0xffff0000u)}; }
}

struct EpiResid {
    static constexpr bool PERM = true, AFTER_DRAIN = false, HAS_INIT = true, HAS_PREP = false;
    typedef NoPrep Prep;
    const bf16_t* xin; bf16_t* xo; float* SS;
    __device__ __forceinline__ void init_load(u32x4 (&raw)[16], const Unit& u, int wr, int wc, int fr, int fq) const { resid_init_load(raw, xin, u, wr, wc, fr, fq); }
    __device__ __forceinline__ void init_acc(f32x4 (&acc)[2][2][4][2], const u32x4 (&raw)[16]) const { resid_init_acc(acc, raw); }
    __device__ __forceinline__ void operator()(f32x4 (&acc)[2][2][4][2], const Unit& u, const Unit& nxt, bool has_next, int wr, int wc, int fr, int fq, int tid) const {
        const int row0 = u.pm * BM + wr * 64 + fr, col0 = u.pn * BM + wc * 32 + 8 * fq;
#pragma unroll
        for (int ai = 0; ai < 2; ++ai)
#pragma unroll
            for (int m = 0; m < 4; ++m) {
                const int row = row0 + ai * HALF + m * 16; float ssq = 0.f;
#pragma unroll
                for (int bj = 0; bj < 2; ++bj) {
                    const size_t off = (size_t)row * DMODEL + col0 + bj * HALF;
                    const f32x4 h0 = acc[ai][bj][m][0], h1 = acc[ai][bj][m][1];
                    u32x4 w; w.x = cvt_pk_bf16(h0[0], h0[1]); w.y = cvt_pk_bf16(h0[2], h0[3]); w.z = cvt_pk_bf16(h1[0], h1[1]); w.w = cvt_pk_bf16(h1[2], h1[3]);
                    { const bf16_t* p_ = xo + off; asm volatile("global_store_dwordx4 %0, %1, off sc1\n\ts_nop 1" :: "v"(p_), "v"(w) : "memory"); }
                    ssq += ((h0[0] * h0[0] + h0[1] * h0[1]) + (h0[2] * h0[2] + h0[3] * h0[3])) + ((h1[0] * h1[0] + h1[1] * h1[1]) + (h1[2] * h1[2] + h1[3] * h1[3]));
                }
                ssq += __shfl_xor(ssq, 16); ssq += __shfl_xor(ssq, 32);
                if (fq == 0) SS[(size_t)row * 16 + u.pn * 4 + wc] = ssq;
            }
    }
};

struct EpiResidFinal {
    static constexpr bool PERM = true, AFTER_DRAIN = false, HAS_INIT = true, HAS_PREP = false;
    typedef NoPrep Prep;
    const bf16_t* xin; float* out; float* SS; const float* g; unsigned* cnt; PG8_LAS unsigned* flag;
    __device__ __forceinline__ void init_load(u32x4 (&raw)[16], const Unit& u, int wr, int wc, int fr, int fq) const { resid_init_load(raw, xin, u, wr, wc, fr, fq); }
    __device__ __forceinline__ void init_acc(f32x4 (&acc)[2][2][4][2], const u32x4 (&raw)[16]) const { resid_init_acc(acc, raw); }
    __device__ __forceinline__ void operator()(f32x4 (&acc)[2][2][4][2], const Unit& u, const Unit& nxt, bool has_next, int wr, int wc, int fr, int fq, int tid) const {
        const int row0 = u.pm * BM + wr * 64 + fr, col0 = u.pn * BM + wc * 32 + 8 * fq;
#pragma unroll
        for (int ai = 0; ai < 2; ++ai) {
#pragma unroll
            for (int m = 0; m < 4; ++m) {
                const int row = row0 + ai * HALF + m * 16; float ssq = 0.f;
#pragma unroll
                for (int bj = 0; bj < 2; ++bj) {
                    const f32x4 h0 = acc[ai][bj][m][0], h1 = acc[ai][bj][m][1];
                    ssq += ((h0[0] * h0[0] + h0[1] * h0[1]) + (h0[2] * h0[2] + h0[3] * h0[3])) + ((h1[0] * h1[0] + h1[1] * h1[1]) + (h1[2] * h1[2] + h1[3] * h1[3]));
                }
                ssq += __shfl_xor(ssq, 16); ssq += __shfl_xor(ssq, 32);
                if (fq == 0) __hip_atomic_store(SS + (size_t)row * 16 + u.pn * 4 + wc, ssq, __ATOMIC_RELAXED, __HIP_MEMORY_SCOPE_AGENT);
            }
        }
        asm volatile("s_waitcnt vmcnt(0)" ::: "memory");
        __builtin_amdgcn_s_barrier(); asm volatile("" ::: "memory");
        if (wr == 0 && wc == 0 && fr == 0 && fq == 0) {
            __hip_atomic_fetch_add(cnt + 64 * u.pm, 1u, __ATOMIC_RELAXED, __HIP_MEMORY_SCOPE_AGENT);
            unsigned spins = 0;
            while (__hip_atomic_load(cnt + 64 * u.pm, __ATOMIC_RELAXED, __HIP_MEMORY_SCOPE_AGENT) < 4u) { __builtin_amdgcn_s_sleep(2); if (++spins > (1u << 22)) break; }
            __builtin_amdgcn_fence(__ATOMIC_ACQUIRE, "agent");
            asm volatile("s_waitcnt vmcnt(0)" ::: "memory");
            flag[0] = 1u;
        }
        asm volatile("s_waitcnt lgkmcnt(0)" ::: "memory"); __builtin_amdgcn_s_barrier(); asm volatile("" ::: "memory");
        f32x4 part[2][4];
#pragma unroll
        for (int ai = 0; ai < 2; ++ai)
#pragma unroll
            for (int m = 0; m < 4; ++m) { float* sp = SS + (size_t)(row0 + ai * HALF + m * 16) * 16 + 4 * fq;
#pragma unroll
                for (int j = 0; j < 4; ++j) part[ai][m][j] = __hip_atomic_load(sp + j, __ATOMIC_RELAXED, __HIP_MEMORY_SCOPE_AGENT); }
        f32x4 gv[2][2];
#pragma unroll
        for (int bj = 0; bj < 2; ++bj) { gv[bj][0] = *(const f32x4*)(g + col0 + bj * HALF); gv[bj][1] = *(const f32x4*)(g + col0 + bj * HALF + 4); }
#pragma unroll
        for (int ai = 0; ai < 2; ++ai)
#pragma unroll
            for (int m = 0; m < 4; ++m) {
                const float rs = rstd_finish(part[ai][m]);
                float* rowp = out + (size_t)(row0 + ai * HALF + m * 16) * DMODEL + col0;
#pragma unroll
                for (int bj = 0; bj < 2; ++bj) { *(f32x4*)(rowp + bj * HALF) = acc[ai][bj][m][0] * rs * gv[bj][0]; *(f32x4*)(rowp + bj * HALF + 4) = acc[ai][bj][m][1] * rs * gv[bj][1]; }
            }
    }
};

template <int N> __device__ __forceinline__ float dpp_ror(float v) { return __builtin_bit_cast(float, __builtin_amdgcn_mov_dpp(__builtin_bit_cast(int, v), 0x120 + N, 0xf, 0xf, true)); }

template <int N> __device__ __forceinline__ void fmac_row_shr(float& d, float s, float w) { asm("v_fmac_f32_dpp %0, %1, %2 row_shr:%3 row_mask:0xf bank_mask:0xf bound_ctrl:0" : "+v"(d) : "v"(s), "v"(w), "n"(N)); }
template <int N> __device__ __forceinline__ void fmac_row_shl(float& d, float s, float w) { asm("v_fmac_f32_dpp %0, %1, %2 row_shl:%3 row_mask:0xf bank_mask:0xf bound_ctrl:0" : "+v"(d) : "v"(s), "v"(w), "n"(N)); }

template <bool B> struct BoolC { static constexpr bool value = B; };
struct EpiGlu {
    static constexpr bool PERM = true, AFTER_DRAIN = false, HAS_INIT = false, HAS_PREP = true;
    bf16_t* ACT; const float* SS; const float* cw;
    PG8_LAS float* halo;
    PG8_LAS float* lrstd;
    PG8_LAS float* lcw;
    struct Prep { f32x4 s0, s1, w; };
    __device__ __forceinline__ void prep_load(Prep& P, const Unit& u, int tid) const {
        asm volatile("" : "+v"(tid));
        int row = u.pm * 254 - 2 + (tid >> 1); row = row < 0 ? 0 : (row >= MROWS ? MROWS - 1 : row);
        const f32x4* sp = (const f32x4*)(SS + (size_t)row * 16 + 8 * (tid & 1)); P.s0 = sp[0]; P.s1 = sp[1];
        if (tid < 96) P.w = *(const f32x4*)(cw + (tid >> 5) * 2816 + u.pn * 128 + 4 * (tid & 31));
    }
    __device__ __forceinline__ void prep_store(const Prep& P, const Unit& u, int tid) const {
        asm volatile("" : "+v"(tid));
        float s = ((P.s0[0] + P.s0[1]) + (P.s0[2] + P.s0[3])) + ((P.s1[0] + P.s1[1]) + (P.s1[2] + P.s1[3]));
        s += __shfl_xor(s, 1);
        if ((tid & 1) == 0) lrstd[tid >> 1] = __builtin_amdgcn_rsqf(s * (1.0f / 1024.0f) + 1e-6f);
        if (tid < 96) *(PG8_LAS f32x4*)(lcw + 4 * tid) = P.w * (-1.4426950408889634f);
    }
    __device__ __forceinline__ void operator()(f32x4 (&acc)[2][2][4][2], const Unit& u, const Unit& nxt, bool has_next, int wr, int wc, int fr, int fq, int tid) const {
        const int lane = fr + 16 * fq;
        const int grow0 = u.pm * 254 - 2;
        const int cl = wc * 32 + 8 * fq;
        const int hcol = u.pn * 128 + cl;
#pragma unroll
        for (int ai = 0; ai < 2; ++ai)
#pragma unroll
            for (int m = 0; m < 4; ++m) {
                const float rs = lrstd[ai * HALF + wr * 64 + m * 16 + fr];
                const float ru = rs * (-0.6931471805599453f);
                acc[ai][0][m][0] = acc[ai][0][m][0] * rs; acc[ai][0][m][1] = acc[ai][0][m][1] * rs; acc[ai][1][m][0] = acc[ai][1][m][0] * ru; acc[ai][1][m][1] = acc[ai][1][m][1] * ru;
            }
        const f32x4 w0a = *(const PG8_LAS f32x4*)(lcw + cl), w0b = *(const PG8_LAS f32x4*)(lcw + cl + 4);
        const f32x4 w1a = *(const PG8_LAS f32x4*)(lcw + 128 + cl), w1b = *(const PG8_LAS f32x4*)(lcw + 128 + cl + 4);
        const f32x4 w2a = *(const PG8_LAS f32x4*)(lcw + 256 + cl), w2b = *(const PG8_LAS f32x4*)(lcw + 256 + cl + 4);
        if (fr >= 14) {
#pragma unroll
            for (int ai = 0; ai < 2; ++ai) { PG8_LAS float* hp = halo + ((2 * ai + wr) * 2 + (fr - 14)) * 128 + cl;
                *(PG8_LAS f32x4*)hp = acc[ai][0][3][0]; *(PG8_LAS f32x4*)(hp + 4) = acc[ai][0][3][1]; }
        }
        asm volatile("s_waitcnt lgkmcnt(0)" ::: "memory"); __builtin_amdgcn_s_barrier(); asm volatile("" ::: "memory");
        Prep P;
        const bool has_start = (((grow0 + 255) >> 11) << 11) >= grow0 - 1;
        auto conv = [&](auto MASKC) {
        constexpr bool MASK = decltype(MASKC)::value;
#pragma unroll
        for (int ai = 0; ai < 2; ++ai) {
            if (ai == 1 && has_next) prep_load(P, nxt, tid);
            const int q = 2 * ai + wr;
            f32x4 pv0 = {0.f, 0.f, 0.f, 0.f}, pv1 = pv0;
            if (fr >= 14 && q > 0) { const PG8_LAS float* hp = halo + ((q - 1) * 2 + (fr - 14)) * 128 + cl; pv0 = *(const PG8_LAS f32x4*)hp; pv1 = *(const PG8_LAS f32x4*)(hp + 4); }
#pragma unroll
            for (int m = 0; m < 4; ++m) {
                const int rl = ai * HALF + wr * 64 + m * 16 + fr, grow = grow0 + rl;
                const int tpos = grow & 2047;
                const float f1 = (tpos >= 1) ? 1.0f : 0.0f, f2 = (tpos >= 2) ? 1.0f : 0.0f;
                const f32x4 gp0 = (m == 0) ? pv0 : acc[ai][0][m - 1][0], gp1 = (m == 0) ? pv1 : acc[ai][0][m - 1][1];
                f32x4 r0, r1;
#pragma unroll
                for (int j = 0; j < 4; ++j) {
                    { const float cur = acc[ai][0][m][0][j];
                      float t = w2a[j] * cur;
                      if constexpr (MASK) {
                          const float w1e = w1a[j] * f1, w0e = w0a[j] * f2;
                          fmac_row_shr<1>(t, cur, w1e); fmac_row_shl<15>(t, gp0[j], w1e); fmac_row_shr<2>(t, cur, w0e); fmac_row_shl<14>(t, gp0[j], w0e);
                      } else {
                          fmac_row_shr<1>(t, cur, w1a[j]); fmac_row_shl<15>(t, gp0[j], w1a[j]); fmac_row_shr<2>(t, cur, w0a[j]); fmac_row_shl<14>(t, gp0[j], w0a[j]);
                      }
                      float sg = __builtin_amdgcn_rcpf(1.0f + __builtin_amdgcn_exp2f(t)); asm("" : "+v"(sg));
                      r0[j] = (t * sg) * acc[ai][1][m][0][j]; }
                    { const float cur = acc[ai][0][m][1][j];
                      float t = w2b[j] * cur;
                      if constexpr (MASK) {
                          const float w1e = w1b[j] * f1, w0e = w0b[j] * f2;
                          fmac_row_shr<1>(t, cur, w1e); fmac_row_shl<15>(t, gp1[j], w1e); fmac_row_shr<2>(t, cur, w0e); fmac_row_shl<14>(t, gp1[j], w0e);
                      } else {
                          fmac_row_shr<1>(t, cur, w1b[j]); fmac_row_shl<15>(t, gp1[j], w1b[j]); fmac_row_shr<2>(t, cur, w0b[j]); fmac_row_shl<14>(t, gp1[j], w0b[j]);
                      }
                      float sg = __builtin_amdgcn_rcpf(1.0f + __builtin_amdgcn_exp2f(t)); asm("" : "+v"(sg));
                      r1[j] = (t * sg) * acc[ai][1][m][1][j]; }
                }
                if (rl >= 2 && grow < MROWS) {
                    u32x4 w; w.x = cvt_pk_bf16(r0[0], r0[1]); w.y = cvt_pk_bf16(r0[2], r0[3]); w.z = cvt_pk_bf16(r1[0], r1[1]); w.w = cvt_pk_bf16(r1[2], r1[3]);
                    *(u32x4*)(ACT + (size_t)grow * 2816 + hcol) = w;
                }
            }
        }
        };
        if (has_start) conv(BoolC<true>{}); else conv(BoolC<false>{});
        if (has_next) prep_store(P, nxt, tid);
    }
};
template <class Epi, class Sched, bool ALIGN_EPI = false, bool SP2 = false>
__device__ __forceinline__ void gemm_phase(PG8_LAS unsigned char* lds, const Gemm g, const Sched& S, const Epi& E) {
    int tid_ = threadIdx.x; asm volatile("" : "+v"(tid_));
    const int tid = tid_, wid = __builtin_amdgcn_readfirstlane(tid >> 6), lane = tid & 63, wr = wid >> 2, wc = wid & 3, fr = lane & 15, fq = lane >> 4;
    const int K = g.K, nt = K / BK;
    unsigned voffA[2], voffB[2];
#pragma unroll
    for (int i = 0; i < 2; ++i) { int R, C; stage_rc(tid * 16 + i * 8192, R, C); const int Rb = Epi::PERM ? ((R & ~31) + perm32(R & 31)) : R;
        voffA[i] = (unsigned)(R * K + C) * 2u; voffB[i] = (unsigned)(Rb * K + C) * 2u; }
    const size_t kstep = (size_t)(BK * 2);
    const size_t hstep = (size_t)HALF * K * 2;
    const size_t tstep = 2 * hstep;
    const size_t tstepA = (size_t)g.a_rows * K * 2;
    const unsigned ldsw = (unsigned)wid * 1024u;
    const int aoff = lds_byte(wr * 64 + fr, fq * 8), boff = lds_byte(wc * 32 + fr, fq * 8);
#define PG8_SA(b, h) (((b) * 2 + (h)) * HTB)
#define PG8_SB(b, h) ((4 + (b) * 2 + (h)) * HTB)
#define PG8_STAGE(bufoff, gbase, voff) do { _Pragma("unroll") for (int _i = 0; _i < 2; ++_i) \
        __builtin_amdgcn_global_load_lds((const unsigned*)((const char*)(gbase) + (voff)[_i]), (PG8_LAS unsigned*)(lds + (bufoff) + ldsw + _i * 8192), 16, 0, 0); } while (0)
#define PG8_LDA(dst, b, h) do { _Pragma("unroll") for (int m = 0; m < 4; ++m) _Pragma("unroll") for (int k = 0; k < 2; ++k) dst[m][k] = *(const PG8_LAS bf16x8*)(lds + PG8_SA(b, h) + aoff + m * 2048 + k * 1024); } while (0)
#define PG8_LDB(dst, b, h) do { _Pragma("unroll") for (int n = 0; n < 2; ++n) _Pragma("unroll") for (int k = 0; k < 2; ++k) dst[n][k] = *(const PG8_LAS bf16x8*)(lds + PG8_SB(b, h) + boff + n * 2048 + k * 1024); } while (0)
#define PG8_MMA(ai, bj, At, Bt) do { __builtin_amdgcn_s_setprio(1); _Pragma("unroll") for (int m = 0; m < 4; ++m) _Pragma("unroll") for (int n = 0; n < 2; ++n) _Pragma("unroll") for (int k = 0; k < 2; ++k) \
        acc[ai][bj][m][n] = __builtin_amdgcn_mfma_f32_16x16x32_bf16(Bt[n][k], At[m][k], acc[ai][bj][m][n], 0, 0, 0); __builtin_amdgcn_s_setprio(0); } while (0)
#define PG8_WAIT_V(n) asm volatile("s_waitcnt vmcnt(" #n ")" ::: "memory")
#define PG8_WAIT_L(n) asm volatile("s_waitcnt lgkmcnt(" #n ")" ::: "memory")
#define PG8_BAR __builtin_amdgcn_s_barrier()
#define PG8_SCHED __builtin_amdgcn_sched_barrier(0)
    Unit cur, nxt; int ui = 0;
    if (!S.next(0, cur)) return;
    f32x4 acc[2][2][4][2];
    u32x4 iraw[Epi::HAS_INIT ? 16 : 1];
    if constexpr (Epi::HAS_INIT) E.init_load(iraw, cur, wr, wc, fr, fq);
    typename Epi::Prep prep;
    if constexpr (Epi::HAS_PREP) E.prep_load(prep, cur, tid);
    bf16x8 At[4][2], B0[2][2], B1[2][2];
    const char* cA = (const char*)g.A + (size_t)cur.pm * tstepA; const char* cB = (const char*)g.Bt + (size_t)cur.pn * tstep;
    S.a_ready(cur);
    if constexpr (SP2) {
        PG8_STAGE(PG8_SB(0, 0), cB, voffB); PG8_STAGE(PG8_SB(0, 1), cB + hstep, voffB); PG8_STAGE(PG8_SA(0, 0), cA, voffA); PG8_STAGE(PG8_SA(0, 1), cA + hstep, voffA);
        PG8_STAGE(PG8_SB(1, 0), cB + kstep, voffB); PG8_STAGE(PG8_SA(1, 0), cA + kstep, voffA); PG8_STAGE(PG8_SB(1, 1), cB + hstep + kstep, voffB);
        if (wr == 1) PG8_BAR;
        PG8_WAIT_V(8); PG8_BAR;
        PG8_WAIT_V(6); PG8_BAR;
    } else {
        PG8_STAGE(PG8_SB(0, 0), cB, voffB); PG8_STAGE(PG8_SA(0, 0), cA, voffA); PG8_STAGE(PG8_SB(0, 1), cB + hstep, voffB); PG8_STAGE(PG8_SA(0, 1), cA + hstep, voffA);
        if (wr == 1) PG8_BAR;
        PG8_WAIT_V(4); PG8_BAR;
        PG8_STAGE(PG8_SB(1, 0), cB + kstep, voffB); PG8_STAGE(PG8_SA(1, 0), cA + kstep, voffA); PG8_STAGE(PG8_SB(1, 1), cB + hstep + kstep, voffB);
        PG8_WAIT_V(6); PG8_BAR;
    }
    if constexpr (Epi::HAS_PREP) E.prep_store(prep, cur, tid);
    if constexpr (Epi::HAS_INIT) { E.init_acc(acc, iraw); }
    else {
#pragma unroll
        for (int a = 0; a < 2; ++a)
#pragma unroll
            for (int b = 0; b < 2; ++b)
#pragma unroll
                for (int m = 0; m < 4; ++m)
#pragma unroll
                    for (int n = 0; n < 2; ++n) acc[a][b][m][n] = (f32x4){0.f, 0.f, 0.f, 0.f};
    }
    for (;;) {
        const bool has_next = S.next(ui + 1, nxt);
        const char* nA = has_next ? (const char*)g.A + (size_t)nxt.pm * tstepA : cA; const char* nB = has_next ? (const char*)g.Bt + (size_t)nxt.pn * tstep : cB;
        for (int t = 0; t < nt; t += 2) {
            const bool last = (t == nt - 2);
            const char* a1 = cA + (size_t)(t + 1) * kstep;
            const char* a2 = last ? nA : cA + (size_t)(t + 2) * kstep; const char* b2 = last ? nB : cB + (size_t)(t + 2) * kstep;
            const char* a3 = a2 + kstep; const char* b3 = b2 + kstep;
            if (last && has_next) S.a_ready(nxt);
            if constexpr (SP2) {
            PG8_LDB(B0, 0, 0); PG8_LDB(B1, 0, 1); PG8_SCHED; PG8_LDA(At, 0, 0); PG8_STAGE(PG8_SA(1, 1), a1 + hstep, voffA);
            PG8_WAIT_V(8); PG8_WAIT_L(0); PG8_BAR; PG8_MMA(0, 0, At, B0); PG8_MMA(0, 1, At, B1); PG8_BAR; PG8_SCHED;
            PG8_LDA(At, 0, 1); PG8_STAGE(PG8_SB(0, 0), b2, voffB); PG8_STAGE(PG8_SB(0, 1), b2 + hstep, voffB); PG8_STAGE(PG8_SA(0, 0), a2, voffA);
            PG8_WAIT_V(8); PG8_WAIT_L(0); PG8_BAR; PG8_MMA(1, 0, At, B0); PG8_MMA(1, 1, At, B1); PG8_BAR; PG8_SCHED;
            PG8_LDB(B0, 1, 0); PG8_LDB(B1, 1, 1); PG8_SCHED; PG8_LDA(At, 1, 0); PG8_STAGE(PG8_SA(0, 1), a2 + hstep, voffA);
            PG8_WAIT_V(8); PG8_WAIT_L(0); PG8_BAR; PG8_MMA(0, 0, At, B0); PG8_MMA(0, 1, At, B1); PG8_BAR; PG8_SCHED;
            PG8_LDA(At, 1, 1); PG8_STAGE(PG8_SB(1, 0), b3, voffB); PG8_STAGE(PG8_SB(1, 1), b3 + hstep, voffB); PG8_STAGE(PG8_SA(1, 0), a3, voffA);
            PG8_WAIT_V(8); PG8_WAIT_L(0); PG8_BAR; PG8_MMA(1, 0, At, B0); PG8_MMA(1, 1, At, B1); PG8_BAR; PG8_SCHED;
            } else {
            PG8_LDB(B0, 0, 0); PG8_SCHED; PG8_LDA(At, 0, 0); PG8_STAGE(PG8_SA(1, 1), a1 + hstep, voffA);
            PG8_WAIT_L(8); PG8_BAR; PG8_WAIT_L(0); PG8_MMA(0, 0, At, B0); PG8_BAR; PG8_SCHED;
            PG8_LDB(B1, 0, 1); PG8_STAGE(PG8_SB(0, 0), b2, voffB);
            PG8_BAR; PG8_WAIT_L(0); PG8_MMA(0, 1, At, B1); PG8_BAR;
            PG8_LDA(At, 0, 1); PG8_STAGE(PG8_SA(0, 0), a2, voffA);
            PG8_BAR; PG8_WAIT_L(0); PG8_MMA(1, 0, At, B0); PG8_BAR; PG8_SCHED;
            PG8_STAGE(PG8_SB(0, 1), b2 + hstep, voffB);
            PG8_WAIT_V(6); PG8_BAR; PG8_MMA(1, 1, At, B1); PG8_BAR;
            PG8_LDB(B0, 1, 0); PG8_SCHED; PG8_LDA(At, 1, 0); PG8_STAGE(PG8_SA(0, 1), a2 + hstep, voffA);
            PG8_WAIT_L(8); PG8_BAR; PG8_WAIT_L(0); PG8_MMA(0, 0, At, B0); PG8_BAR; PG8_SCHED;
            PG8_LDB(B1, 1, 1); PG8_STAGE(PG8_SB(1, 0), b3, voffB);
            PG8_BAR; PG8_WAIT_L(0); PG8_MMA(0, 1, At, B1); PG8_BAR;
            PG8_LDA(At, 1, 1); PG8_STAGE(PG8_SA(1, 0), a3, voffA);
            PG8_BAR; PG8_WAIT_L(0); PG8_MMA(1, 0, At, B0); PG8_BAR; PG8_SCHED;
            PG8_STAGE(PG8_SB(1, 1), b3 + hstep, voffB);
            PG8_WAIT_V(6); PG8_BAR; PG8_MMA(1, 1, At, B1); PG8_BAR;
            }
        }
        if constexpr (ALIGN_EPI) { if (wr == 0) PG8_BAR; }
#ifdef PRB_EPITIME
        const unsigned long long te0_ = __builtin_amdgcn_s_memrealtime();
#endif
        if constexpr (!Epi::AFTER_DRAIN) { E(acc, cur, nxt, has_next, wr, wc, fr, fq, tid); S.done(cur); }
#ifdef PRB_EPITIME
        if (tid == 0) { volatile PG8_LAS unsigned* w_ = (volatile PG8_LAS unsigned*)(lds + 135168); w_[44 + w_[43]] += (unsigned)(__builtin_amdgcn_s_memrealtime() - te0_); }
#endif
        if (!has_next) break;
        if constexpr (Epi::HAS_INIT) { E.init_load(iraw, nxt, wr, wc, fr, fq); E.init_acc(acc, iraw); }
        else {
#pragma unroll
        for (int a = 0; a < 2; ++a)
#pragma unroll
            for (int b = 0; b < 2; ++b)
#pragma unroll
                for (int m = 0; m < 4; ++m)
#pragma unroll
                    for (int n = 0; n < 2; ++n) acc[a][b][m][n] = (f32x4){0.f, 0.f, 0.f, 0.f};
        }
        cur = nxt; cA = nA; cB = nB; ++ui;
        if constexpr (ALIGN_EPI) { if (wr == 1) PG8_BAR; }
    }
    PG8_WAIT_V(0);
    if constexpr (!ALIGN_EPI) { if (wr == 0) PG8_BAR; }
    PG8_BAR;
    if constexpr (Epi::AFTER_DRAIN) { E.fused(acc, cur, wr, wc, fr, fq, lds, wid, lane); S.done(cur); }
#undef PG8_SA
#undef PG8_SB
#undef PG8_STAGE
#undef PG8_LDA
#undef PG8_LDB
#undef PG8_MMA
#undef PG8_WAIT_V
#undef PG8_WAIT_L
#undef PG8_BAR
#undef PG8_SCHED
}
}
namespace attn_body {
using bf16=__hip_bfloat16;
using bf16x8=__attribute__((ext_vector_type(8)))short;
using s16x4=__attribute__((ext_vector_type(4)))short;
using f32x16=__attribute__((ext_vector_type(16)))float;
using u32x4=__attribute__((ext_vector_type(4)))unsigned;
constexpr int BATCH=8,SEQ=2048,D=64,DM=3072;
constexpr int NW=8,QBLK=32,QB=QBLK*NW,KVBLK=64,NQB=SEQ/QB;
constexpr int ATTN_UNIT_ROWS=QB;
__device__ __forceinline__ int crow(int r,int hi){return (r&3)+8*(r>>2)+4*hi;}
#define SBAR() __builtin_amdgcn_sched_barrier(0)
__device__ __forceinline__ void cmask(f32x16&p0,f32x16&p1,int jb,int qrel,int hi){
  const float NEG=-INFINITY; int kb=64*jb+4*hi;
  #pragma unroll
  for(int r=0;r<16;++r){int kv=kb+(r&3)+8*(r>>2); if(kv>qrel)p0[r]=NEG; if(kv+32>qrel)p1[r]=NEG;}
}

__device__ __forceinline__ float dwl(int d){
  const int w=(int)(d<=128)+(int)(((d&3)==0)&&(d<=512))+(int)((d&15)==0);
  const float a=(w==0)?-INFINITY:(w==1)?0.f:(w==2)?1.f:1.5849625007f;
  return d<0?-INFINITY:a;
}
typedef __attribute__((address_space(3))) const float* ldsf_cptr;
typedef float f32x2m __attribute__((ext_vector_type(2)));
constexpr int DMASK_TBL_N=2368;
#define DMASK_BATCH(o_) asm volatile("ds_read2_b32 %0, %8 offset0:" #o_ "+0 offset1:" #o_ "+1\n\tds_read2_b32 %1, %8 offset0:" #o_ "+2 offset1:" #o_ "+3\n\t" \
      "ds_read2_b32 %2, %8 offset0:" #o_ "+8 offset1:" #o_ "+9\n\tds_read2_b32 %3, %8 offset0:" #o_ "+10 offset1:" #o_ "+11\n\t" \
      "ds_read2_b32 %4, %8 offset0:" #o_ "+16 offset1:" #o_ "+17\n\tds_read2_b32 %5, %8 offset0:" #o_ "+18 offset1:" #o_ "+19\n\t" \
      "ds_read2_b32 %6, %8 offset0:" #o_ "+24 offset1:" #o_ "+25\n\tds_read2_b32 %7, %8 offset0:" #o_ "+26 offset1:" #o_ "+27\n\ts_waitcnt lgkmcnt(0)" \
      :"=&v"(t0),"=&v"(t1),"=&v"(t2),"=&v"(t3),"=&v"(t4),"=&v"(t5),"=&v"(t6),"=&v"(t7):"v"(a):"memory")
__device__ __forceinline__ void dmask(f32x16&p0,f32x16&p1,int base,unsigned tbl_addr){
  const unsigned a=tbl_addr+(unsigned)(2047-base)*4u;
  f32x2m t0,t1,t2,t3,t4,t5,t6,t7;
  DMASK_BATCH(0);
  p0[0]+=t0.x;p0[1]+=t0.y;p0[2]+=t1.x;p0[3]+=t1.y;p0[4]+=t2.x;p0[5]+=t2.y;p0[6]+=t3.x;p0[7]+=t3.y;
  p0[8]+=t4.x;p0[9]+=t4.y;p0[10]+=t5.x;p0[11]+=t5.y;p0[12]+=t6.x;p0[13]+=t6.y;p0[14]+=t7.x;p0[15]+=t7.y;
  DMASK_BATCH(32);
  p1[0]+=t0.x;p1[1]+=t0.y;p1[2]+=t1.x;p1[3]+=t1.y;p1[4]+=t2.x;p1[5]+=t2.y;p1[6]+=t3.x;p1[7]+=t3.y;
  p1[8]+=t4.x;p1[9]+=t4.y;p1[10]+=t5.x;p1[11]+=t5.y;p1[12]+=t6.x;p1[13]+=t6.y;p1[14]+=t7.x;p1[15]+=t7.y;
}

constexpr int NSLOT=3, SLOTB=8192;
constexpr int LDS_K=0, LDS_V=NSLOT*SLOTB, LDS_WS=2*NSLOT*SLOTB, LDS_OST=LDS_WS+NW*64*4, LDS_BYTES=LDS_OST+NW*4096;
constexpr float C2=0.125f*1.4426950408889634f;
__device__ __forceinline__ void glds16(const void*gsrc,unsigned lds_dst){unsigned keep;
  asm volatile("s_mov_b32 %0, m0\n\ts_mov_b32 m0, %2\n\ts_nop 0\n\tglobal_load_lds_dwordx4 %1, off\n\ts_mov_b32 m0, %0":"=&s"(keep):"v"(gsrc),"s"(lds_dst):"memory");}
__device__ __forceinline__ float max3f(float a,float b,float c){float r;asm("v_max3_f32 %0, %1, %2, %3":"=v"(r):"v"(a),"v"(b),"v"(c));return r;}
__device__ __forceinline__ float max2f(float a,float b){float r;asm("v_max_f32_e32 %0, %1, %2":"=v"(r):"v"(a),"v"(b));return r;}
__device__ __forceinline__ float fadd_s(float a,float b){float r;asm("v_add_f32_e32 %0, %1, %2":"=v"(r):"v"(a),"v"(b));return r;}
__device__ __forceinline__ float fsub_s(float a,float b){float r;asm("v_sub_f32_e32 %0, %1, %2":"=v"(r):"v"(a),"v"(b));return r;}
typedef float f32x2_t __attribute__((ext_vector_type(2))); typedef __bf16 bf16x2_t __attribute__((ext_vector_type(2)));
__device__ __forceinline__ unsigned cvtpk_s(float lo,float hi){f32x2_t v={lo,hi};bf16x2_t b=__builtin_convertvector(v,bf16x2_t);return __builtin_bit_cast(unsigned,b);}
#define WAIT_BAR(N) asm volatile("s_waitcnt vmcnt(" #N ") lgkmcnt(0)\n\ts_barrier":::"memory")

__device__ __forceinline__ void qkt(f32x16&p0,f32x16&p1,const char*Kslot,const bf16x8*qr,const f32x16&negm,int r32,int hi){
  const char*kb=Kslot+hi*1024+r32*16;
  #pragma unroll
  for(int d0=0;d0<4;++d0){
    const bf16x8 b0=*reinterpret_cast<const bf16x8*>(kb+d0*2048);
    const bf16x8 b1=*reinterpret_cast<const bf16x8*>(kb+d0*2048+512);
    if(d0==0){p0=__builtin_amdgcn_mfma_f32_32x32x16_bf16(b0,qr[0],negm,0,0,0);p1=__builtin_amdgcn_mfma_f32_32x32x16_bf16(b1,qr[0],negm,0,0,0);}
    else{p0=__builtin_amdgcn_mfma_f32_32x32x16_bf16(b0,qr[d0],p0,0,0,0);p1=__builtin_amdgcn_mfma_f32_32x32x16_bf16(b1,qr[d0],p1,0,0,0);}}
}
typedef __attribute__((address_space(3))) const char* lds_cptr;
typedef short v4i16_t __attribute__((ext_vector_type(4)));
__device__ __forceinline__ void kload8(bf16x8*kf,lds_cptr kp){
  kf[0]=*(const __attribute__((address_space(3))) bf16x8*)(kp);      kf[1]=*(const __attribute__((address_space(3))) bf16x8*)(kp+512);
  kf[2]=*(const __attribute__((address_space(3))) bf16x8*)(kp+2048); kf[3]=*(const __attribute__((address_space(3))) bf16x8*)(kp+2560);
  kf[4]=*(const __attribute__((address_space(3))) bf16x8*)(kp+4096); kf[5]=*(const __attribute__((address_space(3))) bf16x8*)(kp+4608);
  kf[6]=*(const __attribute__((address_space(3))) bf16x8*)(kp+6144); kf[7]=*(const __attribute__((address_space(3))) bf16x8*)(kp+6656);
}
__device__ __forceinline__ void kload2(bf16x8*kf,lds_cptr kp,int j){ kf[2*j]=*(const __attribute__((address_space(3))) bf16x8*)(kp+j*2048); kf[2*j+1]=*(const __attribute__((address_space(3))) bf16x8*)(kp+j*2048+512); }
__device__ __forceinline__ s16x4 vtr(lds_cptr p){ return __builtin_bit_cast(s16x4,__builtin_amdgcn_ds_read_tr16_b64_v4i16((__attribute__((address_space(3))) v4i16_t*)p)); }
__device__ __forceinline__ float rowmax(const f32x16&p0,const f32x16&p1){
  float a=max3f(p0[0],p0[1],p1[0]),b=max3f(p0[2],p0[3],p1[1]);a=max3f(a,p1[2],p1[3]);
  #pragma unroll
  for(int r=4;r<16;r+=4){a=max3f(a,p0[r],p0[r+1]);b=max3f(b,p0[r+2],p0[r+3]);a=max3f(a,p1[r],p1[r+1]);b=max3f(b,p1[r+2],p1[r+3]);}
  const float m=max2f(a,b);
  auto rr=__builtin_amdgcn_permlane32_swap(__float_as_uint(m),__float_as_uint(m),false,false);
  return max2f(__uint_as_float(rr[0]),__uint_as_float(rr[1]));
}
__device__ __forceinline__ void pv(f32x16*o,int vb,bf16x8 pa0,bf16x8 pa1,bf16x8 pa2,bf16x8 pa3){
  #pragma unroll
  for(int d0=0;d0<2;++d0){s16x4 lo[4],hi[4];
    #pragma unroll
    for(int ks=0;ks<4;++ks){
      asm volatile("ds_read_b64_tr_b16 %0,%1 offset:%c2":"=&v"(lo[ks]):"v"(vb),"i"(d0*4096+ks*1024):"memory");
      asm volatile("ds_read_b64_tr_b16 %0,%1 offset:%c2":"=&v"(hi[ks]):"v"(vb),"i"(d0*4096+ks*1024+512):"memory");}
    asm volatile("s_waitcnt lgkmcnt(0)":::"memory");SBAR();
    #define PK(k) (bf16x8){lo[k][0],lo[k][1],lo[k][2],lo[k][3],hi[k][0],hi[k][1],hi[k][2],hi[k][3]}
    o[d0]=__builtin_amdgcn_mfma_f32_32x32x16_bf16(pa0,PK(0),o[d0],0,0,0);
    o[d0]=__builtin_amdgcn_mfma_f32_32x32x16_bf16(pa1,PK(1),o[d0],0,0,0);
    o[d0]=__builtin_amdgcn_mfma_f32_32x32x16_bf16(pa2,PK(2),o[d0],0,0,0);
    o[d0]=__builtin_amdgcn_mfma_f32_32x32x16_bf16(pa3,PK(3),o[d0],0,0,0);
    #undef PK
  }
}

#ifndef ATTN_STORE16
#define ATTN_STORE16(p,v) do { const void* p_ = (p); asm volatile("global_store_dwordx4 %0, %1, off sc1\n\ts_nop 1" :: "v"(p_), "v"(v) : "memory"); } while (0)
#endif
template<int THRL,int MODE> __device__ __forceinline__ void attn_unit(int b,int qb,const bf16*Q,const bf16*__restrict__ K,const bf16*__restrict__ V,bf16*O,int opitch,char*shm,unsigned tbl){
  int tid_=threadIdx.x; asm volatile("":"+v"(tid_));
  const int tid=tid_,lane=tid&63,r32=lane&31,hi=lane>>5; const int wid=__builtin_amdgcn_readfirstlane(tid>>6);
  const long rowbase=(long)b*SEQ; const int q0=qb*QB;
  const bf16*Qw=Q+(rowbase+q0+wid*QBLK)*DM;
  const bf16*Kh=K+rowbase*DM,*Vh=V+rowbase*DM;
  const unsigned lds0=(unsigned)(uintptr_t)shm;
  float*wsf=(float*)(shm+LDS_WS)+wid*64;
  const bf16*ksrc=Kh+(long)lane*DM+wid*8;
  const bf16*vsrc=Vh+(long)(16*(wid&3)+(lane>>2))*DM+(wid>>2)*32+(lane&3)*8;
  const unsigned kdst=lds0+LDS_K+wid*1024, vdst=lds0+LDS_V+wid*1024;
  #define DMA_K(t,slot) glds16(ksrc+(long)(t)*KVBLK*DM,(unsigned)__builtin_amdgcn_readfirstlane(kdst+(slot)))
  #define DMA_V(t,slot) glds16(vsrc+(long)(t)*KVBLK*DM,(unsigned)__builtin_amdgcn_readfirstlane(vdst+(slot)))
  const int vb0=(int)(lds0+LDS_V)+((lane>>4)&1)*32+(lane&3)*8+(4*hi+((lane&15)>>2))*64;
  const char*Kbase=shm+LDS_K; bf16x8 kf[8];
  const lds_cptr shm3=(lds_cptr)shm; const lds_cptr kp0=shm3+LDS_K+hi*1024+r32*16; const lds_cptr vp0=shm3+LDS_V+((lane>>4)&1)*32+(lane&3)*8+(4*hi+((lane&15)>>2))*64;
  const int NT=(q0+QB)/KVBLK;
  DMA_K(0,0);DMA_V(0,0);DMA_K(1,SLOTB);
  bf16x8 qr[4];
  #pragma unroll
  for(int d0=0;d0<4;++d0)qr[d0]=*reinterpret_cast<const bf16x8*>(&Qw[(long)r32*DM+d0*16+hi*8]);
  float mhat=0.f,l_reg=0.f;f32x16 o[2];o[0]=f32x16{};o[1]=f32x16{};f32x16 negm=f32x16{};asm volatile("":"+v"(negm));
  const int qrel=wid*QBLK+r32;
  #define CMASK(P0,P1,t) do{ if constexpr(MODE==0){int jb_=(t)-(NT-4); if(jb_>=0)cmask(P0,P1,jb_,qrel,hi);} else if constexpr(MODE==1) { dmask(P0,P1,q0+qrel-64*(t)-4*hi,tbl); } }while(0)
  bool resc=false;
  #define START(P0,P1) do{ const float rm=rowmax(P0,P1); resc=false; \
    { const float dl=rm; mhat=fadd_s(mhat,dl); \
      _Pragma("unroll") for(int r=0;r<16;++r){P0[r]=fsub_s(P0[r],dl);P1[r]=fsub_s(P1[r],dl);} \
      _Pragma("unroll") for(int r=0;r<16;++r)negm[r]=-mhat; asm volatile("":"+v"(negm)); } \
    _Pragma("unroll") for(int r=0;r<16;++r)P0[r]=__builtin_amdgcn_exp2f(P0[r]); }while(0)
  #define RESC() do{ if(resc){ asm volatile("s_waitcnt lgkmcnt(0)":::"memory"); \
      _Pragma("unroll") for(int d_=0;d_<2;++d_) _Pragma("unroll") for(int r=0;r<16;++r)o[d_][r]*=wsf[crow(r,hi)]; } }while(0)
  f32x16 pA0,pA1,pB0,pB1;
  int sl_prev=0,sl_cur=0,sl_next=SLOTB;
  #define ROT() do{sl_prev=sl_cur;sl_cur=sl_next;sl_next=(sl_next==(NSLOT-1)*SLOTB)?0:sl_next+SLOTB;}while(0)
  DMA_K(2,2*SLOTB);
  WAIT_BAR(3);
  qkt(pA0,pA1,Kbase,qr,negm,r32,hi);asm volatile("s_nop 15\n\ts_nop 7":"+v"(pA0),"+v"(pA1));CMASK(pA0,pA1,0);
  START(pA0,pA1);
  _Pragma("unroll") for(int r=0;r<16;++r)pA1[r]=__builtin_amdgcn_exp2f(pA1[r]);
  WAIT_BAR(0);
  DMA_K(3,0);DMA_V(1,SLOTB);
  ROT();
  kload8(kf,kp0+sl_cur);
  WAIT_BAR(2);
  s16x4 vlo[8],vhi[8]; u32x4 pw0,pw1,pw2,pw3;
  #define PKW(P,B) cvtpk_s(P[B],P[B+1])
  #define PAF(k) __builtin_bit_cast(bf16x8,pw##k)
  #define VFR(i) (bf16x8){vlo[i][0],vlo[i][1],vlo[i][2],vlo[i][3],vhi[i][0],vhi[i][1],vhi[i][2],vhi[i][3]}
  #define PIN(x) asm volatile("":"+v"(x))
  #define MX3(a,b,c) __builtin_fmaxf(__builtin_fmaxf((a),(b)),(c))
  #define GAPA(MF,A0,A1,A2,A3,W0,W1,PW) do{ MF; sacc+=A0; sacc+=A1; sacc+=A2; sacc+=A3; PIN(sacc); W0; W1; PIN(PW); SBAR(); }while(0)
  #define EX(v) __builtin_amdgcn_exp2f(v)
  #define GAPB(MF,X,B) do{ MF; X[B]=EX(X[B]); X[B+1]=EX(X[B+1]); X[B+2]=EX(X[B+2]); X[B+3]=EX(X[B+3]); PIN(X); SBAR(); }while(0)
  #define VRD(i) do{ vlo[i]=vtr(vp_+(((i)>>2)*4096+((i)&3)*1024)); vhi[i]=vtr(vp_+(((i)>>2)*4096+((i)&3)*1024+512)); }while(0)
  #define KRD(G,j) do{ if(G){ kload2(kf,kp0+sl_next,j); SBAR(); } }while(0)
  #define STEP(C0,C1,P0,P1,t,GK,GV,GL) do{ SBAR(); \
    const lds_cptr vp_=vp0+sl_prev; \
    VRD(0); SBAR(); float sacc=(P0[0]+P0[1]); \
    GAPA(C0=__builtin_amdgcn_mfma_f32_32x32x16_bf16(kf[0],qr[0],negm,0,0,0), P0[2],P0[3],P0[4],P0[5],     pw0[0]=PKW(P0,0), pw0[1]=PKW(P0,2), pw0); \
    VRD(4); SBAR(); GAPA(C1=__builtin_amdgcn_mfma_f32_32x32x16_bf16(kf[1],qr[0],negm,0,0,0), P0[6],P0[7],P0[8],P0[9],     pw0[2]=PKW(P0,4), pw0[3]=PKW(P0,6), pw0); \
    VRD(1); SBAR(); GAPA(C0=__builtin_amdgcn_mfma_f32_32x32x16_bf16(kf[2],qr[1],C0,0,0,0),   P0[10],P0[11],P0[12],P0[13], pw1[0]=PKW(P0,8), pw1[1]=PKW(P0,10), pw1); \
    VRD(5); SBAR(); GAPA(C1=__builtin_amdgcn_mfma_f32_32x32x16_bf16(kf[3],qr[1],C1,0,0,0),   P0[14],P0[15],P1[0],P1[1],   pw1[2]=PKW(P0,12),pw1[3]=PKW(P0,14), pw1); \
    VRD(2); SBAR(); GAPA(C0=__builtin_amdgcn_mfma_f32_32x32x16_bf16(kf[4],qr[2],C0,0,0,0),   P1[2],P1[3],P1[4],P1[5],     pw2[0]=PKW(P1,0), pw2[1]=PKW(P1,2), pw2); \
    VRD(6); SBAR(); GAPA(C1=__builtin_amdgcn_mfma_f32_32x32x16_bf16(kf[5],qr[2],C1,0,0,0),   P1[6],P1[7],P1[8],P1[9],     pw2[2]=PKW(P1,4), pw2[3]=PKW(P1,6), pw2); \
    VRD(3); SBAR(); GAPA(C0=__builtin_amdgcn_mfma_f32_32x32x16_bf16(kf[6],qr[3],C0,0,0,0),   P1[10],P1[11],P1[12],P1[13], pw3[0]=PKW(P1,8), pw3[1]=PKW(P1,10), pw3); \
    VRD(7); SBAR(); GAPA(C1=__builtin_amdgcn_mfma_f32_32x32x16_bf16(kf[7],qr[3],C1,0,0,0),   P1[14],P1[15],0.f,0.f,       pw3[2]=PKW(P1,12),pw3[3]=PKW(P1,14), pw3); \
    l_reg+=sacc; \
    if(GK){DMA_K((t)+3,sl_cur);} if(GV){DMA_V((t)+1,sl_next);} \
    CMASK(C0,C1,t); \
    { float a=MX3(C0[0],C0[1],C1[0]),b=MX3(C0[2],C0[3],C1[1]); a=MX3(a,C1[2],C1[3]); \
      _Pragma("unroll") for(int r=4;r<16;r+=4){a=MX3(a,C0[r],C0[r+1]);b=MX3(b,C0[r+2],C0[r+3]);a=MX3(a,C1[r],C1[r+1]);b=MX3(b,C1[r+2],C1[r+3]);} \
      float rm=__builtin_fmaxf(a,b); { auto rr=__builtin_amdgcn_permlane32_swap(__float_as_uint(rm),__float_as_uint(rm),false,false); rm=__builtin_fmaxf(__uint_as_float(rr[0]),__uint_as_float(rr[1])); } \
      resc=false; \
      if(__builtin_expect(__any(rm>(float)THRL),0)){ const float dl=__builtin_fmaxf(rm,0.f); mhat+=dl; \
        _Pragma("unroll") for(int r=0;r<16;++r){C0[r]-=dl;C1[r]-=dl;} \
        _Pragma("unroll") for(int r=0;r<16;++r)negm[r]=-mhat; asm volatile("":"+v"(negm)); \
        const float f=__builtin_amdgcn_exp2f(-dl); l_reg*=f; if(hi==0)wsf[r32]=f; resc=true; } } \
    SBAR(); \
    GAPB(o[0]=__builtin_amdgcn_mfma_f32_32x32x16_bf16(PAF(0),VFR(0),o[0],0,0,0), C0,0); \
    GAPB(o[1]=__builtin_amdgcn_mfma_f32_32x32x16_bf16(PAF(0),VFR(4),o[1],0,0,0), C0,4); \
    KRD(GL,0); GAPB(o[0]=__builtin_amdgcn_mfma_f32_32x32x16_bf16(PAF(1),VFR(1),o[0],0,0,0), C0,8); \
    KRD(GL,1); GAPB(o[1]=__builtin_amdgcn_mfma_f32_32x32x16_bf16(PAF(1),VFR(5),o[1],0,0,0), C0,12); \
    KRD(GL,2); GAPB(o[0]=__builtin_amdgcn_mfma_f32_32x32x16_bf16(PAF(2),VFR(2),o[0],0,0,0), C1,0); \
    KRD(GL,3); GAPB(o[1]=__builtin_amdgcn_mfma_f32_32x32x16_bf16(PAF(2),VFR(6),o[1],0,0,0), C1,4); \
    GAPB(o[0]=__builtin_amdgcn_mfma_f32_32x32x16_bf16(PAF(3),VFR(3),o[0],0,0,0), C1,8); \
    GAPB(o[1]=__builtin_amdgcn_mfma_f32_32x32x16_bf16(PAF(3),VFR(7),o[1],0,0,0), C1,12); \
    }while(0)
  int t=1;
  #undef CMASK
  #define CMASK(P0,P1,t) do{ if constexpr(MODE==1){ dmask(P0,P1,q0+qrel-64*(t)-4*hi,tbl); } }while(0)
  for(;t+5<NT;t+=2){
    STEP(pB0,pB1,pA0,pA1,t,true,true,true);     WAIT_BAR(2); RESC(); ROT();
    STEP(pA0,pA1,pB0,pB1,t+1,true,true,true);   WAIT_BAR(2); RESC(); ROT();
  }
  #undef CMASK
  #define CMASK(P0,P1,t) do{ if constexpr(MODE==0){int jb_=(t)-(NT-4); if(jb_>=0)cmask(P0,P1,jb_,qrel,hi);} else if constexpr(MODE==1) { dmask(P0,P1,q0+qrel-64*(t)-4*hi,tbl); } }while(0)
  #define ENDW(tt) do{ if((tt)+3<NT){WAIT_BAR(2);} else if((tt)+2<NT){WAIT_BAR(1);} else {WAIT_BAR(0);} }while(0)
  for(;t+1<NT;t+=2){
    STEP(pB0,pB1,pA0,pA1,t,(t+3<NT),(t+1<NT),(t+1<NT));       ENDW(t);   RESC(); ROT();
    STEP(pA0,pA1,pB0,pB1,t+1,(t+4<NT),(t+2<NT),(t+2<NT));     ENDW(t+1); RESC(); ROT();
  }
  STEP(pB0,pB1,pA0,pA1,NT-1,false,false,false); RESC();
  { float sacc=pB0[0]+pB0[1]; _Pragma("unroll") for(int r=2;r<16;++r)sacc+=pB0[r]; _Pragma("unroll") for(int r=0;r<16;++r)sacc+=pB1[r]; l_reg+=sacc;
    pw0=(u32x4){PKW(pB0,0),PKW(pB0,2),PKW(pB0,4),PKW(pB0,6)};pw1=(u32x4){PKW(pB0,8),PKW(pB0,10),PKW(pB0,12),PKW(pB0,14)};pw2=(u32x4){PKW(pB1,0),PKW(pB1,2),PKW(pB1,4),PKW(pB1,6)};pw3=(u32x4){PKW(pB1,8),PKW(pB1,10),PKW(pB1,12),PKW(pB1,14)};
    SBAR(); pv(o,vb0+sl_cur,PAF(0),PAF(1),PAF(2),PAF(3)); }
  #undef PKW
  #undef PAF
  #undef VFR
  #undef PIN
  #undef MX3
  #undef GAPA
  #undef GAPB
  #undef EX
  #undef VRD
  #undef KRD
  #undef STEP
  #undef ENDW
  {auto rr=__builtin_amdgcn_permlane32_swap(__float_as_uint(l_reg),__float_as_uint(l_reg),false,false);l_reg=__uint_as_float(rr[0])+__uint_as_float(rr[1]);}
  if(hi==0)wsf[32+r32]=l_reg;asm volatile("s_waitcnt lgkmcnt(0)":::"memory");
  float rli[16];
  #pragma unroll
  for(int r=0;r<16;++r)rli[r]=__builtin_amdgcn_rcpf(wsf[32+crow(r,hi)]);
  bf16*Ow=O+(rowbase+q0+wid*QBLK)*(long)opitch;
  { bf16*stg=(bf16*)(shm+LDS_OST)+wid*2048;
    #pragma unroll
    for(int r=0;r<16;++r){const int orow=crow(r,hi);
      #pragma unroll
      for(int d0=0;d0<2;++d0)stg[orow*64+d0*32+r32]=__float2bfloat16(o[d0][r]*rli[r]);}
    asm volatile("s_waitcnt lgkmcnt(0)":::"memory");
    #pragma unroll
    for(int i=0;i<4;++i){const int row=i*8+(lane>>3),ch=lane&7; const u32x4 v=*(const u32x4*)(stg+row*64+ch*8); ATTN_STORE16(Ow+(long)row*opitch+ch*8,v);} }
  asm volatile("s_waitcnt lgkmcnt(0)\n\ts_barrier":::"memory");
  #undef DMA_K
  #undef DMA_V
  #undef CMASK
  #undef START
  #undef RESC
  #undef ROT
}
constexpr int ATTN_LDS_BYTES=LDS_BYTES;
#undef SBAR
#undef WAIT_BAR
}

namespace attn_b {
using bf16 = __hip_bfloat16;
typedef short bf16x8 __attribute__((ext_vector_type(8)));
typedef short s16x4 __attribute__((ext_vector_type(4)));
typedef float f32x16 __attribute__((ext_vector_type(16)));
typedef float f32x4 __attribute__((ext_vector_type(4)));
typedef unsigned u32x4 __attribute__((ext_vector_type(4)));
constexpr int DQ = 64, DV = 128, PIN = 3072, POUT = 1024;
constexpr int NW = 8, QBLK = 32, KVBLK = 64, QB = NW * QBLK;
constexpr int SHM_V = KVBLK * DV * 2, SHM_K = KVBLK * DQ * 2;
constexpr int NBUF = 3;
constexpr int LDS_BYTES = NBUF * SHM_V + NBUF * SHM_K + NW * 64 * 4;
constexpr int OSTAGE_OFF = 98304;
constexpr float THR = 8.f;
#define KSWZ(row, colB) ((row) * 128 + ((colB) ^ ((((row) >> 1) & 7) << 4)))
#define SBAR() __builtin_amdgcn_sched_barrier(0)
__device__ __forceinline__ int v_st(int k, int c) { const int kk = (k & ~0xC) | ((k & 4) << 1) | ((k & 8) >> 1); return ((kk >> 3) * 4 + (c >> 5)) * 512 + ((kk & 7) * 32 + (c & 31)) * 2; }
__device__ __forceinline__ int v_rd_base(int lane) { return ((lane & 3) << 3) | (((lane >> 2) & 3) << 6) | (((lane >> 4) & 1) << 5) | (((lane >> 5) & 1) << 8); }
constexpr int v_rd_off(int d0, int ks, int half) { return d0 * 512 + ks * 4096 + half * 2048; }
__device__ __forceinline__ int crow(int r, int hi) { return (r & 3) + 8 * (r >> 2) + 4 * hi; }
__device__ __forceinline__ unsigned cvtpk(float lo, float hi) { unsigned r; asm volatile("v_cvt_pk_bf16_f32 %0, %1, %2" : "=v"(r) : "v"(lo), "v"(hi)); return r; }
__device__ __forceinline__ bf16x8 load8(const bf16* p) { return *reinterpret_cast<const bf16x8*>(p); }
__device__ __forceinline__ void mask_tile(f32x16& p0, f32x16& p1, int dq) {
    const float NEG = -__builtin_inff();
#pragma unroll
    for (int r = 0; r < 16; ++r) { const int c = (r & 3) + 8 * (r >> 2); if (dq - c < 0) p0[r] = NEG; if (dq - c - 32 < 0) p1[r] = NEG; }
}
#define MX3(a, b, c) __builtin_fmaxf(__builtin_fmaxf((a), (b)), (c))
__device__ __forceinline__ void partialSM(f32x16& p0, f32x16& p1, float& m_reg, float& mn, float& alpha) {
    float ma = MX3(p0[0], p0[1], p0[2]), mb = MX3(p0[3], p0[4], p0[5]), mc = MX3(p1[0], p1[1], p1[2]), md = MX3(p1[3], p1[4], p1[5]);
    ma = MX3(ma, p0[6], p0[7]); mb = MX3(mb, p0[8], p0[9]); mc = MX3(mc, p1[6], p1[7]); md = MX3(md, p1[8], p1[9]);
    ma = MX3(ma, p0[10], p0[11]); mb = MX3(mb, p0[12], p0[13]); mc = MX3(mc, p1[10], p1[11]); md = MX3(md, p1[12], p1[13]);
    ma = MX3(ma, p0[14], p0[15]); mc = MX3(mc, p1[14], p1[15]);
    float pmax = __builtin_fmaxf(MX3(ma, mb, mc), md);
    { auto rr = __builtin_amdgcn_permlane32_swap(__float_as_uint(pmax), __float_as_uint(pmax), false, false); pmax = fmaxf(__uint_as_float(rr[0]), __uint_as_float(rr[1])); }
    if (__builtin_expect(__all((pmax - m_reg) <= THR), 1)) { mn = m_reg; alpha = 1.f; }
    else { mn = fmaxf(m_reg, pmax); alpha = __builtin_amdgcn_exp2f(m_reg - mn); m_reg = mn; }
#pragma unroll
    for (int r = 0; r < 16; ++r) p0[r] = p0[r] - mn;
#pragma unroll
    for (int r = 0; r < 16; ++r) p1[r] = p1[r] - mn;
#pragma unroll
    for (int r = 0; r < 16; ++r) p0[r] = __builtin_amdgcn_exp2f(p0[r]);
}
__device__ __forceinline__ void finishSM(f32x16& p0, f32x16& p1, float alpha, float& l_reg, bf16x8& pa0, bf16x8& pa1, bf16x8& pa2, bf16x8& pa3) {
#pragma unroll
    for (int r = 0; r < 16; ++r) p1[r] = __builtin_amdgcn_exp2f(p1[r]);
    float sa = p0[0] + p0[1], sb = p0[2] + p0[3], sc = p1[0] + p1[1], sd = p1[2] + p1[3];
#pragma unroll
    for (int r = 4; r < 16; r += 4) { sa += p0[r]; sb += p0[r + 2]; sc += p1[r]; sd += p1[r + 2]; sa += p0[r + 1]; sb += p0[r + 3]; sc += p1[r + 1]; sd += p1[r + 3]; }
    float ps = (sa + sb) + (sc + sd);
    { auto rr = __builtin_amdgcn_permlane32_swap(__float_as_uint(ps), __float_as_uint(ps), false, false); ps = __uint_as_float(rr[0]) + __uint_as_float(rr[1]); }
    l_reg = l_reg * alpha + ps;
#define PK4(P, B_, OUT) do { unsigned a0 = cvtpk(P[B_+0], P[B_+1]), a1 = cvtpk(P[B_+2], P[B_+3]);                          \
        unsigned b0 = cvtpk(P[B_+4], P[B_+5]), b1 = cvtpk(P[B_+6], P[B_+7]);                                             \
        auto r0 = __builtin_amdgcn_permlane32_swap(a0, b0, false, false); auto r1 = __builtin_amdgcn_permlane32_swap(a1, b1, false, false); \
        u32x4 w = {r0[0], r1[0], r0[1], r1[1]}; OUT = *reinterpret_cast<bf16x8*>(&w); } while (0)
    PK4(p0, 0, pa0); PK4(p0, 8, pa1); PK4(p1, 0, pa2); PK4(p1, 8, pa3);
#undef PK4
}
__device__ __forceinline__ void qkt(f32x16& p0, f32x16& p1, const char* K_buf, int r32, int hi, const bf16x8* qr) {
    p0 = f32x16{}; p1 = f32x16{};
#pragma unroll
    for (int d0 = 0; d0 < 4; ++d0) { const char* a = K_buf + KSWZ(r32, (d0 * 16 + hi * 8) * 2);
        bf16x8 b0 = *reinterpret_cast<const bf16x8*>(a);
        bf16x8 b1 = *reinterpret_cast<const bf16x8*>(a + 32 * 128);
        p0 = __builtin_amdgcn_mfma_f32_32x32x16_bf16(b0, qr[d0], p0, 0, 0, 0);
        p1 = __builtin_amdgcn_mfma_f32_32x32x16_bf16(b1, qr[d0], p1, 0, 0, 0); }
}
__device__ __forceinline__ void qkt_shift(f32x16& p0, f32x16& p1, const char* K_buf, int r32, int hi, const bf16x8* qr, const f32x16& negm) {
#pragma unroll
    for (int d0 = 0; d0 < 4; ++d0) { const char* a = K_buf + KSWZ(r32, (d0 * 16 + hi * 8) * 2);
        bf16x8 b0 = *reinterpret_cast<const bf16x8*>(a);
        bf16x8 b1 = *reinterpret_cast<const bf16x8*>(a + 32 * 128);
        if (d0 == 0) { p0 = __builtin_amdgcn_mfma_f32_32x32x16_bf16(b0, qr[0], negm, 0, 0, 0); p1 = __builtin_amdgcn_mfma_f32_32x32x16_bf16(b1, qr[0], negm, 0, 0, 0); }
        else { p0 = __builtin_amdgcn_mfma_f32_32x32x16_bf16(b0, qr[d0], p0, 0, 0, 0); p1 = __builtin_amdgcn_mfma_f32_32x32x16_bf16(b1, qr[d0], p1, 0, 0, 0); } }
}
__device__ __forceinline__ void partialSM_shift(f32x16& p0, f32x16& p1, float& m_reg, f32x16& negm, float& alpha) {
    float ma = MX3(p0[0], p0[1], p0[2]), mb = MX3(p0[3], p0[4], p0[5]), mc = MX3(p1[0], p1[1], p1[2]), md = MX3(p1[3], p1[4], p1[5]);
    ma = MX3(ma, p0[6], p0[7]); mb = MX3(mb, p0[8], p0[9]); mc = MX3(mc, p1[6], p1[7]); md = MX3(md, p1[8], p1[9]);
    ma = MX3(ma, p0[10], p0[11]); mb = MX3(mb, p0[12], p0[13]); mc = MX3(mc, p1[10], p1[11]); md = MX3(md, p1[12], p1[13]);
    ma = MX3(ma, p0[14], p0[15]); mc = MX3(mc, p1[14], p1[15]);
    float pmax = __builtin_fmaxf(MX3(ma, mb, mc), md);
    { auto rr = __builtin_amdgcn_permlane32_swap(__float_as_uint(pmax), __float_as_uint(pmax), false, false); pmax = fmaxf(__uint_as_float(rr[0]), __uint_as_float(rr[1])); }
    if (__builtin_expect(__all(pmax <= THR), 1)) { alpha = 1.f; }
    else { const float dl = fmaxf(pmax, 0.f); alpha = __builtin_amdgcn_exp2f(-dl); m_reg += dl;
#pragma unroll
        for (int r = 0; r < 16; ++r) { p0[r] = p0[r] - dl; p1[r] = p1[r] - dl; }
#pragma unroll
        for (int r = 0; r < 16; ++r) negm[r] = -m_reg;
        asm volatile("" : "+v"(negm)); }
#pragma unroll
    for (int r = 0; r < 16; ++r) p0[r] = __builtin_amdgcn_exp2f(p0[r]);
}
__device__ __forceinline__ void pv_tile(f32x16* o, int vb0, bf16x8 pa0, bf16x8 pa1, bf16x8 pa2, bf16x8 pa3) {
#define TRRD(dst, off) asm volatile("ds_read_b64_tr_b16 %0, %1 offset:%2" : "=&v"(dst) : "v"(vb0), "i"(off) : "memory")
#define PV_D0(d0) do { s16x4 l0, l1, l2, l3, h0, h1, h2, h3; constexpr int b_ = v_rd_off(d0, 0, 0);   \
        TRRD(l0, b_); TRRD(h0, b_ + 2048); TRRD(l1, b_ + 4096); TRRD(h1, b_ + 6144); TRRD(l2, b_ + 8192); TRRD(h2, b_ + 10240); TRRD(l3, b_ + 12288); TRRD(h3, b_ + 14336); \
        asm volatile("s_waitcnt lgkmcnt(0)" ::: "memory"); SBAR();   \
        o[d0] = __builtin_amdgcn_mfma_f32_32x32x16_bf16(pa0, (bf16x8){l0[0], l0[1], l0[2], l0[3], h0[0], h0[1], h0[2], h0[3]}, o[d0], 0, 0, 0);   \
        o[d0] = __builtin_amdgcn_mfma_f32_32x32x16_bf16(pa1, (bf16x8){l1[0], l1[1], l1[2], l1[3], h1[0], h1[1], h1[2], h1[3]}, o[d0], 0, 0, 0);   \
        o[d0] = __builtin_amdgcn_mfma_f32_32x32x16_bf16(pa2, (bf16x8){l2[0], l2[1], l2[2], l2[3], h2[0], h2[1], h2[2], h2[3]}, o[d0], 0, 0, 0);   \
        o[d0] = __builtin_amdgcn_mfma_f32_32x32x16_bf16(pa3, (bf16x8){l3[0], l3[1], l3[2], l3[3], h3[0], h3[1], h3[2], h3[3]}, o[d0], 0, 0, 0); } while (0)
    PV_D0(0); PV_D0(1); PV_D0(2); PV_D0(3);
#undef PV_D0
#undef TRRD
}
__device__ __forceinline__ void partialSM_noexp(f32x16& p0, f32x16& p1, float& m_reg, float& mn, float& alpha) {
    float pmax = p0[0];
#pragma unroll
    for (int r = 1; r < 16; ++r) pmax = fmaxf(pmax, p0[r]);
#pragma unroll
    for (int r = 0; r < 16; ++r) pmax = fmaxf(pmax, p1[r]);
    { auto rr = __builtin_amdgcn_permlane32_swap(__float_as_uint(pmax), __float_as_uint(pmax), false, false); pmax = fmaxf(__uint_as_float(rr[0]), __uint_as_float(rr[1])); }
    if (__builtin_expect(__all((pmax - m_reg) <= THR), 1)) { mn = m_reg; alpha = 1.f; }
    else { mn = fmaxf(m_reg, pmax); alpha = 1.f; m_reg = mn; }
#pragma unroll
    for (int r = 0; r < 16; ++r) p0[r] = p0[r] - mn;
#pragma unroll
    for (int r = 0; r < 16; ++r) p1[r] = p1[r] - mn;
}
__device__ __forceinline__ void finishSM_noexp(f32x16& p0, f32x16& p1, float alpha, float& l_reg, bf16x8& pa0, bf16x8& pa1, bf16x8& pa2, bf16x8& pa3) {
    float ps = 0;
#pragma unroll
    for (int r = 0; r < 16; ++r) ps += p0[r];
#pragma unroll
    for (int r = 0; r < 16; ++r) ps += p1[r];
    { auto rr = __builtin_amdgcn_permlane32_swap(__float_as_uint(ps), __float_as_uint(ps), false, false); ps = __uint_as_float(rr[0]) + __uint_as_float(rr[1]); }
    l_reg = l_reg * alpha + ps;
#define PK4(P, B_, OUT) do { unsigned a0 = cvtpk(P[B_+0], P[B_+1]), a1 = cvtpk(P[B_+2], P[B_+3]);                          \
        unsigned b0 = cvtpk(P[B_+4], P[B_+5]), b1 = cvtpk(P[B_+6], P[B_+7]);                                             \
        auto r0 = __builtin_amdgcn_permlane32_swap(a0, b0, false, false); auto r1 = __builtin_amdgcn_permlane32_swap(a1, b1, false, false); \
        u32x4 w = {r0[0], r1[0], r0[1], r1[1]}; OUT = *reinterpret_cast<bf16x8*>(&w); } while (0)
    PK4(p0, 0, pa0); PK4(p0, 8, pa1); PK4(p1, 0, pa2); PK4(p1, 8, pa3);
#undef PK4
}
__device__ __forceinline__ void qkt_nomma(f32x16& p0, f32x16& p1, const char* K_buf, int r32, int hi, const bf16x8* qr) {
    p0 = f32x16{}; p1 = f32x16{};
#pragma unroll
    for (int d0 = 0; d0 < 4; ++d0) { const char* a = K_buf + KSWZ(r32, (d0 * 16 + hi * 8) * 2);
        bf16x8 b0 = *reinterpret_cast<const bf16x8*>(a);
        bf16x8 b1 = *reinterpret_cast<const bf16x8*>(a + 32 * 128);
        p0[d0] += (float)b0[0] + (float)qr[d0][0]; p1[d0] += (float)b1[0]; }
}
__device__ __forceinline__ void pv_nomma(f32x16* o, int vb0, bf16x8 pa0, bf16x8 pa1, bf16x8 pa2, bf16x8 pa3) {
#define TRRD(dst, off) asm volatile("ds_read_b64_tr_b16 %0, %1 offset:%2" : "=&v"(dst) : "v"(vb0), "i"(off) : "memory")
#define PV_D0(d0) do { s16x4 l0, l1, l2, l3, h0, h1, h2, h3; constexpr int b_ = v_rd_off(d0, 0, 0);   \
        TRRD(l0, b_); TRRD(h0, b_ + 2048); TRRD(l1, b_ + 4096); TRRD(h1, b_ + 6144); TRRD(l2, b_ + 8192); TRRD(h2, b_ + 10240); TRRD(l3, b_ + 12288); TRRD(h3, b_ + 14336); \
        asm volatile("s_waitcnt lgkmcnt(0)" ::: "memory"); SBAR();   \
        o[d0][0] += (float)(l0[0] + h0[0] + l1[0] + h1[0] + l2[0] + h2[0] + l3[0] + h3[0]) + (float)pa0[0] + (float)pa1[0] + (float)pa2[0] + (float)pa3[0]; } while (0)
    PV_D0(0); PV_D0(1); PV_D0(2); PV_D0(3);
#undef PV_D0
#undef TRRD
}
struct BlockRef { const bf16* Q; const bf16* K; const bf16* V; bf16* O; int P0; };
struct Seam { bf16x8 qr[4]; bf16x8 st_v0, st_v1, st_k0; };
#define VMW() asm volatile("s_waitcnt vmcnt(0)" ::: "memory")
#define VMWN(n) asm volatile("s_waitcnt vmcnt(%0)" :: "i"(n) : "memory")
#define SLOAD_H(Kp, Vp, k0) do { S.st_v0 = load8((Vp) + (size_t)((k0) + sr) * PIN + sc); S.st_v1 = load8((Vp) + (size_t)((k0) + 32 + sr) * PIN + sc);   \
                                 S.st_k0 = load8((Kp) + (size_t)((k0) + ksr) * PIN + ksc); } while (0)
#define SWRITE_HK(bf) do { *(bf16x8*)(K_lds + (bf) * SHM_K + kws) = S.st_k0; } while (0)
#define SWRITE_HV(bf) do { *(bf16x8*)(V_lds + (bf) * SHM_V + vst0) = S.st_v0; *(bf16x8*)(V_lds + (bf) * SHM_V + vst1) = S.st_v1; } while (0)
#define SWRITE_H(bf) do { SWRITE_HV(bf); SWRITE_HK(bf); } while (0)
__device__ __forceinline__ void causal_prime(const BlockRef& cur, char* lds, Seam& S) {
    int tid_ = threadIdx.x; asm volatile("" : "+v"(tid_));
    const int tid = tid_, wid = __builtin_amdgcn_readfirstlane(tid >> 6), lane = tid & 63, r32 = lane & 31, hi = lane >> 5;
    const int sr = tid >> 4, sc = (tid & 15) * 8, ksr = tid >> 3, ksc = (tid & 7) * 8, kws = KSWZ(ksr, ksc * 2); char* K_lds = lds + NBUF * SHM_V;
#pragma unroll
    for (int d0 = 0; d0 < 4; ++d0) S.qr[d0] = load8(cur.Q + (size_t)(wid * QBLK + r32) * PIN + d0 * 16 + hi * 8);
    SLOAD_H(cur.K, cur.V, 0); VMW(); SWRITE_HK(0);
    __syncthreads();
}
template <int ABL = 0>
__device__ __forceinline__ void causal_block(const BlockRef& cur, const BlockRef& nxt, char* lds, Seam& S) {
    int tid_ = threadIdx.x; asm volatile("" : "+v"(tid_));
    const int tid = tid_, wid = __builtin_amdgcn_readfirstlane(tid >> 6), lane = tid & 63, r32 = lane & 31, hi = lane >> 5;
    const int NT = (cur.P0 + QB) / KVBLK;
    const int qlo = cur.P0 + wid * QBLK, qm = qlo + r32 - 4 * hi;
    char* V_lds = lds; char* K_lds = lds + NBUF * SHM_V;
    float* ws = (float*)(lds + NBUF * SHM_V + NBUF * SHM_K) + wid * 64; float* li_l = ws, * al_l = ws + 32;
    float m_reg = -1e30f, l_reg = 0; f32x16 o[4] = {};
    const int sr = tid >> 4, sc = (tid & 15) * 8, vst0 = v_st(sr, sc), vst1 = v_st(32 + sr, sc), ksr = tid >> 3, ksc = (tid & 7) * 8, kws = KSWZ(ksr, ksc * 2);
    const int vb0 = (int)(uintptr_t)V_lds + v_rd_base(lane);
    const bf16* Kh = cur.K; const bf16* Vh = cur.V;
#define RESC(a) do { if (__any((a) < 1.f)) { if (hi == 0) al_l[r32] = (a); asm volatile("s_waitcnt lgkmcnt(0)" ::: "memory");              \
                     _Pragma("unroll") for (int d_ = 0; d_ < 4; ++d_) _Pragma("unroll") for (int r = 0; r < 16; ++r) o[d_][r] *= al_l[crow(r, hi)]; } } while (0)
#define KBASE(t) ((t) * KVBLK)
#define MASKT(P0_, P1_, t) do { const int kb_ = KBASE(t); if (kb_ + KVBLK - 1 > qlo) { asm volatile("" ::: "memory"); mask_tile(P0_, P1_, qm - kb_); } } while (0)
    constexpr int NQL = 4;
#define SEAM_K0() do { VMWN(NQL); SWRITE_HK(0); SBAR(); } while (0)
    f32x16 pA0, pA1, pB0, pB1; float mnA, mnB, alA, alB; bf16x8 pa0, pa1, pa2, pa3;
    SWRITE_HV(0); SBAR();
    if (NT > 1) { SLOAD_H(Kh, Vh, KBASE(1)); }
    SBAR(); qkt(pA0, pA1, K_lds, r32, hi, S.qr);
    MASKT(pA0, pA1, 0); partialSM(pA0, pA1, m_reg, mnA, alA);
    f32x16 negm;
#pragma unroll
    for (int r = 0; r < 16; ++r) negm[r] = -m_reg;
    asm volatile("" : "+v"(negm));
    if (NT > 1) { VMW(); SWRITE_H(1); }
    __syncthreads();
    int bt = 1, bp = 0, bn = 2;
#define ROTB() do { const int o_ = bp; bp = bt; bt = bn; bn = o_; } while (0)
#define HALF_STEP(PX0, PX1, mnX, alX, PY0, PY1, alY, t) do {                                                                 \
        SBAR(); if constexpr (ABL != 6 && ABL < 9) { if constexpr (ABL == 2) qkt_nomma(PX0, PX1, K_lds + bt * SHM_K, r32, hi, S.qr); else qkt_shift(PX0, PX1, K_lds + bt * SHM_K, r32, hi, S.qr, negm); } \
        if constexpr (ABL != 7 && ABL < 9) { if constexpr (ABL == 1) finishSM_noexp(PY0, PY1, alY, l_reg, pa0, pa1, pa2, pa3); else finishSM(PY0, PY1, alY, l_reg, pa0, pa1, pa2, pa3); } SBAR(); \
        if constexpr (ABL != 4 && ABL < 9) { if ((t) + 1 < NT) { SLOAD_H(Kh, Vh, KBASE((t) + 1)); SBAR(); } }                              \
        if constexpr (ABL != 5 && ABL < 9) { if constexpr (ABL == 2) pv_nomma(o, vb0 + bp * SHM_V, pa0, pa1, pa2, pa3); else pv_tile(o, vb0 + bp * SHM_V, pa0, pa1, pa2, pa3); } \
        MASKT(PX0, PX1, (t)); if constexpr (ABL != 7 && ABL < 9) { if constexpr (ABL == 1) partialSM_noexp(PX0, PX1, m_reg, mnX, alX); else partialSM_shift(PX0, PX1, m_reg, negm, alX); } else { alX = 1.f; } \
        if constexpr (ABL != 4 && ABL < 9) { if ((t) + 1 < NT) { VMW(); SWRITE_H(bn); } }                                                  \
        RESC(alX); if constexpr (ABL != 3 && ABL != 10) __syncthreads(); ROTB(); } while (0)
    for (int t = 1; t + 1 < NT && ABL != 8; t += 2) {
        HALF_STEP(pB0, pB1, mnB, alB, pA0, pA1, alA, t);
        HALF_STEP(pA0, pA1, mnA, alA, pB0, pB1, alB, t + 1);
    }
    const bool even = (NT & 1) == 0;
    if (even) { SBAR(); qkt_shift(pB0, pB1, K_lds + bt * SHM_K, r32, hi, S.qr, negm); SBAR(); }
    SLOAD_H(nxt.K, nxt.V, 0); SBAR();
#pragma unroll
    for (int d0 = 0; d0 < 4; ++d0) S.qr[d0] = load8(nxt.Q + (size_t)(wid * QBLK + r32) * PIN + d0 * 16 + hi * 8);
    SBAR();
    finishSM(pA0, pA1, alA, l_reg, pa0, pa1, pa2, pa3); SBAR();
    pv_tile(o, vb0 + (even ? bp : bt) * SHM_V, pa0, pa1, pa2, pa3);
    if (even) { MASKT(pB0, pB1, NT - 1); partialSM_shift(pB0, pB1, m_reg, negm, alB); __syncthreads(); RESC(alB);
        finishSM(pB0, pB1, alB, l_reg, pa0, pa1, pa2, pa3); SBAR(); pv_tile(o, vb0 + bt * SHM_V, pa0, pa1, pa2, pa3); }
    SBAR(); SEAM_K0();
    if (hi == 0) li_l[r32] = l_reg; asm volatile("s_waitcnt lgkmcnt(0)" ::: "memory");
    float rli[16];
#pragma unroll
    for (int r = 0; r < 16; ++r) rli[r] = __builtin_amdgcn_rcpf(li_l[crow(r, hi)]);
    bf16* Ow = cur.O + (size_t)(wid * QBLK) * POUT;
    bf16* stg = (bf16*)(lds + OSTAGE_OFF) + wid * 2048;
#pragma unroll
    for (int h2 = 0; h2 < 2; ++h2) {
#pragma unroll
        for (int r = 0; r < 16; ++r) { const int orow = crow(r, hi);
#pragma unroll
            for (int dd = 0; dd < 2; ++dd) stg[orow * 64 + dd * 32 + r32] = __float2bfloat16(o[2 * h2 + dd][r] * rli[r]); }
        asm volatile("s_waitcnt lgkmcnt(0)" ::: "memory");
#pragma unroll
        for (int i = 0; i < 4; ++i) { const int row = i * 8 + (lane >> 3), ch = lane & 7; const u32x4 v = *(const u32x4*)(stg + row * 64 + ch * 8);
            { bf16* p_ = Ow + (size_t)row * POUT + h2 * 64 + ch * 8; asm volatile("global_store_dwordx4 %0, %1, off sc1\n\ts_nop 1" :: "v"(p_), "v"(v) : "memory"); } }
        asm volatile("s_waitcnt lgkmcnt(0)" ::: "memory");
    }
    __syncthreads();
#undef RESC
#undef KBASE
#undef MASKT
#undef SEAM_K0
#undef HALF_STEP
#undef ROTB
}
#undef VMW
#undef VMWN
#undef SLOAD_H
#undef SWRITE_HK
#undef SWRITE_HV
#undef SWRITE_H
#undef KSWZ
#undef SBAR
}

namespace cg = cooperative_groups;
constexpr int NWAVES = 8;
#ifndef MK_N_LAUNCHES
#define MK_N_LAUNCHES 1
#endif
constexpr int NPHASE = 14;

constexpr int M = 16384, DMOD = 1024, SEQL = 2048, NBATCH = 8, DFF = 2816, INC = 3072;
constexpr int NMT_UP = 65;

constexpr size_t MiB = 1u << 20;
constexpr size_t WS_CTL = 0, CTL_ZERO_BYTES = 64 * 1024;
#ifndef CTL_GLOBAL
#define CTL_GLOBAL 1
#endif
__device__ unsigned g_ctl[CTL_ZERO_BYTES / 4];
constexpr int CW_DEPART = 64;
constexpr int CW_PANEL = 8192;
constexpr int CW_BAR = 1024;
constexpr size_t WS_IDENT = 128 * 1024;
constexpr size_t WS_SS = 1 * MiB;
constexpr size_t WS_ROPE = 2 * MiB;
constexpr size_t WS_W = 3 * MiB;
constexpr size_t W_IN_OFF = 0, W_OUT_OFF = 6 * MiB, W_UP_OFF = 8 * MiB, W_DOWN_OFF = 19 * MiB, W_LAYER = 24 * MiB + MiB / 2;
constexpr size_t WS_XB = 52 * MiB + MiB / 2;
constexpr size_t WS_PROJ = 85 * MiB;
constexpr size_t WS_ACT = 85 * MiB;
constexpr size_t WS_OB = 181 * MiB;
constexpr size_t WS_MIX = 213 * MiB;
constexpr size_t WS_END = 245 * MiB;
static_assert(WS_W + 2 * W_LAYER <= WS_XB - MiB / 2 && WS_XB + (size_t)M * DMOD * 2 + MiB / 2 <= WS_PROJ && WS_PROJ + (size_t)M * INC * 2 <= WS_OB && WS_ACT + (size_t)M * DFF * 2 <= WS_OB && WS_MIX + (size_t)M * DMOD * 2 <= WS_END, "d_ws map");

constexpr int RING_OFF = 0, RING_BYTES = 131072;
constexpr int DMASK_TBL_OFF = 86016;
constexpr int HALO_OFF = RING_BYTES;
constexpr int MISC_OFF = HALO_OFF + 4096;
constexpr int P0_SCR_BYTES = 64 * 65 * 4;
constexpr int LRSTD_OFF = MISC_OFF + 256;
constexpr int LROPE_OFF = LRSTD_OFF + 1024;
constexpr int LCW_OFF = LROPE_OFF + 16384;
constexpr int LDS_BYTES = 155648;
static_assert(attn_b::LDS_BYTES <= DMASK_TBL_OFF && NWAVES * P0_SCR_BYTES <= MISC_OFF && LCW_OFF + 1536 <= LDS_BYTES && LDS_BYTES <= 163840 && attn_body::ATTN_LDS_BYTES <= DMASK_TBL_OFF && DMASK_TBL_OFF + attn_body::DMASK_TBL_N * 4 <= attn_b::OSTAGE_OFF && attn_b::OSTAGE_OFF + 32768 <= RING_BYTES, "LDS map");

#define GAS __attribute__((address_space(1)))
#define LAS __attribute__((address_space(3)))
typedef unsigned short bf16;
typedef unsigned v4u __attribute__((ext_vector_type(4)));
typedef unsigned v2u __attribute__((ext_vector_type(2)));
__device__ __forceinline__ void st16_wt(void* p, v4u w) { asm volatile("global_store_dwordx4 %0, %1, off sc1\n\ts_nop 1" :: "v"(p), "v"(w) : "memory"); }
__device__ __forceinline__ void st8_wt(void* p, v2u w) { asm volatile("global_store_dwordx2 %0, %1, off sc1\n\ts_nop 1" :: "v"(p), "v"(w) : "memory"); }
typedef float f32x4 __attribute__((ext_vector_type(4)));
#define LDS_WAIT() asm volatile("s_waitcnt lgkmcnt(0)" ::: "memory")
__device__ __forceinline__ unsigned f2bf(float f) { unsigned u = __builtin_bit_cast(unsigned, f); return (u + 0x7fffu + ((u >> 16) & 1u)) >> 16; }
__device__ __forceinline__ unsigned pk2(float lo, float hi) { return f2bf(lo) | (f2bf(hi) << 16); }
__device__ __forceinline__ float bflo(unsigned w) { return __builtin_bit_cast(float, w << 16); }
__device__ __forceinline__ float bfhi(unsigned w) { return __builtin_bit_cast(float, w & 0xffff0000u); }
__device__ __forceinline__ float wave_sum(float v) {
#pragma unroll
    for (int o = 1; o < 64; o <<= 1) v += __shfl_xor(v, o);
    return v;
}

#define XB_TMO      128
#define XB_XCNT(j)  (256  + 64 * (j))
#define XB_XSUB(j)  (1280 + 64 * (j))
#define XB_XGEN(j)  (2304 + 64 * (j))
#define XB_TOP      3328
#define XB_TOPGEN   3392
#define XCD_BAR_WORDS 3456
#define XB_SPIN_CAP (1u << 18)

__device__ __forceinline__ unsigned xb_ld(unsigned* p)              { return __hip_atomic_load(p, __ATOMIC_RELAXED, __HIP_MEMORY_SCOPE_AGENT); }
__device__ __forceinline__ unsigned xb_add(unsigned* p, unsigned v) { return __hip_atomic_fetch_add(p, v, __ATOMIC_RELAXED, __HIP_MEMORY_SCOPE_AGENT); }
__device__ __forceinline__ unsigned xb_xcc_id() { return (unsigned)__builtin_amdgcn_s_getreg((3 << 11) | 20) & 0xFu; }
#define XB_SPIN(cond, bar) do { unsigned _sp = 0; while (cond) { __builtin_amdgcn_s_sleep(1); \
    if ((++_sp & 255u) == 0u) { if (xb_ld(&(bar)[XB_TMO])) break; if (_sp > XB_SPIN_CAP) { atomicAdd(&(bar)[XB_TMO], 1u); break; } } } } while (0)

struct XcdBarrier {
    unsigned* bar; unsigned x;
    volatile LAS unsigned* st;
};

__device__ __forceinline__ XcdBarrier xcd_barrier_post(unsigned* bar, volatile LAS unsigned* st) {
    XcdBarrier b; b.bar = bar; b.x = xb_xcc_id(); b.st = st;
    if (threadIdx.x == 0) (void)xb_add(&bar[XB_XCNT(b.x)], 1u);
    return b;
}
__device__ __forceinline__ void xcd_barrier_complete(unsigned* bar, unsigned x, unsigned& nloc, unsigned& nx) {
    const unsigned G = gridDim.x * gridDim.y * gridDim.z;
    unsigned sum, cnt, mine, sp = 0u;
    asm volatile("" : "+s"(bar));
    for (;;) {
        sum = 0u; cnt = 0u; mine = 0u;
#pragma unroll
        for (unsigned j = 0; j < 16; ++j) { const unsigned c = xb_ld(&bar[XB_XCNT(j)]); sum += c; cnt += (c > 0u) ? 1u : 0u; }
        mine = xb_ld(&bar[XB_XCNT(x)]);
        if (sum == G) break;
        __builtin_amdgcn_s_sleep(1);
        if ((++sp & 255u) == 0u) { if (xb_ld(&bar[XB_TMO])) break; if (sp > XB_SPIN_CAP) { atomicAdd(&bar[XB_TMO], 1u); break; } }
    }
    nloc = mine > 0u ? mine : 1u; nx = cnt > 0u ? cnt : 1u;
}

__device__ __forceinline__ void xcd_barrier(const XcdBarrier& b) {
    asm volatile("s_waitcnt vmcnt(0)" ::: "memory");
    __syncthreads();
    if (threadIdx.x == 0) {
#if CTL_GLOBAL
        unsigned* bar = g_ctl + CW_BAR;
        asm volatile("" : "+s"(bar));
#else
        unsigned* bar = b.bar;
#endif
        __builtin_amdgcn_s_waitcnt(0);
        unsigned nloc = b.st[0], nx = b.st[1];
        if (nloc == 0u) { xcd_barrier_complete(bar, b.x, nloc, nx); b.st[0] = nloc; b.st[1] = nx; }
        const unsigned old = xb_add(&bar[XB_XSUB(b.x)], 1u);
        const unsigned gen = old / nloc;
        if (old + 1u == (gen + 1u) * nloc) {
            __builtin_amdgcn_fence(__ATOMIC_RELEASE, "agent");
            asm volatile("s_waitcnt vmcnt(0)" ::: "memory");
            const unsigned og = xb_add(&bar[XB_TOP], 1u);
            const unsigned tg = og / nx;
            if (og + 1u == (tg + 1u) * nx) xb_add(&bar[XB_TOPGEN], 1u);
            else XB_SPIN(xb_ld(&bar[XB_TOPGEN]) == tg, bar);
            xb_add(&bar[XB_XGEN(b.x)], 1u);
            __builtin_amdgcn_fence(__ATOMIC_ACQUIRE, "agent");
            asm volatile("s_waitcnt vmcnt(0)" ::: "memory");
        } else {
            XB_SPIN(xb_ld(&bar[XB_XGEN(b.x)]) == gen, bar);
            __builtin_amdgcn_fence(__ATOMIC_ACQUIRE, "agent");
            asm volatile("s_waitcnt vmcnt(0)" ::: "memory");
        }
    }
    __syncthreads();
}

struct Args { const float* in[16]; float* out; unsigned char* ws; int ph_lo, ph_hi; };
static_assert(sizeof(Args) == 16 * 8 + 8 + 8 + 8, "Args has no padding");

struct Frame {
    LAS unsigned char* lds;
    int tid, lane, wave, vcu, G;
    float* out; unsigned char* ws;
};
__device__ __forceinline__ const float* karg_in(int i) {
    const __attribute__((address_space(4))) char* kp = (const __attribute__((address_space(4))) char*)__builtin_amdgcn_kernarg_segment_ptr();
    asm volatile("" : "+s"(kp));
    return ((const float* const __attribute__((address_space(4)))*)kp)[i];
}

__device__ __forceinline__ void p0_transpose_item(const float* W, int K, int N, bf16* WT, int k0, int n0, int drow0, const float* gain, LAS float* scr, int lane, bool rot16 = false) {
    const int lr = lane >> 4, lc = (lane & 15) * 4;
    f32x4 v[16];
#pragma unroll
    for (int i = 0; i < 16; ++i) v[i] = __builtin_nontemporal_load((const f32x4*)(W + (size_t)(k0 + lr + 4 * i) * N + n0 + lc));
    if (gain) {
#pragma unroll
        for (int i = 0; i < 16; ++i) v[i] = v[i] * gain[k0 + lr + 4 * i];
    }
#pragma unroll
    for (int i = 0; i < 16; ++i) { LAS float* p = scr + (lr + 4 * i) * 65 + lc; p[0] = v[i].x; p[1] = v[i].y; p[2] = v[i].z; p[3] = v[i].w; }
    LDS_WAIT(); asm volatile("" ::: "memory");
    const int c = lane >> 3, nn = lane & 7;
#pragma unroll
    for (int j = 0; j < 8; ++j) { const int n = nn + 8 * j; const LAS float* q = scr + (8 * c) * 65 + n;
        v4u o; o.x = pk2(q[0 * 65], q[1 * 65]); o.y = pk2(q[2 * 65], q[3 * 65]); o.z = pk2(q[4 * 65], q[5 * 65]); o.w = pk2(q[6 * 65], q[7 * 65]);
        const int nd = (rot16 && n < 16) ? ((n & 3) | ((n & 4) << 1) | ((n & 8) >> 1)) : n;
        *(v4u*)(WT + (size_t)(drow0 + nd) * K + k0 + 8 * c) = o; }
    LDS_WAIT(); asm volatile("" ::: "memory");
}
__device__ __forceinline__ int in_dest_row(int n0) { if (n0 < 2560) return n0; const int j = n0 - 2560, half = j >= 256 ? 1 : 0, jj = j - half * 256; return 2560 + (jj >> 7) * 256 + half * 128 + (jj & 127); }
__device__ __forceinline__ int up_dest_row(int n0) { const int half = n0 >= DFF ? 1 : 0, n = n0 - half * DFF; return (n >> 7) * 256 + half * 128 + (n & 127); }

constexpr int CV_IN = (DMOD / 64) * (INC / 64), CV_OUT = (DMOD / 64) * (DMOD / 64), CV_UP = (DMOD / 64) * (2 * DFF / 64), CV_DN = (DFF / 64) * (DMOD / 64), CV_LAYER = CV_IN + CV_OUT + CV_UP + CV_DN;
__device__ __forceinline__ void p0_convert_range(Frame& F, int g_lo, int n, int h_lo, int h_n, int widx, int nw) {
    { int t_ = threadIdx.x; asm volatile("" : "+v"(t_)); F.tid = t_; F.lane = t_ & 63; }
    LAS float* scr = (LAS float*)(F.lds + RING_OFF + F.wave * P0_SCR_BYTES);
    constexpr int I_IN = CV_IN, I_OUT = CV_OUT, I_UP = CV_UP;
    for (int idx = widx; idx < n; idx += nw) {
        int g = g_lo + idx; if (g >= h_lo) g += h_n;
        const int L = g >= CV_LAYER ? 1 : 0;
        unsigned char* wl = F.ws + WS_W + (size_t)L * W_LAYER;
        int r = g - L * CV_LAYER;
        if (r < I_IN) { const int nb = INC / 64, kb = r / nb, n0 = 64 * (r % nb);
            p0_transpose_item(karg_in(3) + (size_t)L * DMOD * INC, DMOD, INC, (bf16*)(wl + W_IN_OFF), 64 * kb, n0, in_dest_row(n0), karg_in(2) + L * DMOD, scr, F.lane, (n0 < 512) || (n0 >= 768 && n0 < 1792)); continue; }
        r -= I_IN;
        if (r < I_OUT) { const int nb = DMOD / 64, kb = r / nb, n0 = 64 * (r % nb);
            p0_transpose_item(karg_in(10) + (size_t)L * DMOD * DMOD, DMOD, DMOD, (bf16*)(wl + W_OUT_OFF), 64 * kb, n0, n0, nullptr, scr, F.lane); continue; }
        r -= I_OUT;
        if (r < I_UP) { const int nb = 2 * DFF / 64, kb = r / nb, n0 = 64 * (r % nb);
            p0_transpose_item(karg_in(12) + (size_t)L * DMOD * 2 * DFF, DMOD, 2 * DFF, (bf16*)(wl + W_UP_OFF), 64 * kb, n0, up_dest_row(n0), karg_in(11) + L * DMOD, scr, F.lane); continue; }
        r -= I_UP;
        { const int nb = DMOD / 64, kb = r / nb, n0 = 64 * (r % nb);
            p0_transpose_item(karg_in(14) + (size_t)L * DFF * DMOD, DFF, DMOD, (bf16*)(wl + W_DOWN_OFF), 64 * kb, n0, n0, nullptr, scr, F.lane); }
    }
}

__device__ __forceinline__ void p0_prologue(Frame& F) {
    const int gw = F.vcu * NWAVES + F.wave, NGW = F.G * NWAVES;
    p0_convert_range(F, 0, CV_IN, 1 << 30, 0, gw, NGW);
    bf16* XB = (bf16*)(F.ws + WS_XB); float* SS = (float*)(F.ws + WS_SS);
    for (int m = gw; m < M; m += NGW) {
        const f32x4* xr = (const f32x4*)(karg_in(0) + (size_t)m * DMOD) + F.lane;
        f32x4 v[4]; float s = 0.f;
#pragma unroll
        for (int j = 0; j < 4; ++j) { v[j] = __builtin_nontemporal_load(xr + 64 * j); s += (v[j].x * v[j].x + v[j].y * v[j].y) + (v[j].z * v[j].z + v[j].w * v[j].w); }
        s = wave_sum(s);
        unsigned long long* o8 = (unsigned long long*)(XB + (size_t)m * DMOD) + F.lane;
#pragma unroll
        for (int j = 0; j < 4; ++j) o8[64 * j] = (unsigned long long)pk2(v[j].x, v[j].y) | ((unsigned long long)pk2(v[j].z, v[j].w) << 32);
        if (F.lane < 16) SS[(size_t)m * 16 + F.lane] = (F.lane == 0) ? s : 0.f;
    }
    if (gw == 0 && F.lane < 16) ((float*)(F.ws + WS_IDENT))[F.lane] = F.lane < 8 ? 1.0f : 0.0f;
    const int* pos = (const int*)karg_in(1); float* rope = (float*)(F.ws + WS_ROPE);
    const int gt = (F.vcu * NWAVES + F.wave) * 64 + F.lane, NGT = F.G * NWAVES * 64;
    for (int idx = gt; idx < M * 8; idx += NGT) {
        const int m = idx >> 3, i = idx & 7;
        const double invd = (i == 0) ? 1.0 : (i == 1) ? 0.19392274474868576 : (i == 2) ? 0.03760603093086393 : (i == 3) ? 0.007292664737217109 : (i == 4) ? 0.001414213562373095 :
                            (i == 5) ? 0.0002742481756762073 : (i == 6) ? 5.318295896944988e-05 : 1.031338537721246e-05;
        const double ang = (double)pos[m] * (double)(float)invd;
        const double k = __builtin_rint(ang * 0.15915494309189535);
        const float r = (float)(ang - k * 6.283185307179586);
        rope[(size_t)m * 16 + i] = cosf(r); rope[(size_t)m * 16 + 8 + i] = sinf(r);
    }
}

__device__ __forceinline__ void p_combine(Frame& F, int L) {
    { int t_ = threadIdx.x; asm volatile("" : "+v"(t_)); F.tid = t_; F.lane = t_ & 63; }
    const int gw = F.vcu * NWAVES + F.wave, NGW = F.G * NWAVES, lane = F.lane;
    const float lam_init = 0.8f - 0.6f * expf(-0.3f * (float)L);
    const float d1 = wave_sum(karg_in(4)[L * 64 + lane] * karg_in(5)[L * 64 + lane]), d2 = wave_sum(karg_in(6)[L * 64 + lane] * karg_in(7)[L * 64 + lane]);
    const float lam = expf(d1) - expf(d2) + lam_init, osc = 1.0f - lam_init;
    const bf16* OB = (const bf16*)(F.ws + WS_OB); const bf16* PROJ = (const bf16*)(F.ws + WS_PROJ); bf16* MIX = (bf16*)(F.ws + WS_MIX);
    const int h = lane >> 4, e0 = (lane & 15) * 8, c0 = lane * 4;
    const float* sg = karg_in(8) + L * 128 + e0; const f32x4 g0 = *(const f32x4*)sg, g1 = *(const f32x4*)(sg + 4);
    const float* cw = karg_in(9) + L * 3 * 256 + c0; const f32x4 w0 = *(const f32x4*)cw, w1 = *(const f32x4*)(cw + 256), w2 = *(const f32x4*)(cw + 512);
    constexpr int UR = 4;
    for (int mb = gw; mb < M; mb += UR * NGW) {
        v4u a[UR], b[UR]; v2u cb[UR], cc[UR][3]; float f1[UR], f2[UR];
#pragma unroll
        for (int u = 0; u < UR; ++u) {
            const int m = mb + u * NGW, t = m & (SEQL - 1);
            const bf16* ob = OB + (size_t)m * 1024 + h * 256 + e0;
            a[u] = __builtin_nontemporal_load((const v4u*)ob); b[u] = __builtin_nontemporal_load((const v4u*)(ob + 128));
            const bf16* pr = PROJ + (size_t)m * INC + c0;
            const int o1 = t >= 1 ? INC : 0, o2 = t >= 2 ? 2 * INC : 0;
            f1[u] = t >= 1 ? 1.f : 0.f; f2[u] = t >= 2 ? 1.f : 0.f;
            cb[u] = *(const v2u*)(pr + 2304);
            cc[u][2] = *(const v2u*)(pr + 2560);
            cc[u][1] = *(const v2u*)(pr - o1 + 2560);
            cc[u][0] = *(const v2u*)(pr - o2 + 2560);
        }
#pragma unroll
        for (int u = 0; u < UR; ++u) {
            const int m = mb + u * NGW;
            float o[8];
#pragma unroll
            for (int i = 0; i < 4; ++i) { o[2 * i] = bflo(a[u][i]) - lam * bflo(b[u][i]); o[2 * i + 1] = bfhi(a[u][i]) - lam * bfhi(b[u][i]); }
            float ss = 0.f;
#pragma unroll
            for (int i = 0; i < 8; ++i) ss += o[i] * o[i];
            ss += __shfl_xor(ss, 1); ss += __shfl_xor(ss, 2); ss += __shfl_xor(ss, 4); ss += __shfl_xor(ss, 8);
            const float rs = osc / sqrtf(ss * (1.0f / 128.0f) + 1e-5f);
            v4u w; w.x = pk2(o[0] * rs * g0[0], o[1] * rs * g0[1]); w.y = pk2(o[2] * rs * g0[2], o[3] * rs * g0[3]); w.z = pk2(o[4] * rs * g1[0], o[5] * rs * g1[1]); w.w = pk2(o[6] * rs * g1[2], o[7] * rs * g1[3]);
            st16_wt(MIX + (size_t)m * 1024 + 256 + h * 128 + e0, w);
            f32x4 acc;
            acc[0] = w2[0] * bflo(cc[u][2][0]); acc[1] = w2[1] * bfhi(cc[u][2][0]); acc[2] = w2[2] * bflo(cc[u][2][1]); acc[3] = w2[3] * bfhi(cc[u][2][1]);
            { const f32x4 ww = w1 * f1[u];
              acc[0] += ww[0] * bflo(cc[u][1][0]); acc[1] += ww[1] * bfhi(cc[u][1][0]); acc[2] += ww[2] * bflo(cc[u][1][1]); acc[3] += ww[3] * bfhi(cc[u][1][1]); }
            { const f32x4 ww = w0 * f2[u];
              acc[0] += ww[0] * bflo(cc[u][0][0]); acc[1] += ww[1] * bfhi(cc[u][0][0]); acc[2] += ww[2] * bflo(cc[u][0][1]); acc[3] += ww[3] * bfhi(cc[u][0][1]); }
            v2u oc; oc.x = pk2(bflo(cb[u][0]) * acc[0], bfhi(cb[u][0]) * acc[1]); oc.y = pk2(bflo(cb[u][1]) * acc[2], bfhi(cb[u][1]) * acc[3]);
            st8_wt(MIX + (size_t)m * 1024 + 768 + c0, oc);
        }
    }
}

__device__ __forceinline__ void p_final(Frame& F, float* dst) {
    { int t_ = threadIdx.x; asm volatile("" : "+v"(t_)); F.tid = t_; F.lane = t_ & 63; }
    const int gw = F.vcu * NWAVES + F.wave, NGW = F.G * NWAVES;
    const bf16* XBp = (const bf16*)(F.ws + WS_XB);
    const f32x4* gp = (const f32x4*)karg_in(15) + 2 * F.lane; f32x4 g[4];
#pragma unroll
    for (int j = 0; j < 2; ++j) { g[2 * j] = gp[128 * j]; g[2 * j + 1] = gp[128 * j + 1]; }
    for (int mb = gw; mb < M; mb += 2 * NGW) {
        v4u raw[2][2];
#pragma unroll
        for (int u = 0; u < 2; ++u)
#pragma unroll
            for (int j = 0; j < 2; ++j) raw[u][j] = *((const v4u*)(XBp + (size_t)(mb + u * NGW) * DMOD) + F.lane + 64 * j);
#pragma unroll
        for (int u = 0; u < 2; ++u) {
            f32x4 v[4]; float s = 0.f;
#pragma unroll
            for (int j = 0; j < 2; ++j) { const v4u r = raw[u][j];
                v[2 * j] = (f32x4){bflo(r.x), bfhi(r.x), bflo(r.y), bfhi(r.y)}; v[2 * j + 1] = (f32x4){bflo(r.z), bfhi(r.z), bflo(r.w), bfhi(r.w)}; }
#pragma unroll
            for (int j = 0; j < 4; ++j) s += (v[j].x * v[j].x + v[j].y * v[j].y) + (v[j].z * v[j].z + v[j].w * v[j].w);
            const float rs = 1.0f / sqrtf(wave_sum(s) * (1.0f / DMOD) + 1e-6f);
            f32x4* dr = (f32x4*)(dst + (size_t)(mb + u * NGW) * DMOD) + 2 * F.lane;
#pragma unroll
            for (int j = 0; j < 2; ++j) { dr[128 * j] = v[2 * j] * rs * g[2 * j]; dr[128 * j + 1] = v[2 * j + 1] * rs * g[2 * j + 1]; }
        }
    }
}

__device__ const unsigned short ATT_SCHED[256][8] = {
  {7,2,0,65535,65535,65535,65535,65535},{15,10,8,65535,65535,65535,65535,65535},{6,259,512,65535,65535,65535,65535,65535},{14,267,520,65535,65535,65535,65535,65535},
  {5,1,517,65535,65535,65535,65535,65535},{13,9,525,65535,65535,65535,65535,65535},{251,519,763,65535,65535,65535,65535,65535},{23,18,16,65535,65535,65535,65535,65535},
  {31,26,24,65535,65535,65535,65535,65535},{22,275,528,65535,65535,65535,65535,65535},{30,283,536,65535,65535,65535,65535,65535},{21,17,533,65535,65535,65535,65535,65535},
  {29,25,541,65535,65535,65535,65535,65535},{139,527,651,65535,65535,65535,65535,65535},{39,34,32,65535,65535,65535,65535,65535},{47,42,40,65535,65535,65535,65535,65535},
  {38,291,544,65535,65535,65535,65535,65535},{46,299,552,65535,65535,65535,65535,65535},{37,33,549,65535,65535,65535,65535,65535},{45,41,557,65535,65535,65535,65535,65535},
  {3,535,515,65535,65535,65535,65535,65535},{55,50,48,65535,65535,65535,65535,65535},{63,58,56,65535,65535,65535,65535,65535},{54,307,560,65535,65535,65535,65535,65535},
  {62,315,568,65535,65535,65535,65535,65535},{53,49,565,65535,65535,65535,65535,65535},{61,57,573,65535,65535,65535,65535,65535},{27,543,539,65535,65535,65535,65535,65535},
  {71,66,64,65535,65535,65535,65535,65535},{79,74,72,65535,65535,65535,65535,65535},{70,323,576,65535,65535,65535,65535,65535},{78,331,584,65535,65535,65535,65535,65535},
  {69,65,581,65535,65535,65535,65535,65535},{77,73,589,65535,65535,65535,65535,65535},{83,551,595,65535,65535,65535,65535,65535},{87,82,80,65535,65535,65535,65535,65535},
  {95,90,88,65535,65535,65535,65535,65535},{86,339,592,65535,65535,65535,65535,65535},{94,347,600,65535,65535,65535,65535,65535},{85,81,597,65535,65535,65535,65535,65535},
  {93,89,605,65535,65535,65535,65535,65535},{107,559,619,65535,65535,65535,65535,65535},{103,98,96,65535,65535,65535,65535,65535},{111,106,104,65535,65535,65535,65535,65535},
  {102,355,608,65535,65535,65535,65535,65535},{110,363,616,65535,65535,65535,65535,65535},{101,97,613,65535,65535,65535,65535,65535},{109,105,621,65535,65535,65535,65535,65535},
  {227,567,739,65535,65535,65535,65535,65535},{119,114,112,65535,65535,65535,65535,65535},{127,122,120,65535,65535,65535,65535,65535},{118,371,624,65535,65535,65535,65535,65535},
  {126,379,632,65535,65535,65535,65535,65535},{117,113,629,65535,65535,65535,65535,65535},{125,121,637,65535,65535,65535,65535,65535},{11,575,523,65535,65535,65535,65535,65535},
  {135,130,128,65535,65535,65535,65535,65535},{143,138,136,65535,65535,65535,65535,65535},{134,387,640,65535,65535,65535,65535,65535},{142,395,648,65535,65535,65535,65535,65535},
  {133,129,645,65535,65535,65535,65535,65535},{141,137,653,65535,65535,65535,65535,65535},{179,583,691,65535,65535,65535,65535,65535},{151,146,144,65535,65535,65535,65535,65535},
  {159,154,152,65535,65535,65535,65535,65535},{150,403,656,65535,65535,65535,65535,65535},{158,411,664,65535,65535,65535,65535,65535},{149,145,661,65535,65535,65535,65535,65535},
  {157,153,669,65535,65535,65535,65535,65535},{51,591,563,65535,65535,65535,65535,65535},{167,162,160,65535,65535,65535,65535,65535},{175,170,168,65535,65535,65535,65535,65535},
  {166,419,672,65535,65535,65535,65535,65535},{174,427,680,65535,65535,65535,65535,65535},{165,161,677,65535,65535,65535,65535,65535},{173,169,685,65535,65535,65535,65535,65535},
  {131,599,643,65535,65535,65535,65535,65535},{183,178,176,65535,65535,65535,65535,65535},{191,186,184,65535,65535,65535,65535,65535},{182,435,688,65535,65535,65535,65535,65535},
  {190,443,696,65535,65535,65535,65535,65535},{181,177,693,65535,65535,65535,65535,65535},{189,185,701,65535,65535,65535,65535,65535},{123,607,635,65535,65535,65535,65535,65535},
  {199,194,192,65535,65535,65535,65535,65535},{207,202,200,65535,65535,65535,65535,65535},{198,451,704,65535,65535,65535,65535,65535},{206,459,712,65535,65535,65535,65535,65535},
  {197,193,709,65535,65535,65535,65535,65535},{205,201,717,65535,65535,65535,65535,65535},{187,615,699,65535,65535,65535,65535,65535},{215,210,208,65535,65535,65535,65535,65535},
  {223,218,216,65535,65535,65535,65535,65535},{214,467,720,65535,65535,65535,65535,65535},{222,475,728,65535,65535,65535,65535,65535},{213,209,725,65535,65535,65535,65535,65535},
  {221,217,733,65535,65535,65535,65535,65535},{147,623,659,65535,65535,65535,65535,65535},{231,226,224,65535,65535,65535,65535,65535},{239,234,232,65535,65535,65535,65535,65535},
  {230,483,736,65535,65535,65535,65535,65535},{238,491,744,65535,65535,65535,65535,65535},{229,225,741,65535,65535,65535,65535,65535},{237,233,749,65535,65535,65535,65535,65535},
  {59,631,571,65535,65535,65535,65535,65535},{247,242,240,65535,65535,65535,65535,65535},{255,250,248,65535,65535,65535,65535,65535},{246,499,752,65535,65535,65535,65535,65535},
  {254,507,760,65535,65535,65535,65535,65535},{245,241,757,65535,65535,65535,65535,65535},{253,249,765,65535,65535,65535,65535,65535},{75,639,587,65535,65535,65535,65535,65535},
  {263,258,256,65535,65535,65535,65535,65535},{271,266,264,65535,65535,65535,65535,65535},{262,257,516,65535,65535,65535,65535,65535},{270,265,524,65535,65535,65535,65535,65535},
  {261,534,529,65535,65535,65535,65535,65535},{269,574,569,65535,65535,65535,65535,65535},{163,647,675,65535,65535,65535,65535,65535},{4,260,514,65535,65535,65535,65535,65535},
  {12,268,522,65535,65535,65535,65535,65535},{279,274,272,65535,65535,65535,65535,65535},{287,282,280,65535,65535,65535,65535,65535},{278,273,532,65535,65535,65535,65535,65535},
  {286,281,540,65535,65535,65535,65535,65535},{285,542,537,65535,65535,65535,65535,65535},{277,750,745,65535,65535,65535,65535,65535},{203,655,715,65535,65535,65535,65535,65535},
  {20,276,530,65535,65535,65535,65535,65535},{28,284,538,65535,65535,65535,65535,65535},{295,290,288,65535,65535,65535,65535,65535},{303,298,296,65535,65535,65535,65535,65535},
  {294,289,548,65535,65535,65535,65535,65535},{302,297,556,65535,65535,65535,65535,65535},{301,686,681,65535,65535,65535,65535,65535},{293,710,705,65535,65535,65535,65535,65535},
  {219,663,731,65535,65535,65535,65535,65535},{36,292,546,65535,65535,65535,65535,65535},{44,300,554,65535,65535,65535,65535,65535},{311,306,304,65535,65535,65535,65535,65535},
  {319,314,312,65535,65535,65535,65535,65535},{310,305,564,65535,65535,65535,65535,65535},{318,313,572,65535,65535,65535,65535,65535},{309,590,585,65535,65535,65535,65535,65535},
  {317,630,625,65535,65535,65535,65535,65535},{99,671,611,65535,65535,65535,65535,65535},{52,308,562,65535,65535,65535,65535,65535},{60,316,570,65535,65535,65535,65535,65535},
  {327,322,320,65535,65535,65535,65535,65535},{335,330,328,65535,65535,65535,65535,65535},{326,321,580,65535,65535,65535,65535,65535},{334,329,588,65535,65535,65535,65535,65535},
  {333,638,633,65535,65535,65535,65535,65535},{325,678,673,65535,65535,65535,65535,65535},{67,679,579,65535,65535,65535,65535,65535},{68,324,578,65535,65535,65535,65535,65535},
  {76,332,586,65535,65535,65535,65535,65535},{343,338,336,65535,65535,65535,65535,65535},{351,346,344,65535,65535,65535,65535,65535},{342,337,596,65535,65535,65535,65535,65535},
  {350,345,604,65535,65535,65535,65535,65535},{341,550,545,65535,65535,65535,65535,65535},{349,726,721,65535,65535,65535,65535,65535},{43,687,555,65535,65535,65535,65535,65535},
  {84,340,594,65535,65535,65535,65535,65535},{92,348,602,65535,65535,65535,65535,65535},{359,354,352,65535,65535,65535,65535,65535},{367,362,360,65535,65535,65535,65535,65535},
  {358,353,612,65535,65535,65535,65535,65535},{366,361,620,65535,65535,65535,65535,65535},{365,558,553,65535,65535,65535,65535,65535},{357,670,665,65535,65535,65535,65535,65535},
  {243,695,755,65535,65535,65535,65535,65535},{100,356,610,65535,65535,65535,65535,65535},{108,364,618,65535,65535,65535,65535,65535},{375,370,368,65535,65535,65535,65535,65535},
  {383,378,376,65535,65535,65535,65535,65535},{374,369,628,65535,65535,65535,65535,65535},{382,377,636,65535,65535,65535,65535,65535},{381,606,601,65535,65535,65535,65535,65535},
  {373,702,697,65535,65535,65535,65535,65535},{115,703,627,65535,65535,65535,65535,65535},{116,372,626,65535,65535,65535,65535,65535},{124,380,634,65535,65535,65535,65535,65535},
  {391,386,384,65535,65535,65535,65535,65535},{399,394,392,65535,65535,65535,65535,65535},{390,385,644,65535,65535,65535,65535,65535},{398,393,652,65535,65535,65535,65535,65535},
  {397,526,521,65535,65535,65535,65535,65535},{389,598,593,65535,65535,65535,65535,65535},{35,711,547,65535,65535,65535,65535,65535},{132,388,642,65535,65535,65535,65535,65535},
  {140,396,650,65535,65535,65535,65535,65535},{407,402,400,65535,65535,65535,65535,65535},{415,410,408,65535,65535,65535,65535,65535},{406,401,660,65535,65535,65535,65535,65535},
  {414,409,668,65535,65535,65535,65535,65535},{405,622,617,65535,65535,65535,65535,65535},{413,734,729,65535,65535,65535,65535,65535},{235,719,747,65535,65535,65535,65535,65535},
  {148,404,658,65535,65535,65535,65535,65535},{156,412,666,65535,65535,65535,65535,65535},{423,418,416,65535,65535,65535,65535,65535},{431,426,424,65535,65535,65535,65535,65535},
  {422,417,676,65535,65535,65535,65535,65535},{430,425,684,65535,65535,65535,65535,65535},{421,646,641,65535,65535,65535,65535,65535},{429,758,753,65535,65535,65535,65535,65535},
  {91,727,603,65535,65535,65535,65535,65535},{164,420,674,65535,65535,65535,65535,65535},{172,428,682,65535,65535,65535,65535,65535},{439,434,432,65535,65535,65535,65535,65535},
  {447,442,440,65535,65535,65535,65535,65535},{438,433,692,65535,65535,65535,65535,65535},{446,441,700,65535,65535,65535,65535,65535},{437,582,577,65535,65535,65535,65535,65535},
  {445,614,609,65535,65535,65535,65535,65535},{155,735,667,65535,65535,65535,65535,65535},{180,436,690,65535,65535,65535,65535,65535},{188,444,698,65535,65535,65535,65535,65535},
  {455,450,448,65535,65535,65535,65535,65535},{463,458,456,65535,65535,65535,65535,65535},{454,449,708,65535,65535,65535,65535,65535},{462,457,716,65535,65535,65535,65535,65535},
  {461,654,649,65535,65535,65535,65535,65535},{453,742,737,65535,65535,65535,65535,65535},{195,743,707,65535,65535,65535,65535,65535},{196,452,706,65535,65535,65535,65535,65535},
  {204,460,714,65535,65535,65535,65535,65535},{471,466,464,65535,65535,65535,65535,65535},{479,474,472,65535,65535,65535,65535,65535},{470,465,724,65535,65535,65535,65535,65535},
  {478,473,732,65535,65535,65535,65535,65535},{477,662,657,65535,65535,65535,65535,65535},{469,766,761,65535,65535,65535,65535,65535},{19,751,531,65535,65535,65535,65535,65535},
  {212,468,722,65535,65535,65535,65535,65535},{220,476,730,65535,65535,65535,65535,65535},{487,482,480,65535,65535,65535,65535,65535},{495,490,488,65535,65535,65535,65535,65535},
  {486,481,740,65535,65535,65535,65535,65535},{494,489,748,65535,65535,65535,65535,65535},{485,566,561,65535,65535,65535,65535,65535},{493,718,713,65535,65535,65535,65535,65535},
  {171,759,683,65535,65535,65535,65535,65535},{228,484,738,65535,65535,65535,65535,65535},{236,492,746,65535,65535,65535,65535,65535},{503,498,496,65535,65535,65535,65535,65535},
  {511,506,504,65535,65535,65535,65535,65535},{502,497,756,65535,65535,65535,65535,65535},{510,505,764,65535,65535,65535,65535,65535},{509,518,513,65535,65535,65535,65535,65535},
  {501,694,689,65535,65535,65535,65535,65535},{211,767,723,65535,65535,65535,65535,65535},{244,500,754,65535,65535,65535,65535,65535},{252,508,762,65535,65535,65535,65535,65535},
};

__device__ __forceinline__ attn_b::BlockRef bref(const attn_b::bf16* PROJ, attn_b::bf16* OB, int id) {
    const int qb = id & 7, pr = (id >> 3) & 1, h = (id >> 4) & 3, b = id >> 6;
    attn_b::BlockRef r; const size_t row0 = (size_t)b * SEQL;
    r.Q = PROJ + (row0 + qb * 256) * INC + 768 + h * 128 + pr * 64;
    r.K = PROJ + row0 * INC + 1280 + h * 128 + pr * 64;
    r.V = PROJ + row0 * INC + 1792 + h * 128;
    r.O = OB + (row0 + qb * 256) * 1024 + h * 256 + pr * 128;
    r.P0 = qb * 256;
    return r;
}
__device__ __forceinline__ void p_attention(Frame& F, unsigned char* ldsg, int kind = 0) {
    using abf = attn_body::bf16;
    const abf* PROJ = (const abf*)(F.ws + WS_PROJ); abf* OB = (abf*)(F.ws + WS_OB); abf* MIX = (abf*)(F.ws + WS_MIX);
    { int t_ = threadIdx.x; asm volatile("" : "+v"(t_)); LAS float* tb = (LAS float*)(F.lds + DMASK_TBL_OFF);
      for (int x = t_; x < attn_body::DMASK_TBL_N; x += NWAVES * 64) tb[x] = attn_body::dwl(2047 - x);
      __syncthreads(); }
    const unsigned tbl = (unsigned)(uintptr_t)(ldsg + DMASK_TBL_OFF);
    constexpr int NSL = 8;
    const bool tab = (F.G == 256);
    auto unit_id = [&](int i) -> int { if (tab) return i < NSL ? (int)ATT_SCHED[F.vcu][i] : 0xFFFF; const int id = F.vcu + i * F.G; return id < 768 ? id : 0xFFFF; };
    if (kind != 1) {
        int i = 0, id = unit_id(0);
        while (id != 0xFFFF && id >= 512) id = unit_id(++i);
        if (id != 0xFFFF) {
            attn_b::Seam S; attn_b::BlockRef cur = bref(PROJ, OB, id);
            attn_b::causal_prime(cur, (char*)ldsg, S);
            for (;;) {
                int idn = unit_id(++i);
                while (idn != 0xFFFF && idn >= 512) idn = unit_id(++i);
                const bool last = (idn == 0xFFFF);
                const attn_b::BlockRef nxt = last ? cur : bref(PROJ, OB, idn);
#if defined(PRB_ABL) && PRB_ABL > 0
                if (kind == 2) attn_b::causal_block<PRB_ABL>(cur, nxt, (char*)ldsg, S); else
#endif
                attn_b::causal_block<0>(cur, nxt, (char*)ldsg, S);
                if (last) break;
                cur = nxt;
            }
        }
    }
    if (kind != 2) {
        for (int i = 0;; ++i) {
            const int id = unit_id(i);
            if (id == 0xFFFF) break;
            if (id < 512) continue;
            const int k = id - 512, qb = k & 7, h = (k >> 3) & 3, b = k >> 5;
            attn_body::attn_unit<8, 1>(b, qb, PROJ + h * 64, PROJ + 256 + h * 64, PROJ + 512 + h * 64, MIX + h * 64, 1024, (char*)ldsg, tbl);
        }
    }
}

__global__ void __launch_bounds__(NWAVES * 64, 2) hybrid_fwd(Args args) {
    extern __shared__ __attribute__((aligned(16))) unsigned char lds[];
    Frame F;
    F.lds = (LAS unsigned char*)lds;
    F.tid = threadIdx.x; F.lane = F.tid & 63; F.wave = __builtin_amdgcn_readfirstlane(F.tid >> 6);
    F.G = gridDim.x; { const int bx = blockIdx.x; F.vcu = (F.G % 8 == 0) ? (bx % 8) * (F.G / 8) + bx / 8 : bx; }
    F.out = args.out; F.ws = args.ws;
    const int lo = args.ph_lo, hi = args.ph_hi;
#if MK_N_LAUNCHES == 1
    if (hi > NPHASE) cg::this_grid().sync();
#endif
#if MK_N_LAUNCHES == 1
    for (int u = F.tid; u < 64; u += NWAVES * 64) ((LAS unsigned*)(F.lds + MISC_OFF))[u] = 0u;
    __syncthreads();
#if CTL_GLOBAL
#define ctl g_ctl
#else
    unsigned* const ctl = (unsigned*)(F.ws + WS_CTL);
#endif
    const XcdBarrier bar = xcd_barrier_post(ctl + CW_BAR, (volatile LAS unsigned*)(F.lds + MISC_OFF) + 8);
#endif
#ifndef DBG_MASK
#define DBG_MASK 0xffffffu
#endif
#define IN(k) (((DBG_MASK >> ((k) > 6 && (k) < 13 ? (k) - 6 : (k))) & 1u) && lo <= (k) && (k) < hi)
#if MK_N_LAUNCHES == 1
#define SEAM(k) do { if (IN(k) && IN((k) + 1)) { xcd_barrier(bar); } } while (0)
#else
#define SEAM(k) do { } while (0)
#endif
    bf16* XB = (bf16*)(F.ws + WS_XB); float* SS = (float*)(F.ws + WS_SS);

#ifndef PRB_P0
#define PRB_P0 0
#endif
#ifndef PRB_IN
#define PRB_IN 0
#endif
#ifndef PRB_ATT
#define PRB_ATT 0
#endif
#ifndef PRB_ATT_KIND
#define PRB_ATT_KIND 0
#endif
#ifndef PRB_CMB
#define PRB_CMB 0
#endif
#ifndef PRB_OUT
#define PRB_OUT 0
#endif
#ifndef PRB_UP
#define PRB_UP 0
#endif
#ifndef PRB_DN
#define PRB_DN 0
#endif
#ifndef PRB_FIN
#define PRB_FIN 0
#endif
#if MK_N_LAUNCHES == 1
#define XSEAM() xcd_barrier(bar)
#else
#define XSEAM() do { } while (0)
#endif
    const bool fuse_final = (MK_N_LAUNCHES == 1) && (F.G == 256) && (PRB_FIN == 0);
    for (int r_ = 0; r_ < PRB_P0; ++r_) { p0_prologue(F); XSEAM(); }
#ifndef TSM
#define TSM 0
#endif
    long long ts_acc = 0;
#define TSA(ty) do { if ((TSM >> (ty)) & 1) ts_acc -= (long long)__builtin_amdgcn_s_memrealtime(); } while (0)
#define TSB(ty) do { if ((TSM >> (ty)) & 1) ts_acc += (long long)__builtin_amdgcn_s_memrealtime(); } while (0)
    TSA(0); if (IN(0)) { p0_prologue(F); } SEAM(0); TSB(0);

#pragma unroll 1
    for (int L = 0; L < 2; ++L) {
        const int pb = 1 + 6 * L;
        TSA(1);
        unsigned char* wl = F.ws + WS_W + (size_t)L * W_LAYER;
        const int cvst = (L == 0 && IN(pb)) ? ((((int)blockIdx.x >> 3) & 1) ? 0 : 2) : -1;
        for (int r_ = 0; r_ < ((L == 0) ? 1 + PRB_IN : 1); ++r_) {
        if (r_) XSEAM();
#pragma unroll 1
        for (int st_ = 0; st_ < 3; ++st_) {
        if (st_ == cvst && r_ == 0) { __syncthreads(); p0_convert_range(F, CV_IN, CV_OUT + CV_UP + CV_IN, CV_LAYER - CV_DN, CV_DN, F.vcu * NWAVES + F.wave, F.G * NWAVES); __syncthreads(); }
        if (st_ == 1 && IN(pb)) {
            pg8::Gemm g{XB, (const bf16*)(wl + W_IN_OFF), DMOD, 256}; pg8::StaticOrder S; S.init(M / 256, INC / 256, F.G, (int)blockIdx.x);
            pg8::EpiInProj E{(bf16*)(F.ws + WS_PROJ), SS, (const float*)(F.ws + WS_ROPE), (LAS float*)(F.lds + LRSTD_OFF), (LAS float*)(F.lds + LROPE_OFF)};
#if defined(PRB_STAG_IN)
            if (((int)blockIdx.x >> 3) & 1) { const unsigned long long t0 = __builtin_amdgcn_s_memrealtime(); while (__builtin_amdgcn_s_memrealtime() - t0 < (unsigned long long)(PRB_STAG_IN)) __builtin_amdgcn_s_sleep(4); }
#endif
#ifdef PRB_EPITIME
            if (F.tid == 0) ((volatile LAS unsigned*)(F.lds + MISC_OFF))[43] = 1 + ((g.K > 1024) ? 2 : 0) * (1 == 2);
            __syncthreads();
#endif
            pg8::gemm_phase<pg8::EpiInProj, pg8::StaticOrder, true, true>(F.lds + RING_OFF, g, S, E);
        }
        }
        }
        SEAM(pb);
        TSB(1); TSA(2);
#ifdef TSW_BLK
        if (L == TSW_LAYER) ts_acc -= (long long)__builtin_amdgcn_s_memrealtime();
#endif
        for (int r_ = 0; r_ < ((L == 0) ? 1 + PRB_ATT : 1); ++r_) { if (r_) XSEAM(); if (IN(pb + 1)) { p_attention(F, lds + RING_OFF, (r_ + 1 < ((L == 0) ? 1 + PRB_ATT : 1)) ? PRB_ATT_KIND : 0); } }
#ifdef TSW_BLK
        if (L == TSW_LAYER) ts_acc += (long long)__builtin_amdgcn_s_memrealtime();
#endif
        SEAM(pb + 1);
        TSB(2); TSA(3);
        for (int r_ = 0; r_ < ((L == 0) ? 1 + PRB_CMB : 1); ++r_) { if (r_) XSEAM(); if (IN(pb + 2)) { p_combine(F, L); } }
        SEAM(pb + 2);
        TSB(3); TSA(4);
        for (int r_ = 0, nr_ = ((L == 0) ? 1 + PRB_OUT : 1); r_ < nr_; ++r_) {
        if (r_) XSEAM();
        if (IN(pb + 3)) {
            pg8::Gemm g{(const bf16*)(F.ws + WS_MIX), (const bf16*)(wl + W_OUT_OFF), DMOD, 256}; pg8::StaticOrder S; S.init(M / 256, DMOD / 256, F.G, (int)blockIdx.x);
#ifdef PRB_NOSTORE
            pg8::EpiResid E{XB, (r_ + 1 < nr_) ? (bf16*)nullptr : XB, SS};
#else
            pg8::EpiResid E{XB, (r_ + 1 < nr_) ? (bf16*)(F.ws + WS_PROJ) : XB, SS};
#endif
#ifdef PRB_EPITIME
            if (F.tid == 0) ((volatile LAS unsigned*)(F.lds + MISC_OFF))[43] = 2 + ((g.K > 1024) ? 2 : 0) * (2 == 2);
            __syncthreads();
#endif
            pg8::gemm_phase<pg8::EpiResid, pg8::StaticOrder, true, true>(F.lds + RING_OFF, g, S, E);
        }
        }
        SEAM(pb + 3);
        TSB(4); TSA(5);
        for (int r_ = 0; r_ < ((L == 0) ? 1 + PRB_UP : 1); ++r_) {
        if (r_) XSEAM();
        if (IN(pb + 4)) {
            pg8::Gemm g{XB - 2 * DMOD, (const bf16*)(wl + W_UP_OFF), DMOD, 254}; pg8::StaticOrder S; S.init(NMT_UP, 2 * DFF / 256, F.G, (int)blockIdx.x, 1);
            pg8::EpiGlu E{(bf16*)(F.ws + WS_ACT), SS, karg_in(13) + (size_t)L * 3 * DFF, (LAS float*)(F.lds + HALO_OFF), (LAS float*)(F.lds + LRSTD_OFF), (LAS float*)(F.lds + LCW_OFF)};
#if defined(PRB_STAG_UP)
            if ((int)blockIdx.x >= 150) { const unsigned long long t0 = __builtin_amdgcn_s_memrealtime(); while (__builtin_amdgcn_s_memrealtime() - t0 < (unsigned long long)(PRB_STAG_UP)) __builtin_amdgcn_s_sleep(4); }
#endif
#ifdef PRB_EPITIME
            if (F.tid == 0) ((volatile LAS unsigned*)(F.lds + MISC_OFF))[43] = 3 + ((g.K > 1024) ? 2 : 0) * (3 == 2);
            __syncthreads();
#endif
            pg8::gemm_phase<pg8::EpiGlu, pg8::StaticOrder, true, true>(F.lds + RING_OFF, g, S, E);
            if (r_ == 0) { const int nfull = NMT_UP * (2 * DFF / 256) - (NMT_UP * (2 * DFF / 256) / F.G) * F.G;
                const int g_lo = (L == 0) ? CV_LAYER - CV_DN : 2 * CV_LAYER - CV_DN, g_n = (L == 0) ? CV_DN + CV_OUT + CV_UP : CV_DN;
                const int g_hl = (L == 0) ? CV_LAYER : (1 << 30), g_hn = (L == 0) ? CV_IN : 0;
                const bool part = (nfull > 0 && nfull < F.G);
                const int clast = ((int)blockIdx.x + 8 * (NMT_UP * (2 * DFF / 256) / F.G)) % F.G;
                if (!part || clast >= nfull) p0_convert_range(F, g_lo, g_n, g_hl, g_hn, part ? (clast - nfull) * NWAVES + F.wave : F.vcu * NWAVES + F.wave, part ? (F.G - nfull) * NWAVES : F.G * NWAVES); }
        }
        }
        SEAM(pb + 4);
        TSB(5); TSA(6);
        for (int r_ = 0, nr_ = ((L == 0) ? 1 + PRB_DN : 1); r_ < nr_; ++r_) {
        if (r_) XSEAM();
        if (IN(pb + 5)) {
            pg8::Gemm g{(const bf16*)(F.ws + WS_ACT), (const bf16*)(wl + W_DOWN_OFF), DFF, 256}; pg8::StaticOrder S; S.init(M / 256, DMOD / 256, F.G, (int)blockIdx.x);
            if (L == 1 && r_ + 1 == nr_ && fuse_final) {
                pg8::EpiResidFinal E{XB, F.out, SS, karg_in(15), ctl + CW_PANEL, (LAS unsigned*)(F.lds + MISC_OFF) + 20};
#ifdef PRB_EPITIME
            if (F.tid == 0) ((volatile LAS unsigned*)(F.lds + MISC_OFF))[43] = 4 + ((g.K > 1024) ? 2 : 0) * (4 == 2);
            __syncthreads();
#endif
            pg8::gemm_phase<pg8::EpiResidFinal, pg8::StaticOrder, true, true>(F.lds + RING_OFF, g, S, E);
            } else {
            pg8::EpiResid E{XB, (r_ + 1 < nr_) ? (bf16*)(F.ws + WS_OB) : XB, SS};
#ifdef PRB_EPITIME
            if (F.tid == 0) ((volatile LAS unsigned*)(F.lds + MISC_OFF))[43] = 2 + ((g.K > 1024) ? 2 : 0) * (2 == 2);
            __syncthreads();
#endif
            pg8::gemm_phase<pg8::EpiResid, pg8::StaticOrder, true, true>(F.lds + RING_OFF, g, S, E);
            }
        }
        }
        if (!(L == 1 && fuse_final)) SEAM(pb + 5);
        TSB(6);
    }
    for (int r_ = 0; r_ < PRB_FIN; ++r_) { p_final(F, (float*)(F.ws + WS_OB)); XSEAM(); }
    if (IN(13) && !fuse_final) { p_final(F, F.out); }
#ifndef TSW_BLK
#define TSW_BLK 0
#else
#define TSM_ON 1
#endif
#if TSM != 0 || defined(TSM_ON)
#ifdef PRB_EPITIME
    if (F.vcu == TSW_BLK && F.tid == 0) ts_acc = (long long)((volatile LAS unsigned*)(F.lds + MISC_OFF))[44 + PRB_EPITIME];
#endif
    if (F.vcu == TSW_BLK && F.tid == 0) { const unsigned long long t0 = __builtin_amdgcn_s_memrealtime(); const unsigned long long w = (unsigned long long)(ts_acc > 0 ? ts_acc : 0) * 4ull;
        while (__builtin_amdgcn_s_memrealtime() - t0 < w) __builtin_amdgcn_s_sleep(8); }
#endif
#if MK_N_LAUNCHES == 1 && CTL_GLOBAL
    {
        asm volatile("s_waitcnt vmcnt(0)" ::: "memory");
        __syncthreads();
        volatile LAS unsigned* lastf = (volatile LAS unsigned*)(F.lds + MISC_OFF) + 40;
        if (F.tid == 0) { const unsigned old = xb_add(&ctl[CW_DEPART], 1u); *lastf = (old + 1u == (unsigned)F.G) ? 1u : 0u; }
        __syncthreads();
        if (*lastf) { int t0 = threadIdx.x; asm volatile("" : "+v"(t0));
            for (int u = t0; u < (int)(CTL_ZERO_BYTES / 4); u += NWAVES * 64) __hip_atomic_store(&ctl[u], 0u, __ATOMIC_RELAXED, __HIP_MEMORY_SCOPE_AGENT); }
    }
#endif
#undef IN
#undef SEAM
#undef ctl
}

extern "C" void kernel_launch(void* const* d_in, const int* in_sizes, int n_in, void* d_out, int out_size, void* d_ws, size_t ws_size, hipStream_t stream) {
    static int grid = 0;
    if (grid == 0) {
        if (n_in != 16 || in_sizes[0] != M * DMOD || out_size != M * DMOD || ws_size < WS_END) { fprintf(stderr, "kernel_launch: unexpected shapes (n_in %d, in0 %d, out %d, ws %zu)\n", n_in, n_in > 0 ? in_sizes[0] : -1, out_size, ws_size); grid = -1; return; }
        int dev = 0, cus = 0, per_cu = 0;
        if (hipGetDevice(&dev) != hipSuccess || hipDeviceGetAttribute(&cus, hipDeviceAttributeMultiprocessorCount, dev) != hipSuccess) { grid = -1; return; }
        if (hipFuncSetAttribute((const void*)hybrid_fwd, hipFuncAttributeMaxDynamicSharedMemorySize, LDS_BYTES) != hipSuccess) { fprintf(stderr, "kernel_launch: hipFuncSetAttribute failed\n"); grid = -1; return; }
        if (hipOccupancyMaxActiveBlocksPerMultiprocessor(&per_cu, (const void*)hybrid_fwd, NWAVES * 64, LDS_BYTES) != hipSuccess || per_cu < 1) { fprintf(stderr, "kernel_launch: occupancy query says %d blocks per CU\n", per_cu); per_cu = 1; }
        (void)hipGetLastError();
        grid = cus;
    }
    if (grid < 0) return;
    Args a{};
    for (int i = 0; i < 16; ++i) a.in[i] = (const float*)d_in[i];
    a.out = (float*)d_out; a.ws = (unsigned char*)d_ws;
#if MK_N_LAUNCHES == 1
#ifdef PRB_MEMSET2
    (void)hipMemsetAsync((char*)d_ws + WS_CTL + 512 * 1024, 0, CTL_ZERO_BYTES, stream);
#endif
    if (!CTL_GLOBAL && hipMemsetAsync((char*)d_ws + WS_CTL, 0, CTL_ZERO_BYTES, stream) != hipSuccess) { fprintf(stderr, "kernel_launch: memset of the control words failed\n"); return; }
    a.ph_lo = 0; a.ph_hi = NPHASE;
    void* kargs[] = {&a};
    hipError_t e = hipLaunchCooperativeKernel((const void*)hybrid_fwd, dim3(grid), dim3(NWAVES * 64), kargs, LDS_BYTES, stream);
    if (e != hipSuccess) fprintf(stderr, "kernel_launch: cooperative launch failed: %s (grid %d)\n", hipGetErrorString(e), grid);
#else
    for (int p = 0; p < NPHASE; ++p) {
        a.ph_lo = p; a.ph_hi = p + 1;
        hipLaunchKernelGGL(hybrid_fwd, dim3(grid), dim3(NWAVES * 64), LDS_BYTES, stream, a);
    }
#endif
}
```
